# Optimizing an MI355X kernel written in HIP

```python
import jax, jax.numpy as jnp
from jax import lax
import numpy as np

D_MODEL = 2048
BATCH = 2
SEQ = 8192
DEPTH = 4

CHUNK = 64
RET_HEADS = 8
RET_DK = 128
RET_DV = 256
RET_QK = RET_HEADS * RET_DK
RET_V = RET_HEADS * RET_DV
SGU_GROUPS = 8
SGU_LEN = 128
SGU_WIDTH = D_MODEL
SGU_CH = SGU_WIDTH // SGU_GROUPS
D_FF = -(-(8 * D_MODEL) // (3 * 256)) * 256
ROPE_BASE = 10000.0
EPS = 1e-6
SPLITS = [RET_QK, 2 * RET_QK, 2 * RET_QK + RET_V, 2 * RET_QK + 2 * RET_V,
          2 * RET_QK + 2 * RET_V + SGU_WIDTH, 2 * RET_QK + 2 * RET_V + 2 * SGU_WIDTH,
          2 * RET_QK + 2 * RET_V + 2 * SGU_WIDTH + D_MODEL]
IN_COLS = 2 * RET_QK + 2 * RET_V + 2 * SGU_WIDTH + 2 * D_MODEL

kernel_name = "hybrid_retention_sgu_griffin_merge"


def rms_norm(x, w):
    xf = x.astype(jnp.float32)
    y = xf * lax.rsqrt(jnp.mean(xf * xf, axis=-1, keepdims=True) + EPS)
    return (y * w.astype(jnp.float32)).astype(x.dtype)


def layer_norm(x, w, b):
    xf = x.astype(jnp.float32)
    mu = jnp.mean(xf, axis=-1, keepdims=True)
    var = jnp.mean(jnp.square(xf - mu), axis=-1, keepdims=True)
    y = (xf - mu) * lax.rsqrt(var + EPS) * w.astype(jnp.float32) + b.astype(jnp.float32)
    return y.astype(x.dtype)


def head_group_norm(o, w):
    B, S, H, dv = o.shape
    of = o.astype(jnp.float32)
    mu = jnp.mean(of, axis=-1, keepdims=True)
    var = jnp.mean(jnp.square(of - mu), axis=-1, keepdims=True)
    y = ((of - mu) * lax.rsqrt(var + EPS)).reshape(B, S, H * dv) * w.astype(jnp.float32)
    return y.astype(o.dtype)


def rotary(x, pos):
    half = x.shape[-1] // 2
    inv = ROPE_BASE ** (-jnp.arange(half, dtype=jnp.float32) / half)
    ang = pos.astype(jnp.float32)[:, None] * inv[None, :]
    cos = jnp.cos(ang)[None, :, None, :]
    sin = jnp.sin(ang)[None, :, None, :]
    xf = x.astype(jnp.float32)
    x1, x2 = xf[..., :half], xf[..., half:]
    return jnp.concatenate([x1 * cos - x2 * sin, x2 * cos + x1 * sin], axis=-1).astype(x.dtype)


def retention(q, k, v):
    B, S, H, dk = q.shape
    dv = v.shape[-1]
    nc = S // CHUNK
    dt = q.dtype
    log_g = jnp.log1p(-(2.0 ** (-5.0 - jnp.arange(H, dtype=jnp.float32))))
    idx = jnp.arange(CHUNK, dtype=jnp.float32)
    intra_decay = jnp.exp(log_g[:, None, None] * jnp.abs(idx[:, None] - idx[None, :]))
    q_decay = jnp.exp(log_g[None, :] * (idx[:, None] + 1.0))
    k_decay = jnp.exp(log_g[None, :] * (CHUNK - 1.0 - idx[:, None]))
    chunk_decay = jnp.exp(log_g * CHUNK)

    q = q.reshape(B, nc, CHUNK, H, dk) * (dk ** -0.5)
    k = k.reshape(B, nc, CHUNK, H, dk)
    v = v.reshape(B, nc, CHUNK, H, dv)

    scores = jnp.einsum('bnihd,bnjhd->bnhij', q, k) * intra_decay.astype(dt)
    o_intra = jnp.einsum('bnhij,bnjhe->bnihe', scores, v)

    qs = q * q_decay.astype(dt)[:, :, None]
    ks = k * k_decay.astype(dt)[:, :, None]
    cdec = chunk_decay.astype(dt)[None, :, None, None]

    def step(state, xs):
        qc, kc, vc = xs
        o = jnp.einsum('bihd,bhde->bihe', qc, state)
        state = state * cdec + jnp.einsum('bjhd,bjhe->bhde', kc, vc)
        return state, o

    s0 = jnp.zeros((B, H, dk, dv), dtype=v.dtype)
    _, o_inter = lax.scan(step, s0, (jnp.swapaxes(qs, 0, 1), jnp.swapaxes(ks, 0, 1),
                                     jnp.swapaxes(v, 0, 1)))
    o = o_intra + jnp.swapaxes(o_inter, 0, 1)
    return o.reshape(B, S, H, dv)


def spatial_gating(u, v, ln_w, ln_b, w_s, b_s):
    B, S, W = v.shape
    ng = S // SGU_LEN
    vn = layer_norm(v, ln_w, ln_b).reshape(B, ng, SGU_LEN, SGU_GROUPS, SGU_CH)
    pos = jnp.arange(SGU_LEN)
    mask = (pos[None, :] // CHUNK) <= (pos[:, None] // CHUNK)
    w = jnp.where(mask[None], w_s, jnp.zeros_like(w_s))
    mixed = jnp.einsum('gij,bnjgc->bnigc', w, vn) + b_s.T[None, None, :, :, None]
    return u * mixed.reshape(B, S, W)


def hybrid_layer(x, pos, norm_mix_w, w_in, ret_gn_w, ret_proj, sgu_ln_w, sgu_ln_b,
                 sgu_w_s, sgu_b_s, sgu_proj, w_out, norm_ffn_w, w_ffn_in, w_ffn_out):
    B, S, _ = x.shape
    h = rms_norm(x, norm_mix_w)
    z = h @ w_in
    q, k, v, g, su, sv, gate_a, gate_b = jnp.split(z, SPLITS, axis=-1)

    q = rotary(q.reshape(B, S, RET_HEADS, RET_DK), pos)
    k = rotary(k.reshape(B, S, RET_HEADS, RET_DK), pos)
    v = v.reshape(B, S, RET_HEADS, RET_DV)
    ret = head_group_norm(retention(q, k, v), ret_gn_w)
    branch_a = (jax.nn.silu(g) * ret) @ ret_proj

    zu = jax.nn.gelu(su, approximate=False)
    zv = jax.nn.gelu(sv, approximate=False)
    branch_b = spatial_gating(zu, zv, sgu_ln_w, sgu_ln_b, sgu_w_s, sgu_b_s) @ sgu_proj

    merged = jax.nn.sigmoid(gate_a) * branch_a + jax.nn.sigmoid(gate_b) * branch_b
    x = x + merged @ w_out

    h = rms_norm(x, norm_ffn_w)
    a, c = jnp.split(h @ w_ffn_in, 2, axis=-1)
    x = x + (jax.nn.silu(a) * c) @ w_ffn_out
    return x


def setup_inputs(seed: int = 0) -> dict:
    key = jax.random.key(seed)
    ks = jax.random.split(key, 16)
    f32 = jnp.float32
    nrm = lambda k, shape, scale: jax.random.normal(k, shape, f32) * scale
    return {
        "x": jax.random.normal(ks[0], (BATCH, SEQ, D_MODEL), f32),
        "norm_mix_w": 1.0 + nrm(ks[1], (DEPTH, D_MODEL), 0.02),
        "w_in": nrm(ks[2], (DEPTH, D_MODEL, IN_COLS), D_MODEL ** -0.5),
        "ret_gn_w": 1.0 + nrm(ks[3], (DEPTH, RET_V), 0.02),
        "ret_proj": nrm(ks[4], (DEPTH, RET_V, D_MODEL), RET_V ** -0.5),
        "sgu_ln_w": 1.0 + nrm(ks[5], (DEPTH, SGU_WIDTH), 0.02),
        "sgu_ln_b": nrm(ks[6], (DEPTH, SGU_WIDTH), 0.02),
        "sgu_w_s": nrm(ks[7], (DEPTH, SGU_GROUPS, SGU_LEN, SGU_LEN), SGU_LEN ** -0.5),
        "sgu_b_s": 1.0 + nrm(ks[8], (DEPTH, SGU_GROUPS, SGU_LEN), 0.02),
        "sgu_proj": nrm(ks[9], (DEPTH, SGU_WIDTH, D_MODEL), SGU_WIDTH ** -0.5),
        "w_out": nrm(ks[10], (DEPTH, D_MODEL, D_MODEL), D_MODEL ** -0.5),
        "norm_ffn_w": 1.0 + nrm(ks[11], (DEPTH, D_MODEL), 0.02),
        "w_ffn_in": nrm(ks[12], (DEPTH, D_MODEL, 2 * D_FF), D_MODEL ** -0.5),
        "w_ffn_out": nrm(ks[13], (DEPTH, D_FF, D_MODEL), D_FF ** -0.5),
        "final_norm_w": 1.0 + nrm(ks[14], (D_MODEL,), 0.02),
    }


def reference(x, norm_mix_w, w_in, ret_gn_w, ret_proj, sgu_ln_w, sgu_ln_b, sgu_w_s, sgu_b_s,
              sgu_proj, w_out, norm_ffn_w, w_ffn_in, w_ffn_out, final_norm_w):
    pos = jnp.arange(x.shape[1], dtype=jnp.int32)
    for l in range(DEPTH):
        x = hybrid_layer(x, pos, norm_mix_w[l], w_in[l], ret_gn_w[l], ret_proj[l], sgu_ln_w[l],
                         sgu_ln_b[l], sgu_w_s[l], sgu_b_s[l], sgu_proj[l], w_out[l],
                         norm_ffn_w[l], w_ffn_in[l], w_ffn_out[l])
    return rms_norm(x, final_norm_w)
```

```cpp
#include <hip/hip_runtime.h>
#include <cstdio>
#include <cstdint>
namespace pg8 {
#define PG8_LAS __attribute__((address_space(3)))
typedef unsigned short bf16_t;
typedef short bf16x8 __attribute__((ext_vector_type(8)));
typedef float f32x4 __attribute__((ext_vector_type(4)));
typedef unsigned u32x4 __attribute__((ext_vector_type(4)));
constexpr int BM = 256, BK = 64, HALF = 128, HTB = HALF * BK * 2  , STAGE_BYTES = 8 * HTB, NXCD = 8, WGM = 8;

__host__ __device__ __forceinline__ int lds_byte(int r, int c) { const int st = (r >> 4) * 2 + (c >> 5), rr = r & 15, cc = c & 31, ob = rr * 64 + cc * 2; return st * 1024 + (ob ^ (((ob >> 9) & 1) << 5)); }
__host__ __device__ __forceinline__ void stage_rc(int b, int& R, int& C) { const int st = b / 1024, sb = b % 1024, swz = sb ^ (((sb >> 9) & 1) << 5); R = (st >> 1) * 16 + swz / 64; C = (st & 1) * 32 + (swz % 64) / 2; }
__host__ __device__ __forceinline__ int perm32(int rho) { const int n = rho >> 4, i = rho & 15; return 8 * (i >> 2) + 4 * n + (i & 3); }

struct Unit { int pm, pn; };
struct Gemm { const bf16_t* A; const bf16_t* Bt; int M, N, K; };

struct StaticOrder {
    int nM, nN, nwg, G, c;
    __host__ __device__ void init(int M, int N, int G_, int c_) { nM = M / BM; nN = N / BM; nwg = nM * nN; G = G_; c = c_; }
    __host__ __device__ bool next(int i, Unit& u) const {
        const long L = (long)i * G + c; if (L >= nwg) return false;
        int wgid = (int)L; { const int q = nwg / NXCD, r = nwg % NXCD, xcd = wgid % NXCD, off = wgid / NXCD; wgid = (xcd < r ? xcd * (q + 1) : r * (q + 1) + (xcd - r) * q) + off; }
        const int nig = WGM * nN, gid = wgid / nig, fm = gid * WGM, gsz = (nM - fm) < WGM ? (nM - fm) : WGM;
        u.pm = fm + ((wgid % nig) % gsz); u.pn = (wgid % nig) / gsz; return true;
    }
    __device__ __forceinline__ void a_ready(const Unit&) const {}
    __device__ __forceinline__ void done(const Unit&) const {}
};

typedef float f32x2c_t __attribute__((ext_vector_type(2))); typedef __bf16 bf16x2c_t __attribute__((ext_vector_type(2)));
__device__ __forceinline__ unsigned cvt_pk_bf16(float lo, float hi) { const f32x2c_t v = {lo, hi}; const bf16x2c_t b = __builtin_convertvector(v, bf16x2c_t); return __builtin_bit_cast(unsigned, b); }
typedef float f32x2 __attribute__((ext_vector_type(2)));
__device__ __forceinline__ f32x2 gelu_pk(f32x2 v) {
    const f32x2 av = __builtin_elementwise_abs(v), d = av * 0.2316418882f + 1.0f;
    f32x2 t; t.x = __builtin_amdgcn_rcpf(d.x); t.y = __builtin_amdgcn_rcpf(d.y);
    f32x2 q = t * 0.5307027145f + (-0.7265760135f); q = q * t + 0.7107068705f; q = q * t + (-0.142248368f); q = q * t + 0.127414796f; q = q * t;
    const f32x2 s = (v * v) * (-0.72134752044f);
    f32x2 e; e.x = __builtin_amdgcn_exp2f(s.x); e.y = __builtin_amdgcn_exp2f(s.y);
    const f32x2 m = v * (q * e), r = v - m;
    f32x2 o; o.x = v.x < 0.f ? m.x : r.x; o.y = v.y < 0.f ? m.y : r.y; return o;
}

constexpr int MROWS = 16384, DM = 2048;
constexpr float RMS_EPS = 1e-6f;
__device__ __forceinline__ float sigm_f(float x) { return __builtin_amdgcn_rcpf(1.0f + __builtin_amdgcn_exp2f(x * -1.44269504089f)); }
__device__ __forceinline__ float silu_f(float x) { return x * sigm_f(x); }
__device__ __forceinline__ float bf_lo(unsigned w) { return __uint_as_float(w << 16); }
__device__ __forceinline__ float bf_hi(unsigned w) { return __uint_as_float(w & 0xffff0000u); }
__device__ __forceinline__ u32x4 pack8(const f32x4& a, const f32x4& b) { u32x4 w; w.x = cvt_pk_bf16(a[0], a[1]); w.y = cvt_pk_bf16(a[2], a[3]); w.z = cvt_pk_bf16(b[0], b[1]); w.w = cvt_pk_bf16(b[2], b[3]); return w; }
__device__ __forceinline__ float row_rstd1(const float* ss, int row, int fq) {
    const float* p = ss + (size_t)row * 32 + 8 * fq; const f32x4 a = *(const f32x4*)p, b = *(const f32x4*)(p + 4);
    float s = ((a[0] + a[1]) + (a[2] + a[3])) + ((b[0] + b[1]) + (b[2] + b[3])); s += __shfl_xor(s, 16); s += __shfl_xor(s, 32);
    return 1.0f / sqrtf(s * (1.0f / 2048.0f) + RMS_EPS);
}

struct EpiIn {
    static constexpr bool PERM = true, AFTER_DRAIN = false;
    const float* ss;
    const float* rope;
    bf16_t* q; bf16_t* k;
    bf16_t* o2048;
    float* ls;
    template <int ACT> __device__ __forceinline__ void emit(const f32x4 (&acc)[2][2][4][2], bf16_t* base, int row0, int col0, int slot0, int fq) const {
#pragma unroll
        for (int ai = 0; ai < 2; ++ai)
#pragma unroll
            for (int m = 0; m < 4; ++m) { const int row = row0 + ai * HALF + m * 16; const float r = row_rstd1(ss, row, fq); bf16_t* rowp = base + (size_t)row * DM + col0; float s1 = 0.f, s2 = 0.f;
#pragma unroll
                for (int bj = 0; bj < 2; ++bj) { f32x4 v0 = acc[ai][bj][m][0] * r, v1 = acc[ai][bj][m][1] * r;
                    if (ACT == 1) {
#pragma unroll
                        for (int j = 0; j < 4; ++j) { v0[j] = silu_f(v0[j]); v1[j] = silu_f(v1[j]); } }
                    if (ACT == 2 || ACT == 3) { const f32x2 a = gelu_pk((f32x2){v0[0], v0[1]}), b = gelu_pk((f32x2){v0[2], v0[3]}), c = gelu_pk((f32x2){v1[0], v1[1]}), d = gelu_pk((f32x2){v1[2], v1[3]});
                        v0 = (f32x4){a.x, a.y, b.x, b.y}; v1 = (f32x4){c.x, c.y, d.x, d.y}; }
                    if (ACT == 4) {
#pragma unroll
                        for (int j = 0; j < 4; ++j) { v0[j] = sigm_f(v0[j]); v1[j] = sigm_f(v1[j]); } }
                    if (ACT == 3) { s1 += ((v0[0] + v0[1]) + (v0[2] + v0[3])) + ((v1[0] + v1[1]) + (v1[2] + v1[3]));
                        s2 += ((v0[0] * v0[0] + v0[1] * v0[1]) + (v0[2] * v0[2] + v0[3] * v0[3])) + ((v1[0] * v1[0] + v1[1] * v1[1]) + (v1[2] * v1[2] + v1[3] * v1[3])); }
                    *(u32x4*)(rowp + bj * HALF) = pack8(v0, v1); }
                if (ACT == 3) { s1 += __shfl_xor(s1, 16); s1 += __shfl_xor(s1, 32); s2 += __shfl_xor(s2, 16); s2 += __shfl_xor(s2, 32);
                    if (fq == 0) *(f32x2*)(ls + ((size_t)row * 32 + slot0) * 2) = (f32x2){s1, s2}; } }
    }
    __device__ __forceinline__ void operator()(const f32x4 (&acc)[2][2][4][2], const Unit& u, int wr, int wc, int fr, int fq) const {
        const int row0 = u.pm * BM + wr * 64 + fr, pn = u.pn;
        if (pn < 8) {
            bf16_t* base = (pn < 4) ? q : k; const int col0 = (pn & 3) * BM + wc * 32 + 8 * fq;
#pragma unroll
            for (int ai = 0; ai < 2; ++ai)
#pragma unroll
                for (int m = 0; m < 4; ++m) { const int row = row0 + ai * HALF + m * 16; const float r = row_rstd1(ss, row, fq); const int pos = row & 8191;
                    const f32x4* tp = (const f32x4*)(rope + ((size_t)pos * 64 + 16 * wc + 4 * fq) * 2); const f32x4 t0 = tp[0], t1 = tp[1];
                    bf16_t* rowp = base + (size_t)row * 1024 + col0;
#pragma unroll
                    for (int bj = 0; bj < 2; ++bj) { const f32x4 v0 = acc[ai][bj][m][0] * r, v1 = acc[ai][bj][m][1] * r; f32x4 y0, y1;
                        y0[0] = v0[0] * t0[0] - v0[1] * t0[1]; y0[1] = v0[1] * t0[0] + v0[0] * t0[1]; y0[2] = v0[2] * t0[2] - v0[3] * t0[3]; y0[3] = v0[3] * t0[2] + v0[2] * t0[3];
                        y1[0] = v1[0] * t1[0] - v1[1] * t1[1]; y1[1] = v1[1] * t1[0] + v1[0] * t1[1]; y1[2] = v1[2] * t1[2] - v1[3] * t1[3]; y1[3] = v1[3] * t1[2] + v1[2] * t1[3];
                        *(u32x4*)(rowp + bj * HALF) = pack8(y0, y1); } }
        } else {
            const int s = (pn - 8) >> 3, tile = (pn - 8) & 7; bf16_t* base = o2048 + (size_t)s * ((size_t)MROWS * DM); const int col0 = tile * BM + wc * 32 + 8 * fq, slot0 = tile * 4 + wc;
            if (s == 0) emit<0>(acc, base, row0, col0, slot0, fq);
            else if (s == 1) emit<1>(acc, base, row0, col0, slot0, fq);
            else if (s == 2) emit<2>(acc, base, row0, col0, slot0, fq);
            else if (s == 3) emit<3>(acc, base, row0, col0, slot0, fq);
            else emit<4>(acc, base, row0, col0, slot0, fq);
        }
    }
};

template <bool SECOND> struct EpiMerge {
    static constexpr bool PERM = true, AFTER_DRAIN = false;
    const bf16_t* gate; bf16_t* p; bf16_t* mg;
    __device__ __forceinline__ void operator()(const f32x4 (&acc)[2][2][4][2], const Unit& u, int wr, int wc, int fr, int fq) const {
        const int row0 = u.pm * BM + wr * 64 + fr, col0 = u.pn * BM + wc * 32 + 8 * fq;
#pragma unroll
        for (int ai = 0; ai < 2; ++ai)
#pragma unroll
            for (int m = 0; m < 4; ++m) { const size_t off = (size_t)(row0 + ai * HALF + m * 16) * DM + col0;
#pragma unroll
                for (int bj = 0; bj < 2; ++bj) { const u32x4 g = *(const u32x4*)(gate + off + bj * HALF);
                    f32x4 v0 = acc[ai][bj][m][0], v1 = acc[ai][bj][m][1];
#if defined(G2_TEST) && G2_TEST == 2
                    if (SECOND) {
#endif
                    v0[0] *= bf_lo(g.x); v0[1] *= bf_hi(g.x); v0[2] *= bf_lo(g.y); v0[3] *= bf_hi(g.y); v1[0] *= bf_lo(g.z); v1[1] *= bf_hi(g.z); v1[2] *= bf_lo(g.w); v1[3] *= bf_hi(g.w);
#if defined(G2_TEST) && G2_TEST == 2
                    }
#endif
                    if (SECOND) { const unsigned long long* pq = (const unsigned long long*)(p + off + bj * HALF);
                        const unsigned long long p0 = __hip_atomic_load(pq, __ATOMIC_RELAXED, __HIP_MEMORY_SCOPE_AGENT), p1 = __hip_atomic_load(pq + 1, __ATOMIC_RELAXED, __HIP_MEMORY_SCOPE_AGENT);
                        u32x4 pp; pp.x = (unsigned)p0; pp.y = (unsigned)(p0 >> 32); pp.z = (unsigned)p1; pp.w = (unsigned)(p1 >> 32);
                        v0[0] += bf_lo(pp.x); v0[1] += bf_hi(pp.x); v0[2] += bf_lo(pp.y); v0[3] += bf_hi(pp.y); v1[0] += bf_lo(pp.z); v1[1] += bf_hi(pp.z); v1[2] += bf_lo(pp.w); v1[3] += bf_hi(pp.w);
                        *(u32x4*)(mg + off + bj * HALF) = pack8(v0, v1); }
                    else *(u32x4*)(p + off + bj * HALF) = pack8(v0, v1); }
                asm volatile("" ::: "memory"); }
    }
};

struct EpiResid {
    static constexpr bool PERM = true, AFTER_DRAIN = false;
    float* x; bf16_t* xb; float* ssout;
    __device__ __forceinline__ void operator()(const f32x4 (&acc)[2][2][4][2], const Unit& u, int wr, int wc, int fr, int fq) const {
        const int row0 = u.pm * BM + wr * 64 + fr, col0 = u.pn * BM + wc * 32 + 8 * fq;
#pragma unroll
        for (int ai = 0; ai < 2; ++ai)
#pragma unroll
            for (int m = 0; m < 4; ++m) { const int row = row0 + ai * HALF + m * 16; const size_t off = (size_t)row * DM + col0; float s2 = 0.f;
#pragma unroll
                for (int bj = 0; bj < 2; ++bj) { float* xp = x + off + bj * HALF; f32x4 a0 = *(const f32x4*)xp, a1 = *(const f32x4*)(xp + 4);
                    a0 += acc[ai][bj][m][0]; a1 += acc[ai][bj][m][1]; *(f32x4*)xp = a0; *(f32x4*)(xp + 4) = a1;
                    s2 += ((a0[0] * a0[0] + a0[1] * a0[1]) + (a0[2] * a0[2] + a0[3] * a0[3])) + ((a1[0] * a1[0] + a1[1] * a1[1]) + (a1[2] * a1[2] + a1[3] * a1[3]));
                    *(u32x4*)(xb + off + bj * HALF) = pack8(a0, a1); }
                s2 += __shfl_xor(s2, 16); s2 += __shfl_xor(s2, 32);
                if (fq == 0) ssout[(size_t)row * 32 + u.pn * 4 + wc] = s2;
                asm volatile("" ::: "memory"); }
    }
};

struct EpiSwiglu {
    static constexpr bool PERM = true, AFTER_DRAIN = false;
    const float* ss; bf16_t* h;
    __device__ __forceinline__ void operator()(const f32x4 (&acc)[2][2][4][2], const Unit& u, int wr, int wc, int fr, int fq) const {
        const int row0 = u.pm * BM + wr * 64 + fr, col0 = u.pn * HALF + wc * 32 + 8 * fq;
#pragma unroll
        for (int ai = 0; ai < 2; ++ai)
#pragma unroll
            for (int m = 0; m < 4; ++m) { const float r = row_rstd1(ss, row0 + ai * HALF + m * 16, fq); f32x4 a0 = acc[ai][0][m][0] * r, a1 = acc[ai][0][m][1] * r; const f32x4 c0 = acc[ai][1][m][0] * r, c1 = acc[ai][1][m][1] * r;
#pragma unroll
                for (int j = 0; j < 4; ++j) { a0[j] = silu_f(a0[j]) * c0[j]; a1[j] = silu_f(a1[j]) * c1[j]; }
                *(u32x4*)(h + (size_t)(row0 + ai * HALF + m * 16) * 5632 + col0) = pack8(a0, a1); }
    }
};
template <class Epi, class Sched, bool ALIGN_EPI = false, bool SP2 = false>
__device__ __forceinline__ void gemm_phase(PG8_LAS unsigned char* lds, const Gemm g, const Sched& S, const Epi& E, const int tid_in) {
    const int tid = tid_in, wid = __builtin_amdgcn_readfirstlane(tid >> 6), lane = tid & 63, wr = wid >> 2, wc = wid & 3, fr = lane & 15, fq = lane >> 4;
    const int K = g.K, nt = K / BK;
    unsigned voffA[2], voffB[2];
#pragma unroll
    for (int i = 0; i < 2; ++i) { int R, C; stage_rc(tid * 16 + i * 8192, R, C); const int Rb = Epi::PERM ? ((R & ~31) + perm32(R & 31)) : R;
        voffA[i] = (unsigned)(R * K + C) * 2u; voffB[i] = (unsigned)(Rb * K + C) * 2u; }
    const size_t kstep = (size_t)(BK * 2);
    const size_t hstep = (size_t)HALF * K * 2;
    const size_t tstep = 2 * hstep;
    const unsigned ldsw = (unsigned)wid * 1024u;
    const int aoff = lds_byte(wr * 64 + fr, fq * 8), boff = lds_byte(wc * 32 + fr, fq * 8);
#define PG8_SA(b, h) (((b) * 2 + (h)) * HTB)
#define PG8_SB(b, h) ((4 + (b) * 2 + (h)) * HTB)
#define PG8_STAGE(bufoff, gbase, voff) do { _Pragma("unroll") for (int _i = 0; _i < 2; ++_i) \
        __builtin_amdgcn_global_load_lds((const unsigned*)((const char*)(gbase) + (voff)[_i]), (PG8_LAS unsigned*)(lds + (bufoff) + ldsw + _i * 8192), 16, 0, 0); } while (0)
#define PG8_LDA(dst, b, h) do { _Pragma("unroll") for (int m = 0; m < 4; ++m) _Pragma("unroll") for (int k = 0; k < 2; ++k) dst[m][k] = *(const PG8_LAS bf16x8*)(lds + PG8_SA(b, h) + aoff + m * 2048 + k * 1024); } while (0)
#define PG8_LDB(dst, b, h) do { _Pragma("unroll") for (int n = 0; n < 2; ++n) _Pragma("unroll") for (int k = 0; k < 2; ++k) dst[n][k] = *(const PG8_LAS bf16x8*)(lds + PG8_SB(b, h) + boff + n * 2048 + k * 1024); } while (0)
#define PG8_MMA(ai, bj, At, Bt) do { __builtin_amdgcn_s_setprio(1); _Pragma("unroll") for (int m = 0; m < 4; ++m) _Pragma("unroll") for (int n = 0; n < 2; ++n) _Pragma("unroll") for (int k = 0; k < 2; ++k) \
        acc[ai][bj][m][n] = __builtin_amdgcn_mfma_f32_16x16x32_bf16(Bt[n][k], At[m][k], acc[ai][bj][m][n], 0, 0, 0); __builtin_amdgcn_s_setprio(0); } while (0)
#define PG8_WAIT_V(n) asm volatile("s_waitcnt vmcnt(" #n ")" ::: "memory")
#define PG8_WAIT_L(n) asm volatile("s_waitcnt lgkmcnt(" #n ")" ::: "memory")
#define PG8_BAR __builtin_amdgcn_s_barrier()
#define PG8_SCHED __builtin_amdgcn_sched_barrier(0)
    Unit cur, nxt; int ui = 0;
    if (!S.next(0, cur)) return;
    f32x4 acc[2][2][4][2];
#pragma unroll
    for (int a = 0; a < 2; ++a)
#pragma unroll
        for (int b = 0; b < 2; ++b)
#pragma unroll
            for (int m = 0; m < 4; ++m)
#pragma unroll
                for (int n = 0; n < 2; ++n) acc[a][b][m][n] = (f32x4){0.f, 0.f, 0.f, 0.f};
    bf16x8 At[4][2], B0[2][2], B1[2][2];
    const char* cA = (const char*)g.A + (size_t)cur.pm * tstep; const char* cB = (const char*)g.Bt + (size_t)cur.pn * tstep;
    S.a_ready(cur);
    if constexpr (SP2) {
        PG8_STAGE(PG8_SB(0, 0), cB, voffB); PG8_STAGE(PG8_SB(0, 1), cB + hstep, voffB); PG8_STAGE(PG8_SA(0, 0), cA, voffA); PG8_STAGE(PG8_SA(0, 1), cA + hstep, voffA);
        if (wr == 1) PG8_BAR;
        PG8_WAIT_V(2); PG8_BAR;
        PG8_STAGE(PG8_SB(1, 0), cB + kstep, voffB); PG8_STAGE(PG8_SA(1, 0), cA + kstep, voffA); PG8_STAGE(PG8_SB(1, 1), cB + hstep + kstep, voffB);
        PG8_WAIT_V(6); PG8_BAR;
    } else {
        PG8_STAGE(PG8_SB(0, 0), cB, voffB); PG8_STAGE(PG8_SA(0, 0), cA, voffA); PG8_STAGE(PG8_SB(0, 1), cB + hstep, voffB); PG8_STAGE(PG8_SA(0, 1), cA + hstep, voffA);
        if (wr == 1) PG8_BAR;
        PG8_WAIT_V(4); PG8_BAR;
        PG8_STAGE(PG8_SB(1, 0), cB + kstep, voffB); PG8_STAGE(PG8_SA(1, 0), cA + kstep, voffA); PG8_STAGE(PG8_SB(1, 1), cB + hstep + kstep, voffB);
        PG8_WAIT_V(6); PG8_BAR;
    }
    for (;;) {
        const bool has_next = S.next(ui + 1, nxt);
        const char* nA = has_next ? (const char*)g.A + (size_t)nxt.pm * tstep : cA; const char* nB = has_next ? (const char*)g.Bt + (size_t)nxt.pn * tstep : cB;
        for (int t = 0; t < nt; t += 2) {
            const bool last = (t == nt - 2);
            const char* a1 = cA + (size_t)(t + 1) * kstep;
            const char* a2 = last ? nA : cA + (size_t)(t + 2) * kstep; const char* b2 = last ? nB : cB + (size_t)(t + 2) * kstep;
            const char* a3 = a2 + kstep; const char* b3 = b2 + kstep;
            if (last && has_next) S.a_ready(nxt);
            if constexpr (SP2) {
            PG8_LDB(B0, 0, 0); PG8_LDB(B1, 0, 1); PG8_SCHED; PG8_LDA(At, 0, 0); PG8_STAGE(PG8_SA(1, 1), a1 + hstep, voffA);
            PG8_WAIT_V(8); PG8_WAIT_L(0); PG8_BAR; PG8_MMA(0, 0, At, B0); PG8_MMA(0, 1, At, B1); PG8_BAR; PG8_SCHED;
            PG8_LDA(At, 0, 1); PG8_STAGE(PG8_SB(0, 0), b2, voffB); PG8_STAGE(PG8_SB(0, 1), b2 + hstep, voffB); PG8_STAGE(PG8_SA(0, 0), a2, voffA);
            PG8_WAIT_V(8); PG8_WAIT_L(0); PG8_BAR; PG8_MMA(1, 0, At, B0); PG8_MMA(1, 1, At, B1); PG8_BAR; PG8_SCHED;
            PG8_LDB(B0, 1, 0); PG8_LDB(B1, 1, 1); PG8_SCHED; PG8_LDA(At, 1, 0); PG8_STAGE(PG8_SA(0, 1), a2 + hstep, voffA);
            PG8_WAIT_V(8); PG8_WAIT_L(0); PG8_BAR; PG8_MMA(0, 0, At, B0); PG8_MMA(0, 1, At, B1); PG8_BAR; PG8_SCHED;
            PG8_LDA(At, 1, 1); PG8_STAGE(PG8_SB(1, 0), b3, voffB); PG8_STAGE(PG8_SB(1, 1), b3 + hstep, voffB); PG8_STAGE(PG8_SA(1, 0), a3, voffA);
            PG8_WAIT_V(8); PG8_WAIT_L(0); PG8_BAR; PG8_MMA(1, 0, At, B0); PG8_MMA(1, 1, At, B1); PG8_BAR; PG8_SCHED;
            } else {
            PG8_LDB(B0, 0, 0); PG8_SCHED; PG8_LDA(At, 0, 0); PG8_STAGE(PG8_SA(1, 1), a1 + hstep, voffA);
            PG8_WAIT_L(8); PG8_BAR; PG8_WAIT_L(0); PG8_MMA(0, 0, At, B0); PG8_BAR; PG8_SCHED;
            PG8_LDB(B1, 0, 1); PG8_STAGE(PG8_SB(0, 0), b2, voffB);
            PG8_BAR; PG8_WAIT_L(0); PG8_MMA(0, 1, At, B1); PG8_BAR;
            PG8_LDA(At, 0, 1); PG8_STAGE(PG8_SA(0, 0), a2, voffA);
            PG8_BAR; PG8_WAIT_L(0); PG8_MMA(1, 0, At, B0); PG8_BAR; PG8_SCHED;
            PG8_STAGE(PG8_SB(0, 1), b2 + hstep, voffB);
            PG8_WAIT_V(6); PG8_BAR; PG8_MMA(1, 1, At, B1); PG8_BAR;
            PG8_LDB(B0, 1, 0); PG8_SCHED; PG8_LDA(At, 1, 0); PG8_STAGE(PG8_SA(0, 1), a2 + hstep, voffA);
            PG8_WAIT_L(8); PG8_BAR; PG8_WAIT_L(0); PG8_MMA(0, 0, At, B0); PG8_BAR; PG8_SCHED;
            PG8_LDB(B1, 1, 1); PG8_STAGE(PG8_SB(1, 0), b3, voffB);
            PG8_BAR; PG8_WAIT_L(0); PG8_MMA(0, 1, At, B1); PG8_BAR;
            PG8_LDA(At, 1, 1); PG8_STAGE(PG8_SA(1, 0), a3, voffA);
            PG8_BAR; PG8_WAIT_L(0); PG8_MMA(1, 0, At, B0); PG8_BAR; PG8_SCHED;
            PG8_STAGE(PG8_SB(1, 1), b3 + hstep, voffB);
            PG8_WAIT_V(6); PG8_BAR; PG8_MMA(1, 1, At, B1); PG8_BAR;
            }
        }
        if constexpr (ALIGN_EPI) { if (wr == 0) PG8_BAR; }
        if constexpr (!Epi::AFTER_DRAIN) { E(acc, cur, wr, wc, fr, fq); S.done(cur); }
        if (!has_next) break;
#pragma unroll
        for (int a = 0; a < 2; ++a)
#pragma unroll
            for (int b = 0; b < 2; ++b)
#pragma unroll
                for (int m = 0; m < 4; ++m)
#pragma unroll
                    for (int n = 0; n < 2; ++n) acc[a][b][m][n] = (f32x4){0.f, 0.f, 0.f, 0.f};
        cur = nxt; cA = nA; cB = nB; ++ui;
        if constexpr (ALIGN_EPI) { if (wr == 1) PG8_BAR; }
    }
    PG8_WAIT_V(0);
    if constexpr (!ALIGN_EPI) { if (wr == 0) PG8_BAR; }
    PG8_BAR;
    if constexpr (Epi::AFTER_DRAIN) { E.fused(acc, cur, wr, wc, fr, fq, lds, wid, lane); S.done(cur); }
#undef PG8_SA
#undef PG8_SB
#undef PG8_STAGE
#undef PG8_LDA
#undef PG8_LDB
#undef PG8_MMA
#undef PG8_WAIT_V
#undef PG8_WAIT_L
#undef PG8_BAR
#undef PG8_SCHED
}
}

#ifndef MK_PER_PHASE
#define MK_PER_PHASE 0
#endif
constexpr int NWAVES = 8;
constexpr int BATCH = 2, T = 8192, D = 2048, M = BATCH * T, DEPTH = 4;
constexpr int NIN = 14336, DFF = 5632, NFF = 2 * DFF;
constexpr float EPS = 1e-6f;
static_assert(M == pg8::MROWS && D == pg8::DM, "shapes");

constexpr size_t MiB = 1u << 20;
constexpr size_t WS_CTL = 0, CTL_ZERO_BYTES = 1 * MiB;
constexpr size_t WS_ROPE = 1 * MiB;
constexpr size_t WS_SS = 5 * MiB, WS_SS2 = 7 * MiB;
constexpr size_t WS_LS = 9 * MiB;
constexpr size_t WS_W = 16 * MiB, W_LAYER = 146 * MiB;
constexpr size_t W_IN = 0, W_R = 56 * MiB, W_S = 64 * MiB, W_O = 72 * MiB, W_F1 = 80 * MiB, W_F2 = 124 * MiB;
static_assert((size_t)NIN * D * 2 == 56 * MiB && (size_t)NFF * D * 2 == 44 * MiB && (size_t)D * DFF * 2 == 22 * MiB, "weight map");
constexpr size_t WS_X = 600 * MiB;
constexpr size_t WS_XB = 728 * MiB;
constexpr size_t WS_Q = 792 * MiB, WS_K = 824 * MiB;
constexpr size_t WS_O2048 = 856 * MiB;
constexpr size_t WS_V = WS_O2048, WS_SG = WS_V + 64 * MiB, WS_ZU = WS_SG + 64 * MiB, WS_ZV = WS_ZU + 64 * MiB, WS_GA = WS_ZV + 64 * MiB, WS_GB = WS_GA + 64 * MiB;
constexpr size_t WS_RA = 1240 * MiB, WS_SB = 1304 * MiB;
constexpr size_t WS_P = 1368 * MiB, WS_MG = 1432 * MiB;
constexpr size_t WS_SLOC = 1496 * MiB;
constexpr size_t WS_END = 1528 * MiB;
constexpr size_t WS_H = WS_Q;
static_assert(WS_W + DEPTH * W_LAYER <= WS_X && WS_GB + 64 * MiB == WS_RA && WS_SB == WS_RA + 64 * MiB && WS_H + (size_t)M * DFF * 2 <= WS_ZU, "d_ws map");
constexpr int CW_TMO = 0, CW_CODE = 1, CW_BAR = 4096;

constexpr int RING_OFF = 0, RING_BYTES = 131072;
constexpr int LDSCTL_OFF = RING_BYTES, MISC_OFF = LDSCTL_OFF + 320;
constexpr int LDS_BYTES = 147456;
constexpr int R_Q = 0, R_K = 17408, R_KS = 34816, R_V = 52224, R_P = 86016, R_RED = 95232, R_END = 99328;
constexpr int PQ = 272, PV = 528, PP = 144;
constexpr int S_W = 0, S_VN = 34816, S_ST = 102400, S_END = 103424;
static_assert(R_END <= RING_BYTES && S_END <= RING_BYTES, "LDS map");

#define GAS __attribute__((address_space(1)))
#define LAS __attribute__((address_space(3)))
typedef unsigned short bf16;
typedef unsigned v4u __attribute__((ext_vector_type(4)));
typedef unsigned v2u __attribute__((ext_vector_type(2)));
typedef float f32x4 __attribute__((ext_vector_type(4)));
typedef float f32x2 __attribute__((ext_vector_type(2)));
typedef short bf16x8 __attribute__((ext_vector_type(8)));
typedef short s16x4 __attribute__((ext_vector_type(4)));
typedef GAS unsigned gu32;
#define RLX_AGENT __ATOMIC_RELAXED, __HIP_MEMORY_SCOPE_AGENT
#define LDS_WAIT() asm volatile("s_waitcnt lgkmcnt(0)" ::: "memory")
#define VM_WAIT() asm volatile("s_waitcnt vmcnt(0)" ::: "memory")
__device__ __forceinline__ unsigned f2bf(float f) { unsigned u = __builtin_bit_cast(unsigned, f); return (u + 0x7fffu + ((u >> 16) & 1u)) >> 16; }
__device__ __forceinline__ unsigned pk2(float lo, float hi) { return f2bf(lo) | (f2bf(hi) << 16); }
__device__ __forceinline__ float blo(unsigned w) { return __uint_as_float(w << 16); }
__device__ __forceinline__ float bhi(unsigned w) { return __uint_as_float(w & 0xffff0000u); }
__device__ __forceinline__ float ex2(float x) { return __builtin_amdgcn_exp2f(x); }
__device__ __forceinline__ float l2gamma(int h) {
    const float t0 = (h & 1) ? -0.02272007650008353f : -0.04580368961312479f, t1 = (h & 1) ? -0.005646563141142063f : -0.011315313227834146f;
    const float t2 = (h & 1) ? -0.0014095702546713536f : -0.0028205190623786626f, t3 = (h & 1) ? -0.0003522634716290214f : -0.0007046129765893727f;
    const float a = (h & 2) ? t1 : t0, b = (h & 2) ? t3 : t2; return (h & 4) ? b : a; }
#define MFMA16(a, b, c) __builtin_amdgcn_mfma_f32_16x16x32_bf16((a), (b), (c), 0, 0, 0)

#define XB_TMO      128
#define XB_XCNT(j)  (256  + 64 * (j))
#define XB_XSUB(j)  (1280 + 64 * (j))
#define XB_XGEN(j)  (2304 + 64 * (j))
#define XB_TOP      3328
#define XB_TOPGEN   3392
#define XCD_BAR_WORDS 3456
#define XB_SPIN_CAP (1u << 18)

__device__ __forceinline__ unsigned xb_ld(unsigned* p)              { return __hip_atomic_load(p, __ATOMIC_RELAXED, __HIP_MEMORY_SCOPE_AGENT); }
__device__ __forceinline__ unsigned xb_add(unsigned* p, unsigned v) { return __hip_atomic_fetch_add(p, v, __ATOMIC_RELAXED, __HIP_MEMORY_SCOPE_AGENT); }
__device__ __forceinline__ unsigned xb_xcc_id() { return (unsigned)__builtin_amdgcn_s_getreg((3 << 11) | 20) & 0xFu; }
#define XB_SPIN(cond, bar) do { unsigned _sp = 0; while (cond) { __builtin_amdgcn_s_sleep(1); \
    if ((++_sp & 255u) == 0u) { if (xb_ld(&(bar)[XB_TMO])) break; if (_sp > XB_SPIN_CAP) { atomicAdd(&(bar)[XB_TMO], 1u); break; } } } } while (0)

struct XcdBarrier {
    unsigned* bar; unsigned x;
    volatile LAS unsigned* st;
};

__device__ __forceinline__ XcdBarrier xcd_barrier_post(unsigned* bar, volatile LAS unsigned* st) {
    XcdBarrier b; b.bar = bar; b.x = xb_xcc_id(); b.st = st;
    if (threadIdx.x == 0) (void)xb_add(&bar[XB_XCNT(b.x)], 1u);
    return b;
}
__device__ __forceinline__ void xcd_barrier_complete(unsigned* bar, unsigned x, unsigned& nloc, unsigned& nx) {
    const unsigned G = gridDim.x * gridDim.y * gridDim.z;
    unsigned sum, cnt, mine, sp = 0u;
    for (;;) {
        sum = 0u; cnt = 0u; mine = 0u;
#pragma unroll
        for (unsigned j = 0; j < 16; ++j) { const unsigned c = xb_ld(&bar[XB_XCNT(j)]); sum += c; cnt += (c > 0u) ? 1u : 0u; mine = (j == x) ? c : mine; }
        if (sum == G) break;
        __builtin_amdgcn_s_sleep(1);
        if ((++sp & 255u) == 0u) { if (xb_ld(&bar[XB_TMO])) break; if (sp > XB_SPIN_CAP) { atomicAdd(&bar[XB_TMO], 1u); break; } }
    }
    nloc = mine > 0u ? mine : 1u; nx = cnt > 0u ? cnt : 1u;
}

__device__ __forceinline__ void xcd_barrier(const XcdBarrier& b) {
    asm volatile("s_waitcnt vmcnt(0)" ::: "memory");
    __syncthreads();
    if (threadIdx.x == 0) {
        unsigned* bar = b.bar;
        __builtin_amdgcn_s_waitcnt(0);
        unsigned nloc = b.st[0], nx = b.st[1];
        if (nloc == 0u) { xcd_barrier_complete(bar, b.x, nloc, nx); b.st[0] = nloc; b.st[1] = nx; }
        const unsigned old = xb_add(&bar[XB_XSUB(b.x)], 1u);
        const unsigned gen = old / nloc;
        if (old + 1u == (gen + 1u) * nloc) {
            __builtin_amdgcn_fence(__ATOMIC_RELEASE, "agent");
            asm volatile("s_waitcnt vmcnt(0)" ::: "memory");
            const unsigned og = xb_add(&bar[XB_TOP], 1u);
            const unsigned tg = og / nx;
            if (og + 1u == (tg + 1u) * nx) xb_add(&bar[XB_TOPGEN], 1u);
            else XB_SPIN(xb_ld(&bar[XB_TOPGEN]) == tg, bar);
            __builtin_amdgcn_fence(__ATOMIC_ACQUIRE, "agent");
            xb_add(&bar[XB_XGEN(b.x)], 1u);
            asm volatile("s_waitcnt vmcnt(0)" ::: "memory");
        } else {
            XB_SPIN(xb_ld(&bar[XB_XGEN(b.x)]) == gen, bar);
            __builtin_amdgcn_fence(__ATOMIC_ACQUIRE, "agent");
            asm volatile("s_waitcnt vmcnt(0)" ::: "memory");
        }
    }
    __syncthreads();
}

__device__ __forceinline__ bf16x8 tr_frag(LAS const unsigned char* img, int pitch, int k0, int n0, int lane) {
    const int g = lane >> 4, q = (lane & 15) >> 2, p = lane & 3;
    LAS const unsigned char* a = img + (k0 + 8 * g + q) * pitch + (n0 + 4 * p) * 2;
    const s16x4 lo = __builtin_bit_cast(s16x4, __builtin_amdgcn_ds_read_tr16_b64_v4i16((LAS s16x4*)a));
    const s16x4 hi = __builtin_bit_cast(s16x4, __builtin_amdgcn_ds_read_tr16_b64_v4i16((LAS s16x4*)(a + 4 * pitch)));
    return __builtin_shufflevector(lo, hi, 0, 1, 2, 3, 4, 5, 6, 7);
}
__device__ __forceinline__ bf16x8 pack_f8(const f32x4& a, const f32x4& b) { v4u w; w.x = pg8::cvt_pk_bf16(a[0], a[1]); w.y = pg8::cvt_pk_bf16(a[2], a[3]); w.z = pg8::cvt_pk_bf16(b[0], b[1]); w.w = pg8::cvt_pk_bf16(b[2], b[3]); return __builtin_bit_cast(bf16x8, w); }
__device__ __forceinline__ float wave_sum(float v) {
#pragma unroll
    for (int o = 1; o < 64; o <<= 1) v += __shfl_xor(v, o);
    return v;
}

struct Frame {
    LAS unsigned char* lds;
    int tid, lane, wave, G;
    const float *x, *norm_mix_w, *w_in, *ret_gn_w, *ret_proj, *sgu_ln_w, *sgu_ln_b, *sgu_w_s, *sgu_b_s, *sgu_proj, *w_out, *norm_ffn_w, *w_ffn_in, *w_ffn_out, *final_norm_w;
    float* out; unsigned char* ws;
};

__device__ __forceinline__ void p0_transpose_item(const float* W, int Nsrc, int K, bf16* WT, int mode, const float* kscale, float qs, LAS float* scr, int kb, int nb, int lane) {
    const int k0 = 64 * kb, n0 = 32 * nb, np = n0 + (lane & 31);
    int sc = np; float cs = 1.f;
    if (mode == 1) { if (np < 2048) { const int seg = np >> 10, hh = (np & 1023) >> 7, cp = np & 127; sc = seg * 1024 + hh * 128 + (cp >> 1) + 64 * (cp & 1); if (np < 1024) cs = qs; } }
    else if (mode == 2) { const int t = np >> 8, half = (np >> 7) & 1, i = np & 127; sc = half * DFF + 128 * t + i; }
#pragma unroll 8
    for (int i = 0; i < 32; ++i) { const int kk = 2 * i + (lane >> 5); float w = W[(size_t)(k0 + kk) * Nsrc + sc]; if (kscale) w *= kscale[k0 + kk]; scr[kk * 33 + (lane & 31)] = w * cs; }
    LDS_WAIT(); asm volatile("" ::: "memory");
    const int c = lane & 7;
#pragma unroll
    for (int j = 0; j < 4; ++j) { const int n = (lane >> 3) + 8 * j; const LAS float* s = scr + (8 * c) * 33 + n;
        v4u o; o.x = pk2(s[0 * 33], s[1 * 33]); o.y = pk2(s[2 * 33], s[3 * 33]); o.z = pk2(s[4 * 33], s[5 * 33]); o.w = pk2(s[6 * 33], s[7 * 33]);
        *(GAS v4u*)(WT + (size_t)(n0 + n) * K + k0 + 8 * c) = o; }
    LDS_WAIT(); asm volatile("" ::: "memory");
}
__device__ __forceinline__ void p0_prologue(Frame& F) {
    LAS float* scr = (LAS float*)(F.lds + RING_OFF + F.wave * 16384);
    const int gw = blockIdx.x * NWAVES + F.wave, NGW = F.G * NWAVES;
    constexpr int I_IN = 32 * (NIN / 32), I_SQ = 32 * 64, I_F1 = 32 * (NFF / 32), I_F2 = (DFF / 64) * 64, I_LAYER = I_IN + 3 * I_SQ + I_F1 + I_F2;
    for (int it = gw; it < DEPTH * I_LAYER; it += NGW) {
        const int l = it / I_LAYER; int r = it % I_LAYER;
        unsigned char* wl = F.ws + WS_W + (size_t)l * W_LAYER;
        if (r < I_IN) { p0_transpose_item(F.w_in + (size_t)l * D * NIN, NIN, D, (bf16*)(wl + W_IN), 1, F.norm_mix_w + l * D, 0.08838834764831845f, scr, r / (NIN / 32), r % (NIN / 32), F.lane); continue; } r -= I_IN;
        if (r < I_SQ) { p0_transpose_item(F.ret_proj + (size_t)l * D * D, D, D, (bf16*)(wl + W_R), 0, nullptr, 1.f, scr, r / 64, r % 64, F.lane); continue; } r -= I_SQ;
        if (r < I_SQ) { p0_transpose_item(F.sgu_proj + (size_t)l * D * D, D, D, (bf16*)(wl + W_S), 0, nullptr, 1.f, scr, r / 64, r % 64, F.lane); continue; } r -= I_SQ;
        if (r < I_SQ) { p0_transpose_item(F.w_out + (size_t)l * D * D, D, D, (bf16*)(wl + W_O), 0, nullptr, 1.f, scr, r / 64, r % 64, F.lane); continue; } r -= I_SQ;
        if (r < I_F1) { p0_transpose_item(F.w_ffn_in + (size_t)l * D * NFF, NFF, D, (bf16*)(wl + W_F1), 2, F.norm_ffn_w + l * D, 1.f, scr, r / (NFF / 32), r % (NFF / 32), F.lane); continue; } r -= I_F1;
        p0_transpose_item(F.w_ffn_out + (size_t)l * DFF * D, D, DFF, (bf16*)(wl + W_F2), 0, nullptr, 1.f, scr, r / 64, r % 64, F.lane);
    }
    float* X = (float*)(F.ws + WS_X); bf16* XB = (bf16*)(F.ws + WS_XB); float* SS = (float*)(F.ws + WS_SS);
    for (int m = gw; m < M; m += NGW) {
        const GAS f32x4* xr = (const GAS f32x4*)(F.x + (size_t)m * D) + F.lane; GAS f32x4* xo = (GAS f32x4*)(X + (size_t)m * D) + F.lane; GAS v2u* bo = (GAS v2u*)(XB + (size_t)m * D) + F.lane;
        float s = 0.f;
#pragma unroll
        for (int j = 0; j < 8; ++j) { const f32x4 v = xr[64 * j]; s += (v[0] * v[0] + v[1] * v[1]) + (v[2] * v[2] + v[3] * v[3]); xo[64 * j] = v; v2u w; w.x = pk2(v[0], v[1]); w.y = pk2(v[2], v[3]); bo[64 * j] = w; }
        s = wave_sum(s);
        if (F.lane < 32) SS[(size_t)m * 32 + F.lane] = (F.lane == 0) ? s : 0.f;
    }
    float* rope = (float*)(F.ws + WS_ROPE);
    for (int t = blockIdx.x * (NWAVES * 64) + F.tid; t < T * 64; t += F.G * NWAVES * 64) {
        const int pos = t >> 6, i = t & 63; const float inv = powf(10000.0f, -(float)i * (1.0f / 64.0f)); const float ang = (float)pos * inv;
        float sn, cs; sincosf(ang, &sn, &cs); rope[2 * t] = cs; rope[2 * t + 1] = sn;
    }
}

template <bool P2> __device__ __forceinline__ void ret_unit(Frame& F, int u, int layer) {
    LAS unsigned char* lds = F.lds + RING_OFF;
    const int tid = F.tid, w = F.wave, lane_u = F.lane;
    int lane = lane_u, g = lane >> 4, c16 = lane & 15;
    const int bh = u >> 4, seg = u & 15, b = bh >> 3, h = bh & 7;
    const size_t tb = (size_t)b * T + (size_t)seg * 512;
    const float l2g = l2gamma(h);
    const float cdec = ex2(l2g * 64.0f);
    const bf16* Qg = (const bf16*)(F.ws + WS_Q); const bf16* Kg = (const bf16*)(F.ws + WS_K); const bf16* Vg = (const bf16*)(F.ws + WS_V); const bf16* SGg = (const bf16*)(F.ws + WS_SG);
    bf16* RA = (bf16*)(F.ws + WS_RA);
    float* sp = (float*)(F.ws + WS_SLOC) + (size_t)(bh * 16 + seg) * (128 * 256);
    const float* gnw = F.ret_gn_w + (size_t)layer * 2048 + h * 256;
    f32x4 st[8][2];
    { int so = (4 * g) * 256 + 32 * w + c16;
#pragma unroll
      for (int dt = 0; dt < 8; ++dt) {
        asm volatile("" : "+v"(so));
        const GAS float* spl = (const GAS float*)sp + so;
#pragma unroll
        for (int et = 0; et < 2; ++et) {
            if (P2) {
#pragma unroll
                for (int r = 0; r < 4; ++r) st[dt][et][r] = spl[r * 256 + 16 * et]; }
            else st[dt][et] = (f32x4){0.f, 0.f, 0.f, 0.f}; }
        so += 16 * 256; } }
    const float l2g_u = l2g;
    for (int cc = 0; cc < 8; ++cc) {
        const size_t r0 = tb + (size_t)cc * 64;
        float l2g = l2g_u; asm volatile("" : "+v"(l2g));
        lane = lane_u; asm volatile("" : "+v"(lane)); g = lane >> 4; c16 = lane & 15;
#pragma unroll
        for (int i = 0; i < 2; ++i) { const int ch = tid + 512 * i, row = ch >> 4, c8 = ch & 15;
            if (P2) { const v4u qv = *(const GAS v4u*)(Qg + (r0 + row) * 1024 + h * 128 + c8 * 8); *(LAS v4u*)(lds + R_Q + row * PQ + c8 * 16) = qv; }
            const v4u kv = *(const GAS v4u*)(Kg + (r0 + row) * 1024 + h * 128 + c8 * 8);
            if (P2) *(LAS v4u*)(lds + R_K + row * PQ + c8 * 16) = kv;
            const float kd = ex2(l2g * (float)(63 - row));
            v4u ks; ks.x = pk2(blo(kv.x) * kd, bhi(kv.x) * kd); ks.y = pk2(blo(kv.y) * kd, bhi(kv.y) * kd); ks.z = pk2(blo(kv.z) * kd, bhi(kv.z) * kd); ks.w = pk2(blo(kv.w) * kd, bhi(kv.w) * kd);
            *(LAS v4u*)(lds + R_KS + row * PQ + c8 * 16) = ks; }
#pragma unroll
        for (int i = 0; i < 4; ++i) { const int ch = tid + 512 * i, row = ch >> 5, c8 = ch & 31;
            const v4u vv = *(const GAS v4u*)(Vg + (r0 + row) * 2048 + h * 256 + c8 * 8); *(LAS v4u*)(lds + R_V + row * PV + c8 * 16) = vv; }
        __syncthreads();
        f32x4 o[2][4];
        if (P2) {
#pragma unroll
            for (int tt = 0; tt < 2; ++tt) { const int t16 = 2 * w + tt, jt = t16 >> 2, it = t16 & 3; f32x4 a = (f32x4){0.f, 0.f, 0.f, 0.f};
#pragma unroll
                for (int ks = 0; ks < 4; ++ks) { const bf16x8 A = *(const LAS bf16x8*)(lds + R_K + (16 * jt + c16) * PQ + (32 * ks + 8 * g) * 2); const bf16x8 B = *(const LAS bf16x8*)(lds + R_Q + (16 * it + c16) * PQ + (32 * ks + 8 * g) * 2);
                    a = MFMA16(A, B, a); }
                const int ii = 16 * it + c16;
#pragma unroll
                for (int r = 0; r < 4; ++r) { const int jj = 16 * jt + 4 * g + r; a[r] *= ex2(l2g * fabsf((float)(ii - jj))); }
                v2u pw; pw.x = pg8::cvt_pk_bf16(a[0], a[1]); pw.y = pg8::cvt_pk_bf16(a[2], a[3]);
                *(LAS v2u*)(lds + R_P + ii * PP + (16 * jt + 4 * g) * 2) = pw; }
            __syncthreads();
#pragma unroll
            for (int et = 0; et < 2; ++et)
#pragma unroll
                for (int it = 0; it < 4; ++it) o[et][it] = (f32x4){0.f, 0.f, 0.f, 0.f};
#pragma unroll
            for (int ks = 0; ks < 4; ++ks) { bf16x8 A[2];
#pragma unroll
                for (int et = 0; et < 2; ++et) A[et] = pack_f8(st[2 * ks][et], st[2 * ks + 1][et]);
#pragma unroll
                for (int it = 0; it < 4; ++it) { LAS const unsigned char* qp = lds + R_Q + (16 * it + c16) * PQ + (32 * ks + 4 * g) * 2;
                    const s16x4 lo = *(const LAS s16x4*)qp, hi = *(const LAS s16x4*)(qp + 32); const bf16x8 B = __builtin_shufflevector(lo, hi, 0, 1, 2, 3, 4, 5, 6, 7);
#pragma unroll
                    for (int et = 0; et < 2; ++et) o[et][it] = MFMA16(A[et], B, o[et][it]); }
                __builtin_amdgcn_sched_barrier(0); }
#pragma unroll
            for (int it = 0; it < 4; ++it) { const float qd = ex2(l2g * (float)(16 * it + c16 + 1));
#pragma unroll
                for (int et = 0; et < 2; ++et) o[et][it] *= qd; }
        }
        bf16x8 vf[2][2];
#pragma unroll
        for (int ks2 = 0; ks2 < 2; ++ks2)
#pragma unroll
            for (int et = 0; et < 2; ++et) vf[ks2][et] = tr_frag(lds + R_V, PV, 32 * ks2, 32 * w + 16 * et, lane);
        if (P2) {
#pragma unroll
            for (int ks2 = 0; ks2 < 2; ++ks2)
#pragma unroll
                for (int it = 0; it < 4; ++it) { const bf16x8 B = *(const LAS bf16x8*)(lds + R_P + (16 * it + c16) * PP + (32 * ks2 + 8 * g) * 2);
#pragma unroll
                    for (int et = 0; et < 2; ++et) o[et][it] = MFMA16(vf[ks2][et], B, o[et][it]); __builtin_amdgcn_sched_barrier(0); }
        }
#pragma unroll
        for (int dt = 0; dt < 8; ++dt)
#pragma unroll
            for (int et = 0; et < 2; ++et) st[dt][et] *= cdec;
#pragma unroll
        for (int ks2 = 0; ks2 < 2; ++ks2)
#pragma unroll
            for (int dt = 0; dt < 8; ++dt) { const bf16x8 A = tr_frag(lds + R_KS, PQ, 32 * ks2, 16 * dt, lane);
#pragma unroll
                for (int et = 0; et < 2; ++et) st[dt][et] = MFMA16(A, vf[ks2][et], st[dt][et]); __builtin_amdgcn_sched_barrier(0); }
        if (P2) {
            LAS f32x2* red = (LAS f32x2*)(lds + R_RED);
#pragma unroll
            for (int it = 0; it < 4; ++it) { float s1 = 0.f, s2 = 0.f;
#pragma unroll
                for (int et = 0; et < 2; ++et)
#pragma unroll
                    for (int r = 0; r < 4; ++r) { const float v = o[et][it][r]; s1 += v; s2 += v * v; }
                s1 += __shfl_xor(s1, 16); s1 += __shfl_xor(s1, 32); s2 += __shfl_xor(s2, 16); s2 += __shfl_xor(s2, 32);
                if (g == 0) red[w * 64 + 16 * it + c16] = (f32x2){s1, s2}; }
            __syncthreads();
#pragma unroll
            for (int it = 0; it < 4; ++it) { const int ii = 16 * it + c16; float S1 = 0.f, S2 = 0.f;
#pragma unroll
                for (int w8 = 0; w8 < 8; ++w8) { const f32x2 t = red[w8 * 64 + ii]; S1 += t.x; S2 += t.y; }
                const float mu = S1 * (1.0f / 256.0f), var = fmaxf(S2 * (1.0f / 256.0f) - mu * mu, 0.f), rstd = 1.0f / sqrtf(var + EPS);
#pragma unroll
                for (int et = 0; et < 2; ++et) { const int col = h * 256 + 32 * w + 16 * et + 4 * g; const f32x4 gw4 = *(const f32x4*)(gnw + 32 * w + 16 * et + 4 * g);
                    const size_t off = (r0 + ii) * 2048 + col; const v2u sg = *(const GAS v2u*)(SGg + off);
                    const float y0 = (o[et][it][0] - mu) * rstd * gw4[0] * blo(sg.x), y1 = (o[et][it][1] - mu) * rstd * gw4[1] * bhi(sg.x), y2 = (o[et][it][2] - mu) * rstd * gw4[2] * blo(sg.y), y3 = (o[et][it][3] - mu) * rstd * gw4[3] * bhi(sg.y);
                    v2u ow; ow.x = pg8::cvt_pk_bf16(y0, y1); ow.y = pg8::cvt_pk_bf16(y2, y3); *(GAS v2u*)(RA + off) = ow; } }
        }
        __syncthreads();
    }
#if !defined(SKIP_R1_STORE)
    if (!P2) {
        int so = (4 * g) * 256 + 32 * w + c16;
#pragma unroll
        for (int dt = 0; dt < 8; ++dt) {
            asm volatile("" : "+v"(so));
            GAS float* spl = (GAS float*)sp + so;
#pragma unroll
            for (int et = 0; et < 2; ++et)
#pragma unroll
                for (int r = 0; r < 4; ++r) spl[r * 256 + 16 * et] = st[dt][et][r];
            so += 16 * 256; }
    }
#else
    if (!P2) { float acc_ = 0.f;
#pragma unroll
        for (int dt = 0; dt < 8; ++dt)
#pragma unroll
            for (int et = 0; et < 2; ++et)
#pragma unroll
                for (int r = 0; r < 4; ++r) acc_ += st[dt][et][r];
        if (acc_ == 123.456f) sp[0] = acc_; }
#endif
}
__device__ __forceinline__ void ret_scan(Frame& F) {
    float* sl = (float*)(F.ws + WS_SLOC);
    for (int idx = blockIdx.x * (NWAVES * 64) + F.tid; idx < 16 * 8192; idx += F.G * NWAVES * 64) {
        const int bh = idx >> 13, e4 = idx & 8191, h = bh & 7;
        const float l2g = l2gamma(h); const float cd8 = ex2(l2g * 512.0f);
        f32x4 carry = (f32x4){0.f, 0.f, 0.f, 0.f};
        for (int seg = 0; seg < 16; ++seg) { GAS f32x4* p = (GAS f32x4*)(sl + (size_t)(bh * 16 + seg) * 32768) + e4; const f32x4 t = *p; *p = carry; carry = carry * cd8 + t; }
    }
}

__device__ __forceinline__ void sgu_unit(Frame& F, int u, int layer) {
    LAS unsigned char* lds = F.lds + RING_OFF;
    const int tid = F.tid, lane = F.lane, w = F.wave, g = lane >> 4, c16 = lane & 15;
    const int cg = u & 7, rg = u >> 3; const size_t r0 = (size_t)rg * 128; const int ch0 = 256 * cg;
    const bf16* ZU = (const bf16*)(F.ws + WS_ZU); const bf16* ZV = (const bf16*)(F.ws + WS_ZV); bf16* SB = (bf16*)(F.ws + WS_SB);
    const float* LS = (const float*)(F.ws + WS_LS);
    const float* lnw = F.sgu_ln_w + (size_t)layer * 2048 + ch0; const float* lnb = F.sgu_ln_b + (size_t)layer * 2048 + ch0;
    const float* wsrc = F.sgu_w_s + ((size_t)layer * 8 + cg) * (128 * 128); const float* bs = F.sgu_b_s + ((size_t)layer * 8 + cg) * 128;
    LAS f32x2* stt = (LAS f32x2*)(lds + S_ST);
    if (tid < 128) { const GAS f32x4* p = (const GAS f32x4*)(LS + (r0 + tid) * 64); float S1 = 0.f, S2 = 0.f;
#pragma unroll
        for (int i = 0; i < 16; ++i) { const f32x4 t = p[i]; S1 += t[0] + t[2]; S2 += t[1] + t[3]; }
        const float mu = S1 * (1.0f / 2048.0f), var = fmaxf(S2 * (1.0f / 2048.0f) - mu * mu, 0.f); stt[tid] = (f32x2){mu, 1.0f / sqrtf(var + EPS)}; }
#pragma unroll
    for (int i = 0; i < 8; ++i) { const int idx4 = tid + 512 * i, ir = idx4 >> 5, j4 = (idx4 & 31) * 4; f32x4 wv = *(const GAS f32x4*)(wsrc + ir * 128 + j4);
        if ((j4 >> 6) > (ir >> 6)) wv = (f32x4){0.f, 0.f, 0.f, 0.f};
        v2u pw; pw.x = pk2(wv[0], wv[1]); pw.y = pk2(wv[2], wv[3]); *(LAS v2u*)(lds + S_W + ir * PQ + j4 * 2) = pw; }
    __syncthreads();
#pragma unroll
    for (int i = 0; i < 8; ++i) { const int ch = tid + 512 * i, j = ch >> 5, c8 = ch & 31;
        const v4u zv = *(const GAS v4u*)(ZV + (r0 + j) * 2048 + ch0 + 8 * c8); const f32x4 w0 = *(const f32x4*)(lnw + 8 * c8), w1 = *(const f32x4*)(lnw + 8 * c8 + 4), b0 = *(const f32x4*)(lnb + 8 * c8), b1 = *(const f32x4*)(lnb + 8 * c8 + 4);
        const f32x2 ms = stt[j]; const float mu = ms.x, rs = ms.y;
        v4u o; o.x = pk2((blo(zv.x) - mu) * rs * w0[0] + b0[0], (bhi(zv.x) - mu) * rs * w0[1] + b0[1]); o.y = pk2((blo(zv.y) - mu) * rs * w0[2] + b0[2], (bhi(zv.y) - mu) * rs * w0[3] + b0[3]);
        o.z = pk2((blo(zv.z) - mu) * rs * w1[0] + b1[0], (bhi(zv.z) - mu) * rs * w1[1] + b1[1]); o.w = pk2((blo(zv.w) - mu) * rs * w1[2] + b1[2], (bhi(zv.w) - mu) * rs * w1[3] + b1[3]);
        *(LAS v4u*)(lds + S_VN + j * PV + c8 * 16) = o; }
    __syncthreads();
    f32x4 acc[2][8];
#pragma unroll
    for (int ct = 0; ct < 2; ++ct)
#pragma unroll
        for (int it = 0; it < 8; ++it) acc[ct][it] = (f32x4){0.f, 0.f, 0.f, 0.f};
#pragma unroll
    for (int ks = 0; ks < 4; ++ks) { bf16x8 A[2];
#pragma unroll
        for (int ct = 0; ct < 2; ++ct) A[ct] = tr_frag(lds + S_VN, PV, 32 * ks, 32 * w + 16 * ct, lane);
#pragma unroll
        for (int it = 0; it < 8; ++it) { if (it < 4 && ks >= 2) continue;
            const bf16x8 B = *(const LAS bf16x8*)(lds + S_W + (16 * it + c16) * PQ + (32 * ks + 8 * g) * 2);
#pragma unroll
            for (int ct = 0; ct < 2; ++ct) acc[ct][it] = MFMA16(A[ct], B, acc[ct][it]); __builtin_amdgcn_sched_barrier(0); } }
#pragma unroll
    for (int it = 0; it < 8; ++it) { const int ii = 16 * it + c16; const float bsv = bs[ii];
#pragma unroll
        for (int ct = 0; ct < 2; ++ct) { const size_t off = (r0 + ii) * 2048 + ch0 + 32 * w + 16 * ct + 4 * g; const v2u zu = *(const GAS v2u*)(ZU + off);
            v2u ow; ow.x = pg8::cvt_pk_bf16(blo(zu.x) * (acc[ct][it][0] + bsv), bhi(zu.x) * (acc[ct][it][1] + bsv)); ow.y = pg8::cvt_pk_bf16(blo(zu.y) * (acc[ct][it][2] + bsv), bhi(zu.y) * (acc[ct][it][3] + bsv));
            *(GAS v2u*)(SB + off) = ow; } }
    __syncthreads();
}

__device__ __forceinline__ void final_norm(Frame& F) {
    const int gw = blockIdx.x * NWAVES + F.wave, NGW = F.G * NWAVES;
    const float* X = (const float*)(F.ws + WS_X); const float* SS = (const float*)(F.ws + WS_SS);
    for (int m = gw; m < M; m += NGW) {
        const float s = wave_sum(F.lane < 32 ? SS[(size_t)m * 32 + F.lane] : 0.f); const float rstd = 1.0f / sqrtf(s * (1.0f / 2048.0f) + EPS);
        const GAS f32x4* xr = (const GAS f32x4*)(X + (size_t)m * D) + F.lane; const GAS f32x4* fw = (const GAS f32x4*)F.final_norm_w + F.lane; GAS f32x4* o = (GAS f32x4*)(F.out + (size_t)m * D) + F.lane;
#pragma unroll
        for (int j = 0; j < 8; ++j) o[64 * j] = xr[64 * j] * rstd * fw[64 * j];
    }
}

#if defined(PROBE_STOP)
__device__ __forceinline__ void probe_dump(Frame& F) {
    const size_t offs[12] = {WS_V, WS_SG, WS_ZU, WS_ZV, WS_GA, WS_GB, WS_RA, WS_SB, WS_MG, WS_XB, WS_P, 0};
    for (size_t i = (size_t)blockIdx.x * 512 + F.tid; i < (size_t)M * D; i += (size_t)F.G * 512) {
        float a = 0.f; const size_t m = i >> 11, c = i & 2047;
#pragma unroll
        for (int b = 0; b < 11; ++b) if (PROBE_MASK & (1 << b)) a += blo((unsigned)((const bf16*)(F.ws + offs[b]))[i]);
        if (PROBE_MASK & (1 << 11)) { if (c < 1024) a += blo((unsigned)((const bf16*)(F.ws + WS_Q))[m * 1024 + c]) + blo((unsigned)((const bf16*)(F.ws + WS_K))[m * 1024 + c]); }
        if (PROBE_MASK & (1 << 12)) a += blo((unsigned)((const bf16*)(F.ws + WS_H))[m * 5632 + c]) + blo((unsigned)((const bf16*)(F.ws + WS_H))[m * 5632 + 2048 + c]) + ((c < 1536) ? blo((unsigned)((const bf16*)(F.ws + WS_H))[m * 5632 + 4096 + c]) : 0.f);
        if (PROBE_MASK & (1 << 13)) { if (i < (size_t)D * D) a += blo((unsigned)((const bf16*)(F.ws + WS_W + W_R))[i]); }
        if (PROBE_MASK & (1 << 14)) { if (i < (size_t)D * D) a += blo((unsigned)((const bf16*)(F.ws + WS_W + W_S))[i]) + blo((unsigned)((const bf16*)(F.ws + WS_W + W_O))[i]); }
        if (PROBE_MASK & (1 << 15)) a += ((const float*)(F.ws + WS_X))[i];
        F.out[i] = a;
    }
}
#endif
constexpr int PH_PER_LAYER = 8, NPHASES = 2 + DEPTH * PH_PER_LAYER;
struct Args { const float* in[15]; float* out; unsigned char* ws; int ph_lo, ph_hi; };
static_assert(sizeof(Args) == 15 * 8 + 8 + 8 + 8, "Args has no padding");
__global__ void __launch_bounds__(NWAVES * 64, 2) mk_fwd(Args args) {
    extern __shared__ __attribute__((aligned(16))) unsigned char lds_raw[];
    Frame F;
    F.lds = (LAS unsigned char*)lds_raw;
    F.tid = threadIdx.x; F.lane = F.tid & 63; F.wave = __builtin_amdgcn_readfirstlane(F.tid >> 6); F.G = gridDim.x;
    F.x = args.in[0]; F.norm_mix_w = args.in[1]; F.w_in = args.in[2]; F.ret_gn_w = args.in[3]; F.ret_proj = args.in[4]; F.sgu_ln_w = args.in[5]; F.sgu_ln_b = args.in[6]; F.sgu_w_s = args.in[7];
    F.sgu_b_s = args.in[8]; F.sgu_proj = args.in[9]; F.w_out = args.in[10]; F.norm_ffn_w = args.in[11]; F.w_ffn_in = args.in[12]; F.w_ffn_out = args.in[13]; F.final_norm_w = args.in[14];
    F.out = args.out; F.ws = args.ws;
#if defined(ZERO_LDS)
    for (int u = F.tid; u < LDS_BYTES / 4; u += NWAVES * 64) ((LAS unsigned*)(F.lds))[u] = 0u;
#else
    for (int u = F.tid; u < (LDS_BYTES - LDSCTL_OFF) / 4; u += NWAVES * 64) ((LAS unsigned*)(F.lds + LDSCTL_OFF))[u] = 0u;
#endif
    __syncthreads();
    const int lo = args.ph_lo, hi = args.ph_hi;
    unsigned* ctl = (unsigned*)(F.ws + WS_CTL);
    XcdBarrier bar; bar.bar = ctl + CW_BAR; bar.x = 0; bar.st = nullptr;
    if (hi - lo > 1) bar = xcd_barrier_post(ctl + CW_BAR, (volatile LAS unsigned*)(F.lds + MISC_OFF) + 8);
#ifndef MK_ONLY
#define MK_ONLY -1
#endif
#if defined(PROBE_STOP)
#define IN(k) (lo <= (k) && (k) < hi && ((k) <= PROBE_STOP || (k) == NPHASES - 1))
#else
#define IN(k) (lo <= (k) && (k) < hi)
#endif
#define INP(slot, k) ((MK_ONLY < 0 || MK_ONLY == (slot)) && IN(k))
#define SEAM(k) do { if (IN(k) && IN((k) + 1)) xcd_barrier(bar); } while (0)
    size_t zero_o = 0; int tid_o = threadIdx.x;
#define FRESH() do { asm volatile("" : "+s"(zero_o)); asm volatile("" : "+v"(tid_o)); F.ws = args.ws + zero_o; F.tid = tid_o; F.lane = tid_o & 63; F.wave = __builtin_amdgcn_readfirstlane(tid_o >> 6); } while (0)
#if defined(START_DELAY)
    if (IN(0)) { const unsigned long long t0 = wall_clock64(); while (wall_clock64() - t0 < 100ull * START_DELAY) __builtin_amdgcn_s_sleep(32); }
#endif
    if (INP(0, 0)) { FRESH(); p0_prologue(F); }
    SEAM(0);
    for (int l = 0; l < DEPTH; ++l) {
        const int pb = 1 + PH_PER_LAYER * l;
        if (INP(1, pb + 0)) { FRESH(); unsigned char* wl = F.ws + WS_W + (size_t)l * W_LAYER;
            pg8::Gemm gm{(const pg8::bf16_t*)(F.ws + WS_XB), (const pg8::bf16_t*)(wl + W_IN), M, NIN, D}; pg8::StaticOrder S; S.init(M, NIN, F.G, (int)blockIdx.x);
            pg8::EpiIn E{(const float*)(F.ws + WS_SS), (const float*)(F.ws + WS_ROPE), (pg8::bf16_t*)(F.ws + WS_Q), (pg8::bf16_t*)(F.ws + WS_K), (pg8::bf16_t*)(F.ws + WS_O2048), (float*)(F.ws + WS_LS)};
            pg8::gemm_phase<pg8::EpiIn, pg8::StaticOrder, true, true>(F.lds + RING_OFF, gm, S, E, F.tid);
        }
        SEAM(pb + 0);
        if (INP(2, pb + 1)) { FRESH();
#if !defined(SKIP_R1)
            for (int u = blockIdx.x; u < 256; u += F.G) ret_unit<false>(F, u, l);
#endif
#if defined(SLEEP_R1)
            { const unsigned long long t0 = wall_clock64(); while (wall_clock64() - t0 < 100ull * SLEEP_R1) __builtin_amdgcn_s_sleep(32); }
#endif
#if defined(DUMMY_R1)
            { const GAS v4u* src = (const GAS v4u*)(F.ws + WS_K); unsigned a_ = 0;
              for (size_t i = (size_t)blockIdx.x * 512 + F.tid; i < (size_t)96 * MiB / 16; i += (size_t)F.G * 512) { const v4u t = src[i]; a_ += t.x ^ t.y ^ t.z ^ t.w; }
              if (a_ == 0x12345678u) ((float*)(F.ws + WS_SLOC))[0] = 1.f; }
#endif
            FRESH();
#if !defined(SKIP_SGU)
            for (int u = blockIdx.x; u < 1024; u += F.G) sgu_unit(F, u, l);
#endif
        }
        SEAM(pb + 1);
        if (INP(3, pb + 2)) { FRESH(); ret_scan(F); }
        SEAM(pb + 2);
        if (INP(4, pb + 3)) { FRESH(); for (int u = blockIdx.x; u < 256; u += F.G) ret_unit<true>(F, u, l); }
        SEAM(pb + 3);
        if (INP(5, pb + 4)) { FRESH(); unsigned char* wl = F.ws + WS_W + (size_t)l * W_LAYER;
#if defined(G2_TEST) && G2_TEST == 1
            { pg8::Gemm gm{(const pg8::bf16_t*)(F.ws + WS_XB), (const pg8::bf16_t*)(wl + W_R), M, D, D}; pg8::StaticOrder S; S.init(M, D, F.G, (int)blockIdx.x);
#else
            { pg8::Gemm gm{(const pg8::bf16_t*)(F.ws + WS_RA), (const pg8::bf16_t*)(wl + W_R), M, D, D}; pg8::StaticOrder S; S.init(M, D, F.G, (int)blockIdx.x);
#endif
              pg8::EpiMerge<false> E{(const pg8::bf16_t*)(F.ws + WS_GA), (pg8::bf16_t*)(F.ws + WS_P), (pg8::bf16_t*)(F.ws + WS_MG)};
              pg8::gemm_phase<pg8::EpiMerge<false>, pg8::StaticOrder, true, true>(F.lds + RING_OFF, gm, S, E, F.tid); }
            asm volatile("s_waitcnt vmcnt(0)" ::: "memory");
            { pg8::Gemm gm{(const pg8::bf16_t*)(F.ws + WS_SB), (const pg8::bf16_t*)(wl + W_S), M, D, D}; pg8::StaticOrder S; S.init(M, D, F.G, (int)blockIdx.x);
              pg8::EpiMerge<true> E{(const pg8::bf16_t*)(F.ws + WS_GB), (pg8::bf16_t*)(F.ws + WS_P), (pg8::bf16_t*)(F.ws + WS_MG)};
              pg8::gemm_phase<pg8::EpiMerge<true>, pg8::StaticOrder, true, true>(F.lds + RING_OFF, gm, S, E, F.tid); }
        }
        SEAM(pb + 4);
        if (INP(6, pb + 5)) { FRESH(); unsigned char* wl = F.ws + WS_W + (size_t)l * W_LAYER;
            pg8::Gemm gm{(const pg8::bf16_t*)(F.ws + WS_MG), (const pg8::bf16_t*)(wl + W_O), M, D, D}; pg8::StaticOrder S; S.init(M, D, F.G, (int)blockIdx.x);
            pg8::EpiResid E{(float*)(F.ws + WS_X), (pg8::bf16_t*)(F.ws + WS_XB), (float*)(F.ws + WS_SS2)};
            pg8::gemm_phase<pg8::EpiResid, pg8::StaticOrder, true, true>(F.lds + RING_OFF, gm, S, E, F.tid);
        }
        SEAM(pb + 5);
        if (INP(7, pb + 6)) { FRESH(); unsigned char* wl = F.ws + WS_W + (size_t)l * W_LAYER;
            pg8::Gemm gm{(const pg8::bf16_t*)(F.ws + WS_XB), (const pg8::bf16_t*)(wl + W_F1), M, NFF, D}; pg8::StaticOrder S; S.init(M, NFF, F.G, (int)blockIdx.x);
            pg8::EpiSwiglu E{(const float*)(F.ws + WS_SS2), (pg8::bf16_t*)(F.ws + WS_H)};
            pg8::gemm_phase<pg8::EpiSwiglu, pg8::StaticOrder, true, true>(F.lds + RING_OFF, gm, S, E, F.tid);
        }
        SEAM(pb + 6);
        if (INP(8, pb + 7)) { FRESH(); unsigned char* wl = F.ws + WS_W + (size_t)l * W_LAYER;
            pg8::Gemm gm{(const pg8::bf16_t*)(F.ws + WS_H), (const pg8::bf16_t*)(wl + W_F2), M, D, DFF}; pg8::StaticOrder S; S.init(M, D, F.G, (int)blockIdx.x);
            pg8::EpiResid E{(float*)(F.ws + WS_X), (pg8::bf16_t*)(F.ws + WS_XB), (float*)(F.ws + WS_SS)};
            pg8::gemm_phase<pg8::EpiResid, pg8::StaticOrder, true, true>(F.lds + RING_OFF, gm, S, E, F.tid);
        }
        SEAM(pb + 7);
    }
#if defined(END_WB)
    asm volatile("s_waitcnt vmcnt(0)" ::: "memory"); __builtin_amdgcn_fence(__ATOMIC_RELEASE, "agent"); asm volatile("s_waitcnt vmcnt(0)" ::: "memory");
#endif
#if defined(PROBE_STOP)
    if (hi - lo > 1) xcd_barrier(bar);
    if (IN(NPHASES - 1)) { FRESH(); probe_dump(F); }
#else
    if (INP(9, NPHASES - 1)) { FRESH(); final_norm(F); }
#endif
#undef IN
#undef INP
#undef FRESH
#undef SEAM
}

extern "C" void kernel_launch(void* const* d_in, const int* in_sizes, int n_in, void* d_out, int out_size, void* d_ws, size_t ws_size, hipStream_t stream) {
    static int grid = 0;
    if (grid == 0) {
        if (n_in != 15 || in_sizes[0] != M * D || out_size != M * D || ws_size < WS_END) { fprintf(stderr, "kernel_launch: unexpected sizes (n_in %d, in0 %d, out %d, ws %zu < %zu?)\n", n_in, n_in > 0 ? in_sizes[0] : -1, out_size, ws_size, (size_t)WS_END); grid = -1; return; }
        int dev = 0, cus = 0, per_cu = 0;
        if (hipGetDevice(&dev) != hipSuccess || hipDeviceGetAttribute(&cus, hipDeviceAttributeMultiprocessorCount, dev) != hipSuccess) { grid = -1; return; }
        if (hipFuncSetAttribute((const void*)mk_fwd, hipFuncAttributeMaxDynamicSharedMemorySize, LDS_BYTES) != hipSuccess) { fprintf(stderr, "kernel_launch: hipFuncSetAttribute failed\n"); grid = -1; return; }
        if (hipOccupancyMaxActiveBlocksPerMultiprocessor(&per_cu, (const void*)mk_fwd, NWAVES * 64, LDS_BYTES) != hipSuccess || per_cu < 1) fprintf(stderr, "kernel_launch: occupancy query reports %d\n", per_cu);
        (void)hipGetLastError();
        grid = cus;
    }
    if (grid < 0) return;
    if (hipMemsetAsync((char*)d_ws + WS_CTL, 0, CTL_ZERO_BYTES, stream) != hipSuccess) return;
    Args a{};
    for (int i = 0; i < 15; ++i) a.in[i] = (const float*)d_in[i];
    a.out = (float*)d_out; a.ws = (unsigned char*)d_ws;
#if MK_PER_PHASE
    for (int p = 0; p < NPHASES; ++p) { a.ph_lo = p; a.ph_hi = p + 1; hipLaunchKernelGGL(mk_fwd, dim3(grid), dim3(NWAVES * 64), LDS_BYTES, stream, a); }
#else
    a.ph_lo = 0; a.ph_hi = NPHASES; hipLaunchKernelGGL(mk_fwd, dim3(grid), dim3(NWAVES * 64), LDS_BYTES, stream, a);
#endif
}
```

```cpp
#define G1_REV 1
#define G4_REV 1
#define CONV_BLK24 1
#include <hip/hip_runtime.h>
#include <cstdio>
#include <cstdint>
namespace pg8 {
#define PG8_LAS __attribute__((address_space(3)))
typedef unsigned short bf16_t;
typedef short bf16x8 __attribute__((ext_vector_type(8)));
typedef float f32x4 __attribute__((ext_vector_type(4)));
typedef float f32x16 __attribute__((ext_vector_type(16)));
typedef unsigned u32x4 __attribute__((ext_vector_type(4)));
constexpr int BM = 256, BK = 64, HALF = 128, HTB = HALF * BK * 2  , STAGE_BYTES = 8 * HTB, NXCD = 8, WGM = 8;

__host__ __device__ __forceinline__ int lds_byte(int r, int c) { const int st = (r >> 4) * 2 + (c >> 5), rr = r & 15, cc = c & 31, ob = rr * 64 + cc * 2; return st * 1024 + (ob ^ (((ob >> 9) & 1) << 5)); }
__host__ __device__ __forceinline__ void stage_rc(int b, int& R, int& C) { const int st = b / 1024, sb = b % 1024, swz = sb ^ (((sb >> 9) & 1) << 5); R = (st >> 1) * 16 + swz / 64; C = (st & 1) * 32 + (swz % 64) / 2; }
__host__ __device__ __forceinline__ int perm32(int rho) { const int n = rho >> 4, i = rho & 15; return 8 * (i >> 2) + 4 * n + (i & 3); }

struct Unit { int pm, pn; };
struct Gemm { const bf16_t* A; const bf16_t* Bt; int M, N, K; };

struct StaticOrder {
    int nM, nN, nwg, G, c;
    __host__ __device__ __forceinline__ void init(int M, int N, int G_, int c_) { nM = M / BM; nN = N / BM; nwg = nM * nN; G = G_; c = c_; }
    __host__ __device__ __forceinline__ bool next(int i, Unit& u) const {
        const long L = (long)i * G + c; if (L >= nwg) return false;
        int wgid = (int)L; { const int q = nwg / NXCD, r = nwg % NXCD, xcd = wgid % NXCD, off = wgid / NXCD; wgid = (xcd < r ? xcd * (q + 1) : r * (q + 1) + (xcd - r) * q) + off; }
        const int nig = WGM * nN, gid = wgid / nig, fm = gid * WGM, gsz = (nM - fm) < WGM ? (nM - fm) : WGM;
        u.pm = fm + ((wgid % nig) % gsz); u.pn = (wgid % nig) / gsz; return true;
    }
    __device__ __forceinline__ void a_ready(const Unit&) const {}
    __device__ __forceinline__ void done(const Unit&) const {}
};

typedef float f32x2c_t __attribute__((ext_vector_type(2))); typedef __bf16 bf16x2c_t __attribute__((ext_vector_type(2)));
__device__ __forceinline__ unsigned cvt_pk_bf16(float lo, float hi) { const f32x2c_t v = {lo, hi}; const bf16x2c_t b = __builtin_convertvector(v, bf16x2c_t); return __builtin_bit_cast(unsigned, b); }
typedef float f32x2 __attribute__((ext_vector_type(2)));
__device__ __forceinline__ f32x2 gelu_pk(f32x2 v) {
    const f32x2 av = __builtin_elementwise_abs(v), d = av * 0.2316418882f + 1.0f;
    f32x2 t; t.x = __builtin_amdgcn_rcpf(d.x); t.y = __builtin_amdgcn_rcpf(d.y);
    f32x2 q = t * 0.5307027145f + (-0.7265760135f); q = q * t + 0.7107068705f; q = q * t + (-0.142248368f); q = q * t + 0.127414796f; q = q * t;
    const f32x2 s = (v * v) * (-0.72134752044f);
    f32x2 e; e.x = __builtin_amdgcn_exp2f(s.x); e.y = __builtin_amdgcn_exp2f(s.y);
    const f32x2 m = v * (q * e), r = v - m;
    f32x2 o; o.x = v.x < 0.f ? m.x : r.x; o.y = v.y < 0.f ? m.y : r.y; return o;
}

constexpr int MROWS = 16384, DM = 2048;
constexpr float RMS_EPS = 1e-6f;
__device__ __forceinline__ float shx(float v, int o, int lane) { return __builtin_bit_cast(float, __builtin_amdgcn_ds_bpermute((lane ^ o) << 2, __builtin_bit_cast(int, v))); }
__device__ __forceinline__ float sigm_f(float x) { return __builtin_amdgcn_rcpf(1.0f + __builtin_amdgcn_exp2f(x * -1.44269504089f)); }
__device__ __forceinline__ float silu_f(float x) { return x * sigm_f(x); }
__device__ __forceinline__ float bf_lo(unsigned w) { return __uint_as_float(w << 16); }
__device__ __forceinline__ float bf_hi(unsigned w) { return __uint_as_float(w & 0xffff0000u); }
__device__ __forceinline__ u32x4 pack8(const f32x4& a, const f32x4& b) { u32x4 w; w.x = cvt_pk_bf16(a[0], a[1]); w.y = cvt_pk_bf16(a[2], a[3]); w.z = cvt_pk_bf16(b[0], b[1]); w.w = cvt_pk_bf16(b[2], b[3]); return w; }
__device__ __forceinline__ float row_rstd1(const float* ss, int row, int fq) {
    const float* p = ss + (size_t)row * 32 + 8 * fq; const f32x4 a = *(const f32x4*)p, b = *(const f32x4*)(p + 4);
    float s = ((a[0] + a[1]) + (a[2] + a[3])) + ((b[0] + b[1]) + (b[2] + b[3])); { int ln; asm volatile("v_mbcnt_lo_u32_b32 %0, -1, 0\n\tv_mbcnt_hi_u32_b32 %0, -1, %0" : "=v"(ln)); s += shx(s, 16, ln); s += shx(s, 32, ln); }
    return 1.0f / sqrtf(s * (1.0f / 2048.0f) + RMS_EPS);
}

__device__ __forceinline__ void rstd_table(const float* ss, int pm0, PG8_LAS float* tab, int tid) {
    if (tid < 256) { const f32x4* p = (const f32x4*)(ss + (size_t)(pm0 * BM + tid) * 32); float s = 0.f;
#pragma unroll
        for (int i = 0; i < 8; ++i) { const f32x4 a = p[i]; s += (a[0] + a[1]) + (a[2] + a[3]); }
        tab[tid] = 1.0f / sqrtf(s * (1.0f / 2048.0f) + RMS_EPS); }
    __syncthreads();
}
#define ROW_RSTD(ss_, tab_, pm0_, u_, rl_, row_, fq_) (((u_).pm == (pm0_)) ? (tab_)[(rl_)] : row_rstd1((ss_), (row_), (fq_)))

struct EpiIn {
    static constexpr bool PERM = true, AFTER_DRAIN = false, CARRY = false;
    const float* ss;
    const float* rope;
    bf16_t* q; bf16_t* k;
    bf16_t* o2048;
    float* ls;
    const PG8_LAS float* rstab; int pm0;
    template <int ACT> __device__ __forceinline__ void emit(const f32x4 (&acc)[2][2][4][2], const Unit& u, bf16_t* base, int row0, int rl0, int col0, int slot0, int fq) const {
#pragma unroll
        for (int ai = 0; ai < 2; ++ai)
#pragma unroll
            for (int m = 0; m < 4; ++m) { const int row = row0 + ai * HALF + m * 16; const float r = ROW_RSTD(ss, rstab, pm0, u, rl0 + ai * HALF + m * 16, row, fq); bf16_t* rowp = base + (size_t)row * DM + col0; float s1 = 0.f, s2 = 0.f;
#pragma unroll
                for (int bj = 0; bj < 2; ++bj) { f32x4 v0 = acc[ai][bj][m][0] * r, v1 = acc[ai][bj][m][1] * r;
                    if (ACT == 1) {
#pragma unroll
                        for (int j = 0; j < 4; ++j) { v0[j] = silu_f(v0[j]); v1[j] = silu_f(v1[j]); } }
                    if (ACT == 2 || ACT == 3) { const f32x2 a = gelu_pk((f32x2){v0[0], v0[1]}), b = gelu_pk((f32x2){v0[2], v0[3]}), c = gelu_pk((f32x2){v1[0], v1[1]}), d = gelu_pk((f32x2){v1[2], v1[3]});
                        v0 = (f32x4){a.x, a.y, b.x, b.y}; v1 = (f32x4){c.x, c.y, d.x, d.y}; }
                    if (ACT == 4) {
#pragma unroll
                        for (int j = 0; j < 4; ++j) { v0[j] = sigm_f(v0[j]); v1[j] = sigm_f(v1[j]); } }
                    if (ACT == 3) { s1 += ((v0[0] + v0[1]) + (v0[2] + v0[3])) + ((v1[0] + v1[1]) + (v1[2] + v1[3]));
                        s2 += ((v0[0] * v0[0] + v0[1] * v0[1]) + (v0[2] * v0[2] + v0[3] * v0[3])) + ((v1[0] * v1[0] + v1[1] * v1[1]) + (v1[2] * v1[2] + v1[3] * v1[3])); }
                    *(u32x4*)(rowp + bj * HALF) = pack8(v0, v1); }
                if (ACT == 3) { const int ln = (row0 & 15) | (fq << 4); s1 += shx(s1, 16, ln); s1 += shx(s1, 32, ln); s2 += shx(s2, 16, ln); s2 += shx(s2, 32, ln);
                    if (fq == 0) *(f32x2*)(ls + ((size_t)row * 32 + slot0) * 2) = (f32x2){s1, s2}; } }
    }
    __device__ __forceinline__ void operator()(const f32x4 (&acc)[2][2][4][2], const Unit& u, int wr, int wc, int fr, int fq) const {
        const int rl0 = wr * 64 + fr, row0 = u.pm * BM + rl0, pn = u.pn;
        if (pn < 8) {
            bf16_t* base = (pn < 4) ? q : k; const int col0 = (pn & 3) * BM + wc * 32 + 8 * fq;
#pragma unroll
            for (int ai = 0; ai < 2; ++ai) { f32x4 tt[4][2];
#pragma unroll
                for (int m = 0; m < 4; ++m) { const int pos = (row0 + ai * HALF + m * 16) & 8191; const f32x4* tp = (const f32x4*)(rope + ((size_t)pos * 64 + 16 * wc + 4 * fq) * 2); tt[m][0] = tp[0]; tt[m][1] = tp[1]; }
#pragma unroll
                for (int m = 0; m < 4; ++m) { const int row = row0 + ai * HALF + m * 16; const float r = ROW_RSTD(ss, rstab, pm0, u, rl0 + ai * HALF + m * 16, row, fq);
                    const f32x4 t0 = tt[m][0], t1 = tt[m][1];
                    bf16_t* rowp = base + (size_t)row * 1024 + col0;
#pragma unroll
                    for (int bj = 0; bj < 2; ++bj) { const f32x4 v0 = acc[ai][bj][m][0] * r, v1 = acc[ai][bj][m][1] * r; f32x4 y0, y1;
                        y0[0] = v0[0] * t0[0] - v0[1] * t0[1]; y0[1] = v0[1] * t0[0] + v0[0] * t0[1]; y0[2] = v0[2] * t0[2] - v0[3] * t0[3]; y0[3] = v0[3] * t0[2] + v0[2] * t0[3];
                        y1[0] = v1[0] * t1[0] - v1[1] * t1[1]; y1[1] = v1[1] * t1[0] + v1[0] * t1[1]; y1[2] = v1[2] * t1[2] - v1[3] * t1[3]; y1[3] = v1[3] * t1[2] + v1[2] * t1[3];
                        *(u32x4*)(rowp + bj * HALF) = pack8(y0, y1); } }
                asm volatile("" ::: "memory"); }
        } else {
            const int s = (pn - 8) >> 3, tile = (pn - 8) & 7; bf16_t* base = o2048 + (size_t)s * ((size_t)MROWS * DM); const int col0 = tile * BM + wc * 32 + 8 * fq, slot0 = tile * 4 + wc;
            if (s == 0) emit<0>(acc, u, base, row0, rl0, col0, slot0, fq);
            else if (s == 1) emit<1>(acc, u, base, row0, rl0, col0, slot0, fq);
            else if (s == 2) emit<2>(acc, u, base, row0, rl0, col0, slot0, fq);
            else if (s == 3) emit<3>(acc, u, base, row0, rl0, col0, slot0, fq);
            else emit<4>(acc, u, base, row0, rl0, col0, slot0, fq);
        }
    }
};

struct EpiMerge {
    static constexpr bool PERM = true, AFTER_DRAIN = false, CARRY = true;
    const bf16_t* ga; const bf16_t* gb; bf16_t* mg;
    __device__ __forceinline__ bool carry(f32x4 (&acc)[2][2][4][2], const Unit& u, int wr, int wc, int fr, int fq) const {
        if (u.pn >= 8) return false;
        const int row0 = u.pm * BM + wr * 64 + fr, col0 = u.pn * BM + wc * 32 + 8 * fq;
        u32x4 a[2][2][2], b[2][2][2];
#define EM_LOAD(q) do { _Pragma("unroll") for (int mm = 0; mm < 2; ++mm) _Pragma("unroll") for (int bj = 0; bj < 2; ++bj) { \
            const size_t off = (size_t)(row0 + ((q) >> 1) * HALF + (2 * ((q) & 1) + mm) * 16) * DM + col0 + bj * HALF; a[(q) & 1][mm][bj] = *(const u32x4*)(ga + off); b[(q) & 1][mm][bj] = *(const u32x4*)(gb + off); } } while (0)
        EM_LOAD(0);
#pragma unroll
        for (int q = 0; q < 4; ++q) { const int ai = q >> 1, mp = q & 1;
            if (q < 3) EM_LOAD(q + 1);
            __builtin_amdgcn_sched_barrier(0);
#pragma unroll
            for (int mm = 0; mm < 2; ++mm)
#pragma unroll
                for (int bj = 0; bj < 2; ++bj) { const int m = 2 * mp + mm; const u32x4 x = a[q & 1][mm][bj], y = b[q & 1][mm][bj]; f32x4& v0 = acc[ai][bj][m][0]; f32x4& v1 = acc[ai][bj][m][1];
                    v0[0] *= bf_lo(x.x) * __builtin_amdgcn_rcpf(fmaxf(bf_lo(y.x), 1e-20f)); v0[1] *= bf_hi(x.x) * __builtin_amdgcn_rcpf(fmaxf(bf_hi(y.x), 1e-20f));
                    v0[2] *= bf_lo(x.y) * __builtin_amdgcn_rcpf(fmaxf(bf_lo(y.y), 1e-20f)); v0[3] *= bf_hi(x.y) * __builtin_amdgcn_rcpf(fmaxf(bf_hi(y.y), 1e-20f));
                    v1[0] *= bf_lo(x.z) * __builtin_amdgcn_rcpf(fmaxf(bf_lo(y.z), 1e-20f)); v1[1] *= bf_hi(x.z) * __builtin_amdgcn_rcpf(fmaxf(bf_hi(y.z), 1e-20f));
                    v1[2] *= bf_lo(x.w) * __builtin_amdgcn_rcpf(fmaxf(bf_lo(y.w), 1e-20f)); v1[3] *= bf_hi(x.w) * __builtin_amdgcn_rcpf(fmaxf(bf_hi(y.w), 1e-20f)); }
            __builtin_amdgcn_sched_barrier(0); }
#undef EM_LOAD
        return true;
    }
    __device__ __forceinline__ void operator()(const f32x4 (&acc)[2][2][4][2], const Unit& u, int wr, int wc, int fr, int fq) const {
        const int pm = u.pm & 63, pn = u.pn & 7;
        typedef __attribute__((address_space(1))) unsigned char gchar;
        const size_t tile = ((size_t)(pm * BM + wr * 64) * DM + (size_t)(pn * BM + wc * 32)) * 2;
        const gchar* gbase = (const gchar*)gb + tile; gchar* mbase = (gchar*)mg + tile;
        const unsigned voff = (unsigned)((fr * DM + 8 * fq) * 2);
        u32x4 g8[2][4][2];
#pragma unroll
        for (int ai = 0; ai < 2; ++ai)
#pragma unroll
            for (int m = 0; m < 4; ++m)
#pragma unroll
                for (int bj = 0; bj < 2; ++bj) g8[ai][m][bj] = *(const __attribute__((address_space(1))) u32x4*)(gbase + (size_t)(((ai * HALF + m * 16) * DM + bj * HALF) * 2) + voff);
        __builtin_amdgcn_sched_barrier(0);
#pragma unroll
        for (int ai = 0; ai < 2; ++ai) {
#pragma unroll
            for (int m = 0; m < 4; ++m) {
#pragma unroll
                for (int bj = 0; bj < 2; ++bj) { const u32x4 g = g8[ai][m][bj]; f32x4 v0 = acc[ai][bj][m][0], v1 = acc[ai][bj][m][1];
                    v0[0] *= fmaxf(bf_lo(g.x), 1e-20f); v0[1] *= fmaxf(bf_hi(g.x), 1e-20f); v0[2] *= fmaxf(bf_lo(g.y), 1e-20f); v0[3] *= fmaxf(bf_hi(g.y), 1e-20f);
                    v1[0] *= fmaxf(bf_lo(g.z), 1e-20f); v1[1] *= fmaxf(bf_hi(g.z), 1e-20f); v1[2] *= fmaxf(bf_lo(g.w), 1e-20f); v1[3] *= fmaxf(bf_hi(g.w), 1e-20f);
                    *(__attribute__((address_space(1))) u32x4*)(mbase + (size_t)(((ai * HALF + m * 16) * DM + bj * HALF) * 2) + voff) = pack8(v0, v1); } }
            asm volatile("" ::: "memory"); }
    }
};
struct RevOrder {
    StaticOrder base;
    __device__ __forceinline__ bool next(int i, Unit& u) const { if (!base.next(i, u)) return false; u.pn = base.nN - 1 - u.pn; return true; }
    __device__ __forceinline__ void a_ready(const Unit&) const {}
    __device__ __forceinline__ void done(const Unit&) const {}
};
struct PairOrder {
    StaticOrder base;
    __device__ __forceinline__ bool next(int i, Unit& u) const { if (!base.next(i >> 1, u)) return false; if (i & 1) { u.pm += 64; u.pn += 8; } return true; }
    __device__ __forceinline__ void a_ready(const Unit&) const {}
    __device__ __forceinline__ void done(const Unit&) const {}
};

struct EpiResid {
    static constexpr bool PERM = true, AFTER_DRAIN = false, CARRY = false;
    bf16_t* xb; float* ssout; float scale;
    __device__ __forceinline__ void operator()(const f32x4 (&acc)[2][2][4][2], const Unit& u, int wr, int wc, int fr, int fq) const {
        const int row0 = u.pm * BM + wr * 64 + fr;
        typedef __attribute__((address_space(1))) unsigned char gchar;
        gchar* base = (gchar*)xb + ((size_t)(u.pm * BM + wr * 64) * DM + (size_t)(u.pn * BM + wc * 32)) * 2;
        const unsigned voff = (unsigned)((fr * DM + 8 * fq) * 2);
        u32x4 xo[2][4][2];
#pragma unroll
        for (int ai = 0; ai < 2; ++ai)
#pragma unroll
            for (int m = 0; m < 4; ++m)
#pragma unroll
                for (int bj = 0; bj < 2; ++bj) xo[ai][m][bj] = *(const __attribute__((address_space(1))) u32x4*)(base + (size_t)(((ai * HALF + m * 16) * DM + bj * HALF) * 2) + voff);
        __builtin_amdgcn_sched_barrier(0);
#pragma unroll
        for (int ai = 0; ai < 2; ++ai) {
#pragma unroll
            for (int m = 0; m < 4; ++m) { const int row = row0 + ai * HALF + m * 16; float s2 = 0.f;
#pragma unroll
                for (int bj = 0; bj < 2; ++bj) { const u32x4 g = xo[ai][m][bj]; f32x4 a0 = acc[ai][bj][m][0] * scale, a1 = acc[ai][bj][m][1] * scale;
                    a0[0] += bf_lo(g.x); a0[1] += bf_hi(g.x); a0[2] += bf_lo(g.y); a0[3] += bf_hi(g.y); a1[0] += bf_lo(g.z); a1[1] += bf_hi(g.z); a1[2] += bf_lo(g.w); a1[3] += bf_hi(g.w);
                    s2 += ((a0[0] * a0[0] + a0[1] * a0[1]) + (a0[2] * a0[2] + a0[3] * a0[3])) + ((a1[0] * a1[0] + a1[1] * a1[1]) + (a1[2] * a1[2] + a1[3] * a1[3]));
                    *(__attribute__((address_space(1))) u32x4*)(base + (size_t)(((ai * HALF + m * 16) * DM + bj * HALF) * 2) + voff) = pack8(a0, a1); }
                { const int ln = fr | (fq << 4); s2 += shx(s2, 16, ln); s2 += shx(s2, 32, ln); }
                if (fq == 0) ssout[(size_t)row * 32 + u.pn * 4 + wc] = s2; }
            asm volatile("" ::: "memory"); }
    }
};

struct EpiSwiglu {
    static constexpr bool PERM = true, AFTER_DRAIN = false, CARRY = false;
    const float* ss; bf16_t* h; const PG8_LAS float* rstab; int pm0;
    __device__ __forceinline__ void operator()(const f32x4 (&acc)[2][2][4][2], const Unit& u, int wr, int wc, int fr, int fq) const {
        const int rl0 = wr * 64 + fr, row0 = u.pm * BM + rl0, col0 = u.pn * HALF + wc * 32 + 8 * fq;
#pragma unroll
        for (int ai = 0; ai < 2; ++ai)
#pragma unroll
            for (int m = 0; m < 4; ++m) { const float r = ROW_RSTD(ss, rstab, pm0, u, rl0 + ai * HALF + m * 16, row0 + ai * HALF + m * 16, fq); f32x4 a0 = acc[ai][0][m][0] * r, a1 = acc[ai][0][m][1] * r; const f32x4 c0 = acc[ai][1][m][0] * r, c1 = acc[ai][1][m][1] * r;
#pragma unroll
                for (int j = 0; j < 4; ++j) { a0[j] = silu_f(a0[j]) * c0[j]; a1[j] = silu_f(a1[j]) * c1[j]; }
                *(u32x4*)(h + (size_t)(row0 + ai * HALF + m * 16) * 5632 + col0) = pack8(a0, a1); }
    }
};

struct EpiNull {
    static constexpr bool PERM = true, AFTER_DRAIN = false, CARRY = false;
    float* sink;
    __device__ __forceinline__ void operator()(const f32x4 (&acc)[2][2][4][2], const Unit& u, int wr, int wc, int fr, int fq) const {
        float s = 0.f;
#pragma unroll
        for (int ai = 0; ai < 2; ++ai)
#pragma unroll
            for (int bj = 0; bj < 2; ++bj)
#pragma unroll
                for (int m = 0; m < 4; ++m)
#pragma unroll
                    for (int n = 0; n < 2; ++n) s += (acc[ai][bj][m][n][0] + acc[ai][bj][m][n][1]) + (acc[ai][bj][m][n][2] + acc[ai][bj][m][n][3]);
        if (s == 123456.789f) sink[u.pm * 64 + u.pn] = s;
    }
};

struct SameTileOrder {
    int nunits;
    __device__ __forceinline__ bool next(int i, Unit& u) const { if (i >= nunits) return false; u.pm = 0; u.pn = 0; return true; }
    __device__ __forceinline__ void a_ready(const Unit&) const {}
    __device__ __forceinline__ void done(const Unit&) const {}
};
template <class Epi, class Sched, bool ALIGN_EPI = false, bool SP2 = false, bool MM32 = false>
__device__ __forceinline__ void gemm_phase(PG8_LAS unsigned char* lds, const Gemm g, const Sched& S, const Epi& E, const int tid_in) {
    const int tid = tid_in, wid = __builtin_amdgcn_readfirstlane(tid >> 6), lane = tid & 63, wr = wid >> 2, wc = wid & 3, fr = lane & 15, fq = lane >> 4;
    const int K = g.K, nt = K / BK;
    unsigned voffA[2], voffB[2];
#pragma unroll
    for (int i = 0; i < 2; ++i) { int R, C; stage_rc(tid * 16 + i * 8192, R, C); const int Rb = Epi::PERM ? ((R & ~31) + perm32(R & 31)) : R;
        voffA[i] = (unsigned)(R * K + C) * 2u; voffB[i] = (unsigned)(Rb * K + C) * 2u; }
    const size_t kstep = (size_t)(BK * 2);
    const size_t hstep = (size_t)HALF * K * 2;
    const size_t tstep = 2 * hstep;
    const unsigned ldsw = (unsigned)wid * 1024u;
    const int aoff = lds_byte(wr * 64 + fr, fq * 8), boff = lds_byte(wc * 32 + fr, fq * 8);
#ifndef PG8_DMA_AUX
#define PG8_DMA_AUX 0
#endif
#define PG8_SA(b, h) (((b) * 2 + (h)) * HTB)
#define PG8_SB(b, h) ((4 + (b) * 2 + (h)) * HTB)
#define PG8_STAGE(bufoff, gbase, voff) do { _Pragma("unroll") for (int _i = 0; _i < 2; ++_i) \
        __builtin_amdgcn_global_load_lds((const unsigned*)((const char*)(gbase) + (voff)[_i]), (PG8_LAS unsigned*)(lds + (bufoff) + ldsw + _i * 8192), 16, 0, PG8_DMA_AUX); } while (0)
#define PG8_LDA(dst, b, h) do { _Pragma("unroll") for (int m = 0; m < 4; ++m) _Pragma("unroll") for (int k = 0; k < 2; ++k) dst[m][k] = *(const PG8_LAS bf16x8*)(lds + PG8_SA(b, h) + aoff + m * 2048 + k * 1024); } while (0)
#define PG8_LDB(dst, b, h) do { _Pragma("unroll") for (int n = 0; n < 2; ++n) _Pragma("unroll") for (int k = 0; k < 2; ++k) dst[n][k] = *(const PG8_LAS bf16x8*)(lds + PG8_SB(b, h) + boff + n * 2048 + k * 1024); } while (0)
#define PG8_MMA(ai, bj, At, Bt) do { __builtin_amdgcn_s_setprio(1); if constexpr (MM32) { _Pragma("unroll") for (int j = 0; j < 4; ++j) _Pragma("unroll") for (int p = 0; p < 2; ++p) \
        acc16[ai][bj][p] = __builtin_amdgcn_mfma_f32_32x32x16_bf16(Bt[p][j & 1], At[j][j >> 1], acc16[ai][bj][p], 0, 0, 0); } else { \
        _Pragma("unroll") for (int m = 0; m < 4; ++m) _Pragma("unroll") for (int n = 0; n < 2; ++n) _Pragma("unroll") for (int k = 0; k < 2; ++k) \
        acc[ai][bj][m][n] = __builtin_amdgcn_mfma_f32_16x16x32_bf16(Bt[n][k], At[m][k], acc[ai][bj][m][n], 0, 0, 0); } __builtin_amdgcn_s_setprio(0); } while (0)
#define PG8_WAIT_V(n) asm volatile("s_waitcnt vmcnt(" #n ")" ::: "memory")
#define PG8_WAIT_L(n) asm volatile("s_waitcnt lgkmcnt(" #n ")" ::: "memory")
#define PG8_BAR __builtin_amdgcn_s_barrier()
#define PG8_SCHED __builtin_amdgcn_sched_barrier(0)
    Unit cur, nxt; int ui = 0;
    if (!S.next(0, cur)) return;
    f32x4 acc[2][2][4][2];
#pragma unroll
    for (int a = 0; a < 2; ++a)
#pragma unroll
        for (int b = 0; b < 2; ++b)
#pragma unroll
            for (int m = 0; m < 4; ++m)
#pragma unroll
                for (int n = 0; n < 2; ++n) acc[a][b][m][n] = (f32x4){0.f, 0.f, 0.f, 0.f};
    f32x16 acc16[2][2][2];
    if constexpr (MM32) {
#pragma unroll
        for (int a = 0; a < 2; ++a)
#pragma unroll
            for (int b = 0; b < 2; ++b)
#pragma unroll
                for (int p = 0; p < 2; ++p)
#pragma unroll
                    for (int e = 0; e < 16; ++e) acc16[a][b][p][e] = 0.f;
    }
    bf16x8 At[4][2], B0[2][2], B1[2][2];
    const char* cA = (const char*)g.A + (size_t)cur.pm * tstep; const char* cB = (const char*)g.Bt + (size_t)cur.pn * tstep;
    S.a_ready(cur);
    if constexpr (SP2) {
        PG8_STAGE(PG8_SB(0, 0), cB, voffB); PG8_STAGE(PG8_SB(0, 1), cB + hstep, voffB); PG8_STAGE(PG8_SA(0, 0), cA, voffA); PG8_STAGE(PG8_SA(0, 1), cA + hstep, voffA);
        if (wr == 1) PG8_BAR;
        PG8_WAIT_V(2); PG8_BAR;
        PG8_STAGE(PG8_SB(1, 0), cB + kstep, voffB); PG8_STAGE(PG8_SA(1, 0), cA + kstep, voffA); PG8_STAGE(PG8_SB(1, 1), cB + hstep + kstep, voffB);
        PG8_WAIT_V(6); PG8_BAR;
    } else {
        PG8_STAGE(PG8_SB(0, 0), cB, voffB); PG8_STAGE(PG8_SA(0, 0), cA, voffA); PG8_STAGE(PG8_SB(0, 1), cB + hstep, voffB); PG8_STAGE(PG8_SA(0, 1), cA + hstep, voffA);
        if (wr == 1) PG8_BAR;
        PG8_WAIT_V(4); PG8_BAR;
        PG8_STAGE(PG8_SB(1, 0), cB + kstep, voffB); PG8_STAGE(PG8_SA(1, 0), cA + kstep, voffA); PG8_STAGE(PG8_SB(1, 1), cB + hstep + kstep, voffB);
        PG8_WAIT_V(6); PG8_BAR;
    }
    for (;;) {
        const bool has_next = S.next(ui + 1, nxt);
        const char* nA = has_next ? (const char*)g.A + (size_t)nxt.pm * tstep : cA; const char* nB = has_next ? (const char*)g.Bt + (size_t)nxt.pn * tstep : cB;
        for (int t = 0; t < nt; t += 2) {
            const bool last = (t == nt - 2);
            const char* a1 = cA + (size_t)(t + 1) * kstep;
            const char* a2 = last ? nA : cA + (size_t)(t + 2) * kstep; const char* b2 = last ? nB : cB + (size_t)(t + 2) * kstep;
            const char* a3 = a2 + kstep; const char* b3 = b2 + kstep;
            if (last && has_next) S.a_ready(nxt);
            if constexpr (SP2) {
            PG8_LDB(B0, 0, 0); PG8_LDB(B1, 0, 1); PG8_SCHED; PG8_LDA(At, 0, 0); PG8_STAGE(PG8_SA(1, 1), a1 + hstep, voffA);
            PG8_WAIT_V(8); PG8_WAIT_L(0); PG8_BAR; PG8_MMA(0, 0, At, B0); PG8_MMA(0, 1, At, B1); PG8_BAR; PG8_SCHED;
            PG8_LDA(At, 0, 1); PG8_STAGE(PG8_SB(0, 0), b2, voffB); PG8_STAGE(PG8_SB(0, 1), b2 + hstep, voffB); PG8_STAGE(PG8_SA(0, 0), a2, voffA);
            PG8_WAIT_V(8); PG8_WAIT_L(0); PG8_BAR; PG8_MMA(1, 0, At, B0); PG8_MMA(1, 1, At, B1); PG8_BAR; PG8_SCHED;
            PG8_LDB(B0, 1, 0); PG8_LDB(B1, 1, 1); PG8_SCHED; PG8_LDA(At, 1, 0); PG8_STAGE(PG8_SA(0, 1), a2 + hstep, voffA);
            PG8_WAIT_V(8); PG8_WAIT_L(0); PG8_BAR; PG8_MMA(0, 0, At, B0); PG8_MMA(0, 1, At, B1); PG8_BAR; PG8_SCHED;
            PG8_LDA(At, 1, 1); PG8_STAGE(PG8_SB(1, 0), b3, voffB); PG8_STAGE(PG8_SB(1, 1), b3 + hstep, voffB); PG8_STAGE(PG8_SA(1, 0), a3, voffA);
            PG8_WAIT_V(8); PG8_WAIT_L(0); PG8_BAR; PG8_MMA(1, 0, At, B0); PG8_MMA(1, 1, At, B1); PG8_BAR; PG8_SCHED;
            } else {
            PG8_LDB(B0, 0, 0); PG8_SCHED; PG8_LDA(At, 0, 0); PG8_STAGE(PG8_SA(1, 1), a1 + hstep, voffA);
            PG8_WAIT_L(8); PG8_BAR; PG8_WAIT_L(0); PG8_MMA(0, 0, At, B0); PG8_BAR; PG8_SCHED;
            PG8_LDB(B1, 0, 1); PG8_STAGE(PG8_SB(0, 0), b2, voffB);
            PG8_BAR; PG8_WAIT_L(0); PG8_MMA(0, 1, At, B1); PG8_BAR;
            PG8_LDA(At, 0, 1); PG8_STAGE(PG8_SA(0, 0), a2, voffA);
            PG8_BAR; PG8_WAIT_L(0); PG8_MMA(1, 0, At, B0); PG8_BAR; PG8_SCHED;
            PG8_STAGE(PG8_SB(0, 1), b2 + hstep, voffB);
            PG8_WAIT_V(6); PG8_BAR; PG8_MMA(1, 1, At, B1); PG8_BAR;
            PG8_LDB(B0, 1, 0); PG8_SCHED; PG8_LDA(At, 1, 0); PG8_STAGE(PG8_SA(0, 1), a2 + hstep, voffA);
            PG8_WAIT_L(8); PG8_BAR; PG8_WAIT_L(0); PG8_MMA(0, 0, At, B0); PG8_BAR; PG8_SCHED;
            PG8_LDB(B1, 1, 1); PG8_STAGE(PG8_SB(1, 0), b3, voffB);
            PG8_BAR; PG8_WAIT_L(0); PG8_MMA(0, 1, At, B1); PG8_BAR;
            PG8_LDA(At, 1, 1); PG8_STAGE(PG8_SA(1, 0), a3, voffA);
            PG8_BAR; PG8_WAIT_L(0); PG8_MMA(1, 0, At, B0); PG8_BAR; PG8_SCHED;
            PG8_STAGE(PG8_SB(1, 1), b3 + hstep, voffB);
            PG8_WAIT_V(6); PG8_BAR; PG8_MMA(1, 1, At, B1); PG8_BAR;
            }
        }
        if constexpr (ALIGN_EPI) { if (wr == 0) PG8_BAR; }
        if constexpr (MM32) {
#pragma unroll
            for (int a = 0; a < 2; ++a)
#pragma unroll
                for (int b = 0; b < 2; ++b)
#pragma unroll
                    for (int m = 0; m < 4; ++m)
#pragma unroll
                        for (int n = 0; n < 2; ++n)
#pragma unroll
                            for (int e = 0; e < 4; ++e) acc[a][b][m][n][e] = acc16[a][b][m >> 1][(m & 1) * 8 + n * 4 + e];
        }
        bool keep = false;
        if constexpr (!Epi::AFTER_DRAIN) { if constexpr (Epi::CARRY) keep = E.carry(acc, cur, wr, wc, fr, fq); if (!keep) E(acc, cur, wr, wc, fr, fq); S.done(cur); }
        if (!has_next) break;
        if (!keep)
#pragma unroll
        for (int a = 0; a < 2; ++a)
#pragma unroll
            for (int b = 0; b < 2; ++b)
#pragma unroll
                for (int m = 0; m < 4; ++m)
#pragma unroll
                    for (int n = 0; n < 2; ++n) acc[a][b][m][n] = (f32x4){0.f, 0.f, 0.f, 0.f};
        cur = nxt; cA = nA; cB = nB; ++ui;
        if constexpr (ALIGN_EPI) { if (wr == 1) PG8_BAR; }
    }
    PG8_WAIT_V(0);
    if constexpr (!ALIGN_EPI) { if (wr == 0) PG8_BAR; }
    PG8_BAR;
    if constexpr (Epi::AFTER_DRAIN) { E.fused(acc, cur, wr, wc, fr, fq, lds, wid, lane); S.done(cur); }
#undef PG8_SA
#undef PG8_SB
#undef PG8_STAGE
#undef PG8_LDA
#undef PG8_LDB
#undef PG8_MMA
#undef PG8_WAIT_V
#undef PG8_WAIT_L
#undef PG8_BAR
#undef PG8_SCHED
}
}

#ifndef MK_PER_PHASE
#define MK_PER_PHASE 0
#endif
constexpr int NWAVES = 8;
constexpr int NWG = 256;
constexpr int BATCH = 2, T = 8192, D = 2048, M = BATCH * T, DEPTH = 4;
constexpr int NIN = 14336, DFF = 5632, NFF = 2 * DFF;
constexpr float EPS = 1e-6f;
static_assert(M == pg8::MROWS && D == pg8::DM, "shapes");

constexpr size_t MiB = 1u << 20;
constexpr size_t WS_CTL = 0, CTL_ZERO_BYTES = 1 * MiB;
constexpr size_t WS_ROPE = 1 * MiB;
constexpr size_t WS_SS = 5 * MiB, WS_SS2 = 7 * MiB;
constexpr size_t WS_LS = 9 * MiB;
constexpr size_t WS_W = 16 * MiB, W_LAYER = 146 * MiB;
constexpr size_t W_IN = 0, W_R = 56 * MiB, W_S = 64 * MiB, W_O = 72 * MiB, W_F1 = 80 * MiB, W_F2 = 124 * MiB;
static_assert((size_t)NIN * D * 2 == 56 * MiB && (size_t)NFF * D * 2 == 44 * MiB && (size_t)D * DFF * 2 == 22 * MiB, "weight map");
constexpr size_t WS_X = 600 * MiB;
constexpr size_t WS_XB = 728 * MiB;
constexpr size_t WS_Q = 792 * MiB, WS_K = 824 * MiB;
constexpr size_t WS_O2048 = 856 * MiB;
constexpr size_t WS_V = WS_O2048, WS_SG = WS_V + 64 * MiB, WS_ZU = WS_SG + 64 * MiB, WS_ZV = WS_ZU + 64 * MiB, WS_GA = WS_ZV + 64 * MiB, WS_GB = WS_GA + 64 * MiB;
constexpr size_t WS_RA = 1240 * MiB, WS_SB = 1304 * MiB;
constexpr size_t WS_P = 1368 * MiB, WS_MG = 1432 * MiB;
constexpr size_t WS_SLOC = 1496 * MiB;
constexpr size_t WS_END = 1528 * MiB;
constexpr size_t WS_H = WS_Q;
static_assert(WS_W + DEPTH * W_LAYER <= WS_X && WS_GB + 64 * MiB == WS_RA && WS_SB == WS_RA + 64 * MiB && WS_H + (size_t)M * DFF * 2 <= WS_ZU, "d_ws map");
constexpr int CW_TMO = 0, CW_CODE = 1, CW_BAR = 4096;

constexpr int RING_OFF = 0, RING_BYTES = 131072;
constexpr int LDSCTL_OFF = RING_BYTES, MISC_OFF = LDSCTL_OFF + 320, RSTAB_OFF = LDSCTL_OFF + 1024;
constexpr int LDS_BYTES = 147456;
constexpr int R_Q = 0, R_K = 17408, R_KS = 34816, R_V = 52224, R_P = 86016, R_RED = 95232, R_END = 99328;
constexpr int PQ = 272, PV = 528, PP = 144;
constexpr int R1_KS = 0, R1_V = 17408, R1_BUF = 51200;
static_assert(2 * R1_BUF <= RING_BYTES, "LDS map");
constexpr int S_W = 0, S_VN = 34816, S_ST = 102400, S_END = 104448;
static_assert(R_END <= RING_BYTES && S_END <= RING_BYTES, "LDS map");

#define GAS __attribute__((address_space(1)))
#define LAS __attribute__((address_space(3)))
typedef unsigned short bf16;
typedef unsigned v4u __attribute__((ext_vector_type(4)));
typedef unsigned v2u __attribute__((ext_vector_type(2)));
typedef float f32x4 __attribute__((ext_vector_type(4)));
typedef float f32x2 __attribute__((ext_vector_type(2)));
typedef short bf16x8 __attribute__((ext_vector_type(8)));
typedef short s16x4 __attribute__((ext_vector_type(4)));
typedef GAS unsigned gu32;
#define RLX_AGENT __ATOMIC_RELAXED, __HIP_MEMORY_SCOPE_AGENT
#define LDS_WAIT() asm volatile("s_waitcnt lgkmcnt(0)" ::: "memory")
#define VM_WAIT() asm volatile("s_waitcnt vmcnt(0)" ::: "memory")
__device__ __forceinline__ unsigned f2bf(float f) { unsigned u = __builtin_bit_cast(unsigned, f); return (u + 0x7fffu + ((u >> 16) & 1u)) >> 16; }
__device__ __forceinline__ unsigned pk2(float lo, float hi) { typedef float f2_ __attribute__((ext_vector_type(2))); typedef __bf16 b2_ __attribute__((ext_vector_type(2))); const f2_ v = {lo, hi}; return __builtin_bit_cast(unsigned, __builtin_convertvector(v, b2_)); }
__device__ __forceinline__ float blo(unsigned w) { return __uint_as_float(w << 16); }
__device__ __forceinline__ float bhi(unsigned w) { return __uint_as_float(w & 0xffff0000u); }
__device__ __forceinline__ float ex2(float x) { return __builtin_amdgcn_exp2f(x); }
__device__ __forceinline__ float l2gamma(int h) {
    const float t0 = (h & 1) ? -0.02272007650008353f : -0.04580368961312479f, t1 = (h & 1) ? -0.005646563141142063f : -0.011315313227834146f;
    const float t2 = (h & 1) ? -0.0014095702546713536f : -0.0028205190623786626f, t3 = (h & 1) ? -0.0003522634716290214f : -0.0007046129765893727f;
    const float a = (h & 2) ? t1 : t0, b = (h & 2) ? t3 : t2; return (h & 4) ? b : a; }
#define MFMA16(a, b, c) __builtin_amdgcn_mfma_f32_16x16x32_bf16((a), (b), (c), 0, 0, 0)

#define XB_TMO      128
#define XB_XCNT(j)  (256  + 64 * (j))
#define XB_XSUB(j)  (1280 + 64 * (j))
#define XB_XGEN(j)  (2304 + 64 * (j))
#define XB_TOP      3328
#define XB_TOPGEN   3392
#define XCD_BAR_WORDS 3456
#define XB_SPIN_CAP (1u << 18)

__device__ __forceinline__ unsigned xb_ld(unsigned* p)              { return __hip_atomic_load(p, __ATOMIC_RELAXED, __HIP_MEMORY_SCOPE_AGENT); }
__device__ __forceinline__ unsigned xb_add(unsigned* p, unsigned v) { return __hip_atomic_fetch_add(p, v, __ATOMIC_RELAXED, __HIP_MEMORY_SCOPE_AGENT); }
__device__ __forceinline__ unsigned xb_xcc_id() { return (unsigned)__builtin_amdgcn_s_getreg((3 << 11) | 20) & 0xFu; }
#define XB_SPIN(cond, bar) do { unsigned _sp = 0; while (cond) { __builtin_amdgcn_s_sleep(1); \
    if ((++_sp & 255u) == 0u) { if (xb_ld(&(bar)[XB_TMO])) break; if (_sp > XB_SPIN_CAP) { atomicAdd(&(bar)[XB_TMO], 1u); break; } } } } while (0)

struct XcdBarrier {
    unsigned* bar; unsigned x;
    volatile LAS unsigned* st;
};

__device__ __forceinline__ XcdBarrier xcd_barrier_post(unsigned* bar, volatile LAS unsigned* st) {
    XcdBarrier b; b.bar = bar; b.x = xb_xcc_id(); b.st = st;
    if (threadIdx.x == 0) (void)xb_add(&bar[XB_XCNT(b.x)], 1u);
    return b;
}
__device__ __forceinline__ void xcd_barrier_complete(unsigned* bar, unsigned x, unsigned& nloc, unsigned& nx) {
    const unsigned G = gridDim.x * gridDim.y * gridDim.z;
    unsigned sum, cnt, mine, sp = 0u;
    for (;;) {
        sum = 0u; cnt = 0u; mine = 0u;
#pragma unroll
        for (unsigned j = 0; j < 16; ++j) { const unsigned c = xb_ld(&bar[XB_XCNT(j)]); sum += c; cnt += (c > 0u) ? 1u : 0u; mine = (j == x) ? c : mine; }
        if (sum == G) break;
        __builtin_amdgcn_s_sleep(1);
        if ((++sp & 255u) == 0u) { if (xb_ld(&bar[XB_TMO])) break; if (sp > XB_SPIN_CAP) { atomicAdd(&bar[XB_TMO], 1u); break; } }
    }
    nloc = mine > 0u ? mine : 1u; nx = cnt > 0u ? cnt : 1u;
}

__device__ __forceinline__ void xcd_barrier(const XcdBarrier& b) {
    asm volatile("s_waitcnt vmcnt(0)" ::: "memory");
    __syncthreads();
    if (threadIdx.x == 0) {
        unsigned* bar = b.bar;
        __builtin_amdgcn_s_waitcnt(0);
        unsigned nloc = b.st[0], nx = b.st[1];
        if (nloc == 0u) { xcd_barrier_complete(bar, b.x, nloc, nx); b.st[0] = nloc; b.st[1] = nx; }
        const unsigned old = xb_add(&bar[XB_XSUB(b.x)], 1u);
        const unsigned gen = old / nloc;
        if (old + 1u == (gen + 1u) * nloc) {
            __builtin_amdgcn_fence(__ATOMIC_RELEASE, "agent");
            asm volatile("s_waitcnt vmcnt(0)" ::: "memory");
            const unsigned og = xb_add(&bar[XB_TOP], 1u);
            const unsigned tg = og / nx;
            if (og + 1u == (tg + 1u) * nx) xb_add(&bar[XB_TOPGEN], 1u);
            else XB_SPIN(xb_ld(&bar[XB_TOPGEN]) == tg, bar);
            __builtin_amdgcn_fence(__ATOMIC_ACQUIRE, "agent");
            xb_add(&bar[XB_XGEN(b.x)], 1u);
            asm volatile("s_waitcnt vmcnt(0)" ::: "memory");
        } else {
            XB_SPIN(xb_ld(&bar[XB_XGEN(b.x)]) == gen, bar);
            __builtin_amdgcn_fence(__ATOMIC_ACQUIRE, "agent");
            asm volatile("s_waitcnt vmcnt(0)" ::: "memory");
        }
    }
    __syncthreads();
}

struct Frame;
__device__ __forceinline__ bool conv_work_one(Frame& F, int max_layer);
__device__ __forceinline__ void xcd_barrier_idle(const XcdBarrier& b, Frame& F, const int tid_) {
    asm volatile("s_waitcnt vmcnt(0)" ::: "memory");
    __syncthreads();
    if (tid_ == 0) {
        unsigned* bar = b.bar;
        __builtin_amdgcn_s_waitcnt(0);
        unsigned nloc = b.st[0], nx = b.st[1];
        if (nloc == 0u) { xcd_barrier_complete(bar, b.x, nloc, nx); b.st[0] = nloc; b.st[1] = nx; }
        const unsigned old = xb_add(&bar[XB_XSUB(b.x)], 1u);
        const unsigned gen = old / nloc;
        if (old + 1u == (gen + 1u) * nloc) {
            __builtin_amdgcn_fence(__ATOMIC_RELEASE, "agent");
            asm volatile("s_waitcnt vmcnt(0)" ::: "memory");
            const unsigned og = xb_add(&bar[XB_TOP], 1u);
            const unsigned tg = og / nx;
            if (og + 1u == (tg + 1u) * nx) xb_add(&bar[XB_TOPGEN], 1u);
            else XB_SPIN(xb_ld(&bar[XB_TOPGEN]) == tg, bar);
            __builtin_amdgcn_fence(__ATOMIC_ACQUIRE, "agent");
            xb_add(&bar[XB_XGEN(b.x)], 1u);
            asm volatile("s_waitcnt vmcnt(0)" ::: "memory");
            b.st[2] = 0u;
        } else { b.st[2] = 1u; b.st[3] = gen;
#if defined(PRE_WB)
            { const unsigned pos = old - gen * nloc;
              if (pos + 1u == nloc / 2u || pos + 4u == nloc || pos + 2u == nloc) asm volatile("buffer_wbl2 sc1" ::: "memory"); }
#endif
        }
    }
    __syncthreads();
    if (b.st[2] != 0u) {
        unsigned* bar = b.bar; const unsigned gen = b.st[3]; bool more = true;
        for (unsigned it = 0; it < (1u << 20); ++it) {
            if (tid_ == 0) b.st[4] = (xb_ld(&bar[XB_XGEN(b.x)]) != gen || xb_ld(&bar[XB_TMO]) != 0u) ? 1u : 0u;
            __syncthreads();
            const unsigned rel = b.st[4];
            if (rel) break;
            if (more) { const unsigned w_ = conv_work_one(F, DEPTH - 1) ? 1u : 0u; volatile LAS unsigned* wf = b.st + 16;
                if ((tid_ & 63) == 0) wf[tid_ >> 6] = w_;
                __syncthreads();
                more = (wf[0] | wf[1] | wf[2] | wf[3] | wf[4] | wf[5] | wf[6] | wf[7]) != 0u; }
            else { if (tid_ == 0) XB_SPIN(xb_ld(&bar[XB_XGEN(b.x)]) == gen, bar); __syncthreads(); break; }
        }
        if (tid_ == 0) { __builtin_amdgcn_fence(__ATOMIC_ACQUIRE, "agent"); asm volatile("s_waitcnt vmcnt(0)" ::: "memory"); }
    }
    __syncthreads();
}

__device__ __forceinline__ bf16x8 tr_frag(LAS const unsigned char* img, int pitch, int k0, int n0, int lane) {
    const int g = lane >> 4, q = (lane & 15) >> 2, p = lane & 3;
    LAS const unsigned char* a = img + (k0 + 8 * g + q) * pitch + (n0 + 4 * p) * 2;
    const s16x4 lo = __builtin_bit_cast(s16x4, __builtin_amdgcn_ds_read_tr16_b64_v4i16((LAS s16x4*)a));
    const s16x4 hi = __builtin_bit_cast(s16x4, __builtin_amdgcn_ds_read_tr16_b64_v4i16((LAS s16x4*)(a + 4 * pitch)));
    return __builtin_shufflevector(lo, hi, 0, 1, 2, 3, 4, 5, 6, 7);
}
__device__ __forceinline__ bf16x8 pack_f8(const f32x4& a, const f32x4& b) { v4u w; w.x = pg8::cvt_pk_bf16(a[0], a[1]); w.y = pg8::cvt_pk_bf16(a[2], a[3]); w.z = pg8::cvt_pk_bf16(b[0], b[1]); w.w = pg8::cvt_pk_bf16(b[2], b[3]); return __builtin_bit_cast(bf16x8, w); }
__device__ __forceinline__ float wave_sum(float v, int lane) {
#pragma unroll
    for (int o = 1; o < 64; o <<= 1) v += pg8::shx(v, o, lane);
    return v;
}

struct Frame {
    LAS unsigned char* lds;
    int tid, lane, wave;
    const float *x, *norm_mix_w, *w_in, *ret_gn_w, *ret_proj, *sgu_ln_w, *sgu_ln_b, *sgu_w_s, *sgu_b_s, *sgu_proj, *w_out, *norm_ffn_w, *w_ffn_in, *w_ffn_out, *final_norm_w;
    float* out; unsigned char* ws;
};

__device__ __forceinline__ int p0_rowmap(int mode, int c) {
    if (mode == 1) { if (c < 2048) { const int d = c & 127; return (c & ~127) + 2 * (d & 63) + (d >> 6); } return c; }
    if (mode == 2) { const int half = c >= DFF ? 1 : 0, j = c - half * DFF; return 256 * (j >> 7) + 128 * half + (j & 127); }
    return c;
}
__device__ __forceinline__ void p0_transpose_item(const float* W, int Nsrc, int K, bf16* WT, int mode, const float* kscale, float qs, LAS float* scr, int kb, int cb, int lane) {
    const int k0 = 64 * kb, c0 = 64 * cb, c4 = (lane & 15) * 4;
    f32x4 w[16];
#pragma unroll
    for (int i = 0; i < 16; ++i) { const int kk = 4 * i + (lane >> 4); w[i] = *(const GAS f32x4*)(W + (size_t)(k0 + kk) * Nsrc + c0 + c4); }
#pragma unroll
    for (int i = 0; i < 16; ++i) { const int kk = 4 * i + (lane >> 4); const float ks = kscale ? kscale[k0 + kk] : 1.f;
        *(LAS f32x4*)(scr + kk * 64 + (c4 ^ (((kk >> 3) & 7) << 3))) = w[i] * ks; }
    LDS_WAIT(); asm volatile("" ::: "memory");
    const int c = lane & 7;
#pragma unroll
    for (int j = 0; j < 8; ++j) { const int n = (lane >> 3) + 8 * j, row = p0_rowmap(mode, c0 + n); const float cs = (mode == 1 && row < 1024) ? qs : 1.f;
        const LAS float* s = scr + (8 * c) * 64 + (n ^ (c << 3));
        v4u o; o.x = pk2(s[0 * 64] * cs, s[1 * 64] * cs); o.y = pk2(s[2 * 64] * cs, s[3 * 64] * cs); o.z = pk2(s[4 * 64] * cs, s[5 * 64] * cs); o.w = pk2(s[6 * 64] * cs, s[7 * 64] * cs);
        *(GAS v4u*)(WT + (size_t)row * K + k0 + 8 * c) = o; }
    LDS_WAIT(); asm volatile("" ::: "memory");
}
constexpr int I_IN = 32 * (NIN / 64), I_SQ = 32 * 32, I_F1 = 32 * (NFF / 64), I_F2 = (DFF / 64) * 32, I_LAYER = I_IN + 3 * I_SQ + I_F1 + I_F2;
__device__ __forceinline__ void conv_item(Frame& F, int it, LAS float* scr) {
    const int l = it / I_LAYER; int r = it % I_LAYER;
    unsigned char* wl = F.ws + WS_W + (size_t)l * W_LAYER;
    const float* W; int Nsrc = D, K = D, mode = 0, nb = 32; bf16* WT; const float* ks = nullptr; float qs = 1.f;
    if (r < I_IN) { W = F.w_in + (size_t)l * D * NIN; Nsrc = NIN; WT = (bf16*)(wl + W_IN); mode = 1; ks = F.norm_mix_w + l * D; qs = 0.08838834764831845f; nb = NIN / 64; }
    else if ((r -= I_IN) < I_SQ) { W = F.ret_proj + (size_t)l * D * D; WT = (bf16*)(wl + W_R); }
    else if ((r -= I_SQ) < I_SQ) { W = F.sgu_proj + (size_t)l * D * D; WT = (bf16*)(wl + W_S); }
    else if ((r -= I_SQ) < I_SQ) { W = F.w_out + (size_t)l * D * D; WT = (bf16*)(wl + W_O); }
    else if ((r -= I_SQ) < I_F1) { W = F.w_ffn_in + (size_t)l * D * NFF; Nsrc = NFF; WT = (bf16*)(wl + W_F1); mode = 2; ks = F.norm_ffn_w + l * D; nb = NFF / 64; }
    else { r -= I_F1; W = F.w_ffn_out + (size_t)l * DFF * D; K = DFF; WT = (bf16*)(wl + W_F2); }
#if defined(CONV_BLK24)
    { const int r8 = r >> 3, j = r & 7, nb4 = nb >> 2;
      p0_transpose_item(W, Nsrc, K, WT, mode, ks, qs, scr, 2 * (r8 / nb4) + (j >> 2), 4 * (r8 % nb4) + (j & 3), F.lane); }
#else
    p0_transpose_item(W, Nsrc, K, WT, mode, ks, qs, scr, r / nb, r % nb, F.lane);
#endif
}
constexpr int CW_CONV_DONE = 2624;
constexpr int CONV_CUR_OFF = MISC_OFF + 64;
__device__ __forceinline__ bool conv_work_one(Frame& F, int max_layer = DEPTH - 1) {
    volatile LAS unsigned* cur = (volatile LAS unsigned*)(F.lds + CONV_CUR_OFF) + F.wave;
    const int NGW = NWG * NWAVES, gw = blockIdx.x * NWAVES + F.wave;
    const int k = __builtin_amdgcn_readfirstlane((int)*cur);
    if (k >= (DEPTH * I_LAYER) / NGW + 1) return false;
    const int it = I_LAYER + gw + k * NGW;
    if (it >= DEPTH * I_LAYER) return false;
    const int layer = it / I_LAYER;
    if (layer > max_layer) return false;
    conv_item(F, it, (LAS float*)(F.lds + RING_OFF + F.wave * 16384));
    if (F.lane == 0) *cur = (unsigned)(k + 1);
    if ((it + NGW) / I_LAYER != layer) {
        asm volatile("s_waitcnt vmcnt(0)" ::: "memory");
        if (F.lane == 0) __hip_atomic_fetch_add((unsigned*)(F.ws + WS_CTL) + CW_CONV_DONE + 64 * layer, 1u, __ATOMIC_RELAXED, __HIP_MEMORY_SCOPE_AGENT); }
    return true;
}
__device__ __forceinline__ void conv_finish(Frame& F, int layer) {
    while (conv_work_one(F, layer)) { }
    unsigned* cnt = (unsigned*)(F.ws + WS_CTL) + CW_CONV_DONE + 64 * layer; const unsigned want = (unsigned)(NWG * NWAVES);
    for (unsigned spins = 0; spins < (1u << 22); ++spins) {
        unsigned d = 0; if (F.lane == 0) d = __hip_atomic_load(cnt, __ATOMIC_RELAXED, __HIP_MEMORY_SCOPE_AGENT);
        d = (unsigned)__builtin_amdgcn_readfirstlane((int)d);
        if (d >= want) break;
        __builtin_amdgcn_s_sleep(8);
    }
    __syncthreads();
}
__device__ __forceinline__ void p0_prologue(Frame& F) {
    LAS float* scr = (LAS float*)(F.lds + RING_OFF + F.wave * 16384);
    const int gw = blockIdx.x * NWAVES + F.wave, NGW = NWG * NWAVES;
    for (int it = gw; it < I_LAYER; it += NGW) conv_item(F, it, scr);
    bf16* XB = (bf16*)(F.ws + WS_XB); float* SS = (float*)(F.ws + WS_SS);
    for (int m = gw; m < M; m += NGW) {
        const GAS f32x4* xr = (const GAS f32x4*)(F.x + (size_t)m * D) + F.lane; GAS v2u* bo = (GAS v2u*)(XB + (size_t)m * D) + F.lane;
        float s = 0.f;
#pragma unroll
        for (int j = 0; j < 8; ++j) { const f32x4 v = xr[64 * j]; s += (v[0] * v[0] + v[1] * v[1]) + (v[2] * v[2] + v[3] * v[3]); v2u w; w.x = pk2(v[0], v[1]); w.y = pk2(v[2], v[3]); bo[64 * j] = w; }
        s = wave_sum(s, F.lane);
        if (F.lane < 32) SS[(size_t)m * 32 + F.lane] = (F.lane == 0) ? s : 0.f;
    }
    float* rope = (float*)(F.ws + WS_ROPE);
    for (int t = blockIdx.x * (NWAVES * 64) + F.tid; t < T * 64; t += NWG * NWAVES * 64) {
        const int pos = t >> 6, i = t & 63; const float inv = powf(10000.0f, -(float)i * (1.0f / 64.0f)); const float ang = (float)pos * inv;
        float sn, cs; sincosf(ang, &sn, &cs); rope[2 * t] = cs; rope[2 * t + 1] = sn;
    }
}

template <bool P2> __device__ __forceinline__ void ret_unit(Frame& F, int u, int layer) {
    LAS unsigned char* lds = F.lds + RING_OFF;
    const int w = F.wave, lane_u = F.lane;
    int lane = lane_u, g = lane >> 4, c16 = lane & 15;
    const int bh = u >> 4, seg = u & 15, b = bh >> 3, h = bh & 7;
    const size_t tb = (size_t)b * T + (size_t)seg * 512;
    const float l2g = l2gamma(h);
    const float cdec = ex2(l2g * 64.0f);
    const bf16* Qg = (const bf16*)(F.ws + WS_Q); const bf16* Kg = (const bf16*)(F.ws + WS_K); const bf16* Vg = (const bf16*)(F.ws + WS_V); const bf16* SGg = (const bf16*)(F.ws + WS_SG);
    bf16* RA = (bf16*)(F.ws + WS_RA);
    float* sp = (float*)(F.ws + WS_SLOC) + (size_t)(bh * 16 + seg) * (128 * 256);
    const float* gnw = F.ret_gn_w + (size_t)layer * 2048 + h * 256;
    f32x4 st[8][2];
    { int so = (32 * w + c16) * 128 + 4 * g;
#pragma unroll
      for (int dt = 0; dt < 8; ++dt) {
        asm volatile("" : "+v"(so));
        const GAS float* spl = (const GAS float*)sp + so;
#pragma unroll
        for (int et = 0; et < 2; ++et) {
            if (P2) st[dt][et] = *(const GAS f32x4*)(spl + et * 2048);
            else st[dt][et] = (f32x4){0.f, 0.f, 0.f, 0.f}; }
        so += 16; } }
    const float l2g_u = l2g;
    v4u qr[2], kr[2], vr[4];
    { const int tid = (w << 6) | lane_u;
#pragma unroll
    for (int i = 0; i < 2; ++i) { const int ch = tid + 512 * i, row = ch >> 4, c8 = ch & 15;
        if (P2) qr[i] = *(const GAS v4u*)(Qg + (tb + row) * 1024 + h * 128 + c8 * 8);
        kr[i] = *(const GAS v4u*)(Kg + (tb + row) * 1024 + h * 128 + c8 * 8); }
#pragma unroll
    for (int i = 0; i < 4; ++i) { const int ch = tid + 512 * i, row = ch >> 5, c8 = ch & 31; vr[i] = *(const GAS v4u*)(Vg + (tb + row) * 2048 + h * 256 + c8 * 8); } }
    for (int cc = 0; cc < 8; ++cc) {
        const size_t r0 = tb + (size_t)cc * 64;
        float l2g = l2g_u; asm volatile("" : "+v"(l2g));
        lane = lane_u; asm volatile("" : "+v"(lane)); g = lane >> 4; c16 = lane & 15;
        const int tid = (w << 6) | lane;
        LAS unsigned char* img = P2 ? lds : lds + (cc & 1) * R1_BUF;
#pragma unroll
        for (int i = 0; i < 2; ++i) { const int ch = tid + 512 * i, row = ch >> 4, c8 = ch & 15;
            if (P2) { *(LAS v4u*)(img + R_Q + row * PQ + c8 * 16) = qr[i]; *(LAS v4u*)(img + R_K + row * PQ + c8 * 16) = kr[i]; }
            const v4u kv = kr[i]; const float kd = ex2(l2g * (float)(63 - row));
            v4u ks; ks.x = pk2(blo(kv.x) * kd, bhi(kv.x) * kd); ks.y = pk2(blo(kv.y) * kd, bhi(kv.y) * kd); ks.z = pk2(blo(kv.z) * kd, bhi(kv.z) * kd); ks.w = pk2(blo(kv.w) * kd, bhi(kv.w) * kd);
            *(LAS v4u*)(img + (P2 ? R_KS : R1_KS) + row * PQ + c8 * 16) = ks; }
#pragma unroll
        for (int i = 0; i < 4; ++i) { const int ch = tid + 512 * i, row = ch >> 5, c8 = ch & 31; { LAS unsigned char* vp = img + (P2 ? R_V : R1_V) + row * PV + ((c8 >> 2) * 32 + (c8 & 3) * 4) * 2;
            v2u lo_, hi_; lo_.x = vr[i].x; lo_.y = vr[i].y; hi_.x = vr[i].z; hi_.y = vr[i].w; *(LAS v2u*)vp = lo_; *(LAS v2u*)(vp + 32) = hi_; } }
        __syncthreads();
        if (cc < 7) { const size_t rn = r0 + 64;
#pragma unroll
            for (int i = 0; i < 2; ++i) { const int ch = tid + 512 * i, row = ch >> 4, c8 = ch & 15;
                if (P2) qr[i] = *(const GAS v4u*)(Qg + (rn + row) * 1024 + h * 128 + c8 * 8);
                kr[i] = *(const GAS v4u*)(Kg + (rn + row) * 1024 + h * 128 + c8 * 8); }
#pragma unroll
            for (int i = 0; i < 4; ++i) { const int ch = tid + 512 * i, row = ch >> 5, c8 = ch & 31; vr[i] = *(const GAS v4u*)(Vg + (rn + row) * 2048 + h * 256 + c8 * 8); } }
        f32x4 o[2][4];
        if (P2) {
#pragma unroll
            for (int tt = 0; tt < 2; ++tt) { const int t16 = 2 * w + tt, jt = t16 >> 2, it = t16 & 3; f32x4 a = (f32x4){0.f, 0.f, 0.f, 0.f};
#pragma unroll
                for (int ks = 0; ks < 4; ++ks) { const bf16x8 A = *(const LAS bf16x8*)(lds + R_K + (16 * jt + c16) * PQ + (32 * ks + 8 * g) * 2); const bf16x8 B = *(const LAS bf16x8*)(lds + R_Q + (16 * it + c16) * PQ + (32 * ks + 8 * g) * 2);
                    a = MFMA16(A, B, a); }
                const int ii = 16 * it + c16;
#pragma unroll
                for (int r = 0; r < 4; ++r) { const int jj = 16 * jt + 4 * g + r; a[r] *= ex2(l2g * fabsf((float)(ii - jj))); }
                v2u pw; pw.x = pg8::cvt_pk_bf16(a[0], a[1]); pw.y = pg8::cvt_pk_bf16(a[2], a[3]);
                *(LAS v2u*)(lds + R_P + ii * PP + (16 * jt + 4 * g) * 2) = pw; }
            __syncthreads();
#pragma unroll
            for (int et = 0; et < 2; ++et)
#pragma unroll
                for (int it = 0; it < 4; ++it) o[et][it] = (f32x4){0.f, 0.f, 0.f, 0.f};
#pragma unroll
            for (int ks = 0; ks < 4; ++ks) { bf16x8 A[2];
#pragma unroll
                for (int et = 0; et < 2; ++et) A[et] = pack_f8(st[2 * ks][et], st[2 * ks + 1][et]);
#pragma unroll
                for (int it = 0; it < 4; ++it) { LAS const unsigned char* qp = lds + R_Q + (16 * it + c16) * PQ + (32 * ks + 4 * g) * 2;
                    const s16x4 lo = *(const LAS s16x4*)qp, hi = *(const LAS s16x4*)(qp + 32); const bf16x8 B = __builtin_shufflevector(lo, hi, 0, 1, 2, 3, 4, 5, 6, 7);
#pragma unroll
                    for (int et = 0; et < 2; ++et) o[et][it] = MFMA16(A[et], B, o[et][it]); }
                __builtin_amdgcn_sched_barrier(0); }
#pragma unroll
            for (int it = 0; it < 4; ++it) { const float qd = ex2(l2g * (float)(16 * it + c16 + 1));
#pragma unroll
                for (int et = 0; et < 2; ++et) o[et][it] *= qd; }
        }
        if (P2) {
#pragma unroll
            for (int ks2 = 0; ks2 < 2; ++ks2) { bf16x8 vf[2];
#pragma unroll
                for (int et = 0; et < 2; ++et) vf[et] = tr_frag(img + (P2 ? R_V : R1_V), PV, 32 * ks2, 32 * w + 16 * et, lane);
#pragma unroll
                for (int it = 0; it < 4; ++it) { const bf16x8 B = *(const LAS bf16x8*)(lds + R_P + (16 * it + c16) * PP + (32 * ks2 + 8 * g) * 2);
#pragma unroll
                    for (int et = 0; et < 2; ++et) o[et][it] = MFMA16(vf[et], B, o[et][it]); __builtin_amdgcn_sched_barrier(0); } }
        }
#pragma unroll
        for (int dt = 0; dt < 8; ++dt)
#pragma unroll
            for (int et = 0; et < 2; ++et) st[dt][et] *= cdec;
#pragma unroll
        for (int ks2 = 0; ks2 < 2; ++ks2) { bf16x8 vf[2];
#pragma unroll
            for (int et = 0; et < 2; ++et) vf[et] = tr_frag(img + (P2 ? R_V : R1_V), PV, 32 * ks2, 32 * w + 16 * et, lane);
#pragma unroll
            for (int dt = 0; dt < 8; ++dt) { const bf16x8 A = tr_frag(img + (P2 ? R_KS : R1_KS), PQ, 32 * ks2, 16 * dt, lane);
#pragma unroll
                for (int et = 0; et < 2; ++et) st[dt][et] = MFMA16(A, vf[et], st[dt][et]); __builtin_amdgcn_sched_barrier(0); } }
        if (P2) {
            LAS f32x2* red = (LAS f32x2*)(lds + R_RED);
            v4u sgr[4];
#pragma unroll
            for (int it = 0; it < 4; ++it) sgr[it] = *(const GAS v4u*)(SGg + (r0 + 16 * it + c16) * 2048 + h * 256 + 32 * w + 8 * g);
#pragma unroll
            for (int it = 0; it < 4; ++it) { float s1 = 0.f, s2 = 0.f;
#pragma unroll
                for (int et = 0; et < 2; ++et)
#pragma unroll
                    for (int r = 0; r < 4; ++r) { const float v = o[et][it][r]; s1 += v; s2 += v * v; }
                s1 += pg8::shx(s1, 16, lane); s1 += pg8::shx(s1, 32, lane); s2 += pg8::shx(s2, 16, lane); s2 += pg8::shx(s2, 32, lane);
                if (g == 0) red[w * 64 + 16 * it + c16] = (f32x2){s1, s2}; }
            __syncthreads();
#pragma unroll
            for (int it = 0; it < 4; ++it) { const int ii = 16 * it + c16; float S1 = 0.f, S2 = 0.f;
#pragma unroll
                for (int w8 = 0; w8 < 8; ++w8) { const f32x2 t = red[w8 * 64 + ii]; S1 += t.x; S2 += t.y; }
                const float mu = S1 * (1.0f / 256.0f), var = fmaxf(S2 * (1.0f / 256.0f) - mu * mu, 0.f), rstd = 1.0f / sqrtf(var + EPS);
                { const int col = h * 256 + 32 * w + 8 * g; const size_t off = (r0 + ii) * 2048 + col; const v4u sg = sgr[it]; v4u ow;
                  { const f32x4 gw4 = *(const f32x4*)(gnw + 32 * w + 8 * g);
                    const float y0 = (o[0][it][0] - mu) * rstd * gw4[0] * blo(sg.x), y1 = (o[0][it][1] - mu) * rstd * gw4[1] * bhi(sg.x), y2 = (o[0][it][2] - mu) * rstd * gw4[2] * blo(sg.y), y3 = (o[0][it][3] - mu) * rstd * gw4[3] * bhi(sg.y);
                    ow.x = pg8::cvt_pk_bf16(y0, y1); ow.y = pg8::cvt_pk_bf16(y2, y3); }
                  { const f32x4 gw4 = *(const f32x4*)(gnw + 32 * w + 8 * g + 4);
                    const float y0 = (o[1][it][0] - mu) * rstd * gw4[0] * blo(sg.z), y1 = (o[1][it][1] - mu) * rstd * gw4[1] * bhi(sg.z), y2 = (o[1][it][2] - mu) * rstd * gw4[2] * blo(sg.w), y3 = (o[1][it][3] - mu) * rstd * gw4[3] * bhi(sg.w);
                    ow.z = pg8::cvt_pk_bf16(y0, y1); ow.w = pg8::cvt_pk_bf16(y2, y3); }
                  *(GAS v4u*)(RA + off) = ow; } }
        }
    }
    __syncthreads();
#if !defined(SKIP_R1_STORE)
    if (!P2) {
        int so = (32 * w + c16) * 128 + 4 * g;
#pragma unroll
        for (int dt = 0; dt < 8; ++dt) {
            asm volatile("" : "+v"(so));
            GAS float* spl = (GAS float*)sp + so;
#pragma unroll
            for (int et = 0; et < 2; ++et) *(GAS f32x4*)(spl + et * 2048) = st[dt][et];
            so += 16; }
    }
#else
    if (!P2) { float acc_ = 0.f;
#pragma unroll
        for (int dt = 0; dt < 8; ++dt)
#pragma unroll
            for (int et = 0; et < 2; ++et)
#pragma unroll
                for (int r = 0; r < 4; ++r) acc_ += st[dt][et][r];
        if (acc_ == 123.456f) sp[0] = acc_; }
#endif
}
__device__ __forceinline__ void ret_scan(Frame& F) {
    float* sl = (float*)(F.ws + WS_SLOC);
    for (int idx = blockIdx.x * (NWAVES * 64) + F.tid; idx < 16 * 8192; idx += NWG * NWAVES * 64) {
        const int bh = idx >> 13, e4 = idx & 8191, h = bh & 7;
        const float l2g = l2gamma(h); const float cd8 = ex2(l2g * 512.0f);
        f32x4 carry = (f32x4){0.f, 0.f, 0.f, 0.f}; asm volatile("" : "+v"(carry));
        for (int seg = 0; seg < 16; ++seg) { GAS f32x4* p = (GAS f32x4*)(sl + (size_t)(bh * 16 + seg) * 32768) + e4; const f32x4 t = *p; *p = carry; carry = carry * cd8 + t; }
    }
}

__device__ __forceinline__ void sgu_stats(const float* LS, size_t r0, LAS f32x2* stt, int tid) {
    if (tid < 128) { const GAS f32x4* p = (const GAS f32x4*)(LS + (r0 + tid) * 64); float S1 = 0.f, S2 = 0.f;
#pragma unroll
        for (int i = 0; i < 16; ++i) { const f32x4 t = p[i]; S1 += t[0] + t[2]; S2 += t[1] + t[3]; }
        const float mu = S1 * (1.0f / 2048.0f), var = fmaxf(S2 * (1.0f / 2048.0f) - mu * mu, 0.f); stt[tid] = (f32x2){mu, 1.0f / sqrtf(var + EPS)}; }
}
__device__ __forceinline__ void sgu_phase(Frame& F, int layer) {
    LAS unsigned char* lds = F.lds + RING_OFF;
    const int w = F.wave, lane_u = F.lane;
    int lane = lane_u, tid = (w << 6) | lane, g = lane >> 4, c16 = lane & 15;
    const bf16* ZU = (const bf16*)(F.ws + WS_ZU); const bf16* ZV = (const bf16*)(F.ws + WS_ZV); bf16* SB = (bf16*)(F.ws + WS_SB);
    const float* LS = (const float*)(F.ws + WS_LS);
    int cg_loaded = -1;
    v4u zvr[8];
    int u = blockIdx.x;
    if (u < 1024) { const int cg = u & 7; const size_t r0 = (size_t)(u >> 3) * 128;
#pragma unroll
        for (int i = 0; i < 8; ++i) { const int ch = tid + 512 * i, j = ch >> 5, c8 = ch & 31; zvr[i] = *(const GAS v4u*)(ZV + (r0 + j) * 2048 + 256 * cg + 8 * c8); }
        sgu_stats(LS, r0, (LAS f32x2*)(lds + S_ST), tid); }
    for (int it_u = 0; u < 1024; u += NWG, ++it_u) {
        lane = lane_u; asm volatile("" : "+v"(lane)); tid = (w << 6) | lane; g = lane >> 4; c16 = lane & 15;
        const int cg = u & 7, rg = u >> 3; const size_t r0 = (size_t)rg * 128; const int ch0 = 256 * cg;
        const float* lnw = F.sgu_ln_w + (size_t)layer * 2048 + ch0; const float* lnb = F.sgu_ln_b + (size_t)layer * 2048 + ch0;
        const float* bs = F.sgu_b_s + ((size_t)layer * 8 + cg) * 128;
        LAS f32x2* stt = (LAS f32x2*)(lds + S_ST + (it_u & 1) * 1024);
        if (cg != cg_loaded) { const float* wsrc = F.sgu_w_s + ((size_t)layer * 8 + cg) * (128 * 128); cg_loaded = cg;
#pragma unroll
            for (int i = 0; i < 8; ++i) { const int idx4 = tid + 512 * i, ir = idx4 >> 5, j4 = (idx4 & 31) * 4; f32x4 wv = *(const GAS f32x4*)(wsrc + ir * 128 + j4);
                if ((j4 >> 6) > (ir >> 6)) wv = (f32x4){0.f, 0.f, 0.f, 0.f};
                v2u pw; pw.x = pk2(wv[0], wv[1]); pw.y = pk2(wv[2], wv[3]); *(LAS v2u*)(lds + S_W + ir * PQ + j4 * 2) = pw; } }
        if (it_u == 0) __syncthreads();
#pragma unroll
        for (int i = 0; i < 8; ++i) { const int ch = tid + 512 * i, j = ch >> 5, c8 = ch & 31; const v4u zv = zvr[i];
            const f32x4 w0 = *(const f32x4*)(lnw + 8 * c8), w1 = *(const f32x4*)(lnw + 8 * c8 + 4), b0 = *(const f32x4*)(lnb + 8 * c8), b1 = *(const f32x4*)(lnb + 8 * c8 + 4);
            const f32x2 ms = stt[j]; const float mu = ms.x, rs = ms.y;
            v4u o; o.x = pk2((blo(zv.x) - mu) * rs * w0[0] + b0[0], (bhi(zv.x) - mu) * rs * w0[1] + b0[1]); o.y = pk2((blo(zv.y) - mu) * rs * w0[2] + b0[2], (bhi(zv.y) - mu) * rs * w0[3] + b0[3]);
            o.z = pk2((blo(zv.z) - mu) * rs * w1[0] + b1[0], (bhi(zv.z) - mu) * rs * w1[1] + b1[1]); o.w = pk2((blo(zv.w) - mu) * rs * w1[2] + b1[2], (bhi(zv.w) - mu) * rs * w1[3] + b1[3]);
            { LAS unsigned char* vp = lds + S_VN + j * PV + ((c8 >> 2) * 32 + (c8 & 3) * 4) * 2;
              v2u lo_, hi_; lo_.x = o.x; lo_.y = o.y; hi_.x = o.z; hi_.y = o.w; *(LAS v2u*)vp = lo_; *(LAS v2u*)(vp + 32) = hi_; } }
        __syncthreads();
        const int un = u + NWG;
        if (un < 1024) { const size_t rn = (size_t)(un >> 3) * 128; const int cgn = un & 7;
#pragma unroll
            for (int i = 0; i < 8; ++i) { const int ch = tid + 512 * i, j = ch >> 5, c8 = ch & 31; zvr[i] = *(const GAS v4u*)(ZV + (rn + j) * 2048 + 256 * cgn + 8 * c8); }
            sgu_stats(LS, rn, (LAS f32x2*)(lds + S_ST + ((it_u + 1) & 1) * 1024), tid); }
        v4u zur[8];
#pragma unroll
        for (int it = 0; it < 8; ++it) zur[it] = *(const GAS v4u*)(ZU + (r0 + 16 * it + c16) * 2048 + ch0 + 32 * w + 8 * g);
        f32x4 acc[2][8];
#pragma unroll
        for (int ct = 0; ct < 2; ++ct)
#pragma unroll
            for (int it = 0; it < 8; ++it) acc[ct][it] = (f32x4){0.f, 0.f, 0.f, 0.f};
#pragma unroll
        for (int ks = 0; ks < 4; ++ks) { bf16x8 A[2];
#pragma unroll
            for (int ct = 0; ct < 2; ++ct) A[ct] = tr_frag(lds + S_VN, PV, 32 * ks, 32 * w + 16 * ct, lane);
#pragma unroll
            for (int it = 0; it < 8; ++it) { if (it < 4 && ks >= 2) continue;
                const bf16x8 B = *(const LAS bf16x8*)(lds + S_W + (16 * it + c16) * PQ + (32 * ks + 8 * g) * 2);
#pragma unroll
                for (int ct = 0; ct < 2; ++ct) acc[ct][it] = MFMA16(A[ct], B, acc[ct][it]); __builtin_amdgcn_sched_barrier(0); } }
#pragma unroll
        for (int it = 0; it < 8; ++it) { const int ii = 16 * it + c16; const float bsv = bs[ii];
            { const size_t off = (r0 + ii) * 2048 + ch0 + 32 * w + 8 * g; const v4u zu = zur[it];
                v4u ow; ow.x = pg8::cvt_pk_bf16(blo(zu.x) * (acc[0][it][0] + bsv), bhi(zu.x) * (acc[0][it][1] + bsv)); ow.y = pg8::cvt_pk_bf16(blo(zu.y) * (acc[0][it][2] + bsv), bhi(zu.y) * (acc[0][it][3] + bsv));
                ow.z = pg8::cvt_pk_bf16(blo(zu.z) * (acc[1][it][0] + bsv), bhi(zu.z) * (acc[1][it][1] + bsv)); ow.w = pg8::cvt_pk_bf16(blo(zu.w) * (acc[1][it][2] + bsv), bhi(zu.w) * (acc[1][it][3] + bsv));
                *(GAS v4u*)(SB + off) = ow; } }
        __syncthreads();
    }
}

__device__ __forceinline__ void final_norm(Frame& F) {
    const int gw = blockIdx.x * NWAVES + F.wave, NGW = NWG * NWAVES;
    const bf16* XB = (const bf16*)(F.ws + WS_XB); const float* SS = (const float*)(F.ws + WS_SS);
    for (int m = gw; m < M; m += NGW) {
        const float s = wave_sum(F.lane < 32 ? SS[(size_t)m * 32 + F.lane] : 0.f, F.lane); const float rstd = 1.0f / sqrtf(s * (1.0f / 2048.0f) + EPS);
        const GAS v2u* xr = (const GAS v2u*)(XB + (size_t)m * D) + F.lane; const GAS f32x4* fw = (const GAS f32x4*)F.final_norm_w + F.lane; GAS f32x4* o = (GAS f32x4*)(F.out + (size_t)m * D) + F.lane;
#pragma unroll
        for (int j = 0; j < 8; ++j) { const v2u w = xr[64 * j]; const f32x4 g = fw[64 * j]; o[64 * j] = (f32x4){blo(w.x) * rstd * g[0], bhi(w.x) * rstd * g[1], blo(w.y) * rstd * g[2], bhi(w.y) * rstd * g[3]}; }
    }
}

#if defined(PROBE_STOP)
__device__ __forceinline__ void probe_dump(Frame& F) {
    const size_t offs[12] = {WS_V, WS_SG, WS_ZU, WS_ZV, WS_GA, WS_GB, WS_RA, WS_SB, WS_MG, WS_XB, WS_P, 0};
    for (size_t i = (size_t)blockIdx.x * 512 + F.tid; i < (size_t)M * D; i += (size_t)NWG * 512) {
        float a = 0.f; const size_t m = i >> 11, c = i & 2047;
#pragma unroll
        for (int b = 0; b < 11; ++b) if (PROBE_MASK & (1 << b)) a += blo((unsigned)((const bf16*)(F.ws + offs[b]))[i]);
        if (PROBE_MASK & (1 << 11)) { if (c < 1024) a += blo((unsigned)((const bf16*)(F.ws + WS_Q))[m * 1024 + c]) + blo((unsigned)((const bf16*)(F.ws + WS_K))[m * 1024 + c]); }
        if (PROBE_MASK & (1 << 12)) a += blo((unsigned)((const bf16*)(F.ws + WS_H))[m * 5632 + c]) + blo((unsigned)((const bf16*)(F.ws + WS_H))[m * 5632 + 2048 + c]) + ((c < 1536) ? blo((unsigned)((const bf16*)(F.ws + WS_H))[m * 5632 + 4096 + c]) : 0.f);
        if (PROBE_MASK & (1 << 13)) { if (i < (size_t)D * D) a += blo((unsigned)((const bf16*)(F.ws + WS_W + W_R))[i]); }
        if (PROBE_MASK & (1 << 14)) { if (i < (size_t)D * D) a += blo((unsigned)((const bf16*)(F.ws + WS_W + W_S))[i]) + blo((unsigned)((const bf16*)(F.ws + WS_W + W_O))[i]); }
        F.out[i] = a;
    }
}
#endif
constexpr int PH_PER_LAYER = 8, NPHASES = 2 + DEPTH * PH_PER_LAYER;
struct Args { const float* in[15]; float* out; unsigned char* ws; int ph_lo, ph_hi; };
static_assert(sizeof(Args) == 15 * 8 + 8 + 8 + 8, "Args has no padding");
__global__ void __launch_bounds__(NWAVES * 64, 2) mk_fwd(Args args) {
    extern __shared__ __attribute__((aligned(16))) unsigned char lds_raw[];
    Frame F;
    F.lds = (LAS unsigned char*)lds_raw;
    F.tid = threadIdx.x; F.lane = F.tid & 63; F.wave = __builtin_amdgcn_readfirstlane(F.tid >> 6);
    F.x = args.in[0]; F.norm_mix_w = args.in[1]; F.w_in = args.in[2]; F.ret_gn_w = args.in[3]; F.ret_proj = args.in[4]; F.sgu_ln_w = args.in[5]; F.sgu_ln_b = args.in[6]; F.sgu_w_s = args.in[7];
    F.sgu_b_s = args.in[8]; F.sgu_proj = args.in[9]; F.w_out = args.in[10]; F.norm_ffn_w = args.in[11]; F.w_ffn_in = args.in[12]; F.w_ffn_out = args.in[13]; F.final_norm_w = args.in[14];
    F.out = args.out; F.ws = args.ws;
#if defined(ZERO_LDS)
    for (int u = F.tid; u < LDS_BYTES / 4; u += NWAVES * 64) ((LAS unsigned*)(F.lds))[u] = 0u;
#else
    for (int u = F.tid; u < (LDS_BYTES - LDSCTL_OFF) / 4; u += NWAVES * 64) ((LAS unsigned*)(F.lds + LDSCTL_OFF))[u] = 0u;
#endif
    __syncthreads();
#if MK_PER_PHASE || defined(PROBE_STOP)
    const int lo = args.ph_lo, hi = args.ph_hi;
#else
    constexpr int lo = 0, hi = NPHASES;
#endif
    unsigned* ctl = (unsigned*)(F.ws + WS_CTL);
#if defined(TAIL_MIN)
    if (blockIdx.x == 0 && threadIdx.x == 0) ((unsigned long long*)(ctl + 2048))[1] = ~0ull;
#endif
    XcdBarrier bar; bar.bar = ctl + CW_BAR; bar.x = 0; bar.st = nullptr;
    if (hi - lo > 1) bar = xcd_barrier_post(ctl + CW_BAR, (volatile LAS unsigned*)(F.lds + MISC_OFF) + 8);
#ifndef MK_ONLY
#define MK_ONLY -1
#endif
#if defined(PROBE_STOP)
#define IN(k) (lo <= (k) && (k) < hi && ((k) <= PROBE_STOP || (k) == NPHASES - 1))
#elif MK_PER_PHASE
#define IN(k) (lo <= (k) && (k) < hi)
#else
#define IN(k) true
#endif
#define INP(slot, k) ((MK_ONLY < 0 || MK_ONLY == (slot)) && IN(k))
#ifndef DUP_SLOT
#define DUP_SLOT -1
#endif
#define REP(slot) for (int rep_ = 0; rep_ < ((DUP_SLOT == (slot)) ? 2 : 1); ++rep_)
#if defined(TAIL_PROBE)
    unsigned long long wait_sum = 0ull;
#ifndef TAIL_MASK
#define TAIL_MASK 0x1ff
#endif
#define SEAM(k) do { if (IN(k) && IN((k) + 1)) { const unsigned long long t0_ = wall_clock64(); xcd_barrier(bar); const int st_ = ((k) == 0) ? 8 : (((k) - 1) & 7); if ((TAIL_MASK >> st_) & 1) wait_sum += wall_clock64() - t0_; } } while (0)
#elif defined(DUP_BARRIER)
#define SEAM(k) do { if (IN(k) && IN((k) + 1)) { xcd_barrier(bar); xcd_barrier(bar); } } while (0)
#else
#define SEAM(k) do { if (IN(k) && IN((k) + 1)) { FRESH(); XcdBarrier b2_ = bar; b2_.bar = (unsigned*)(F.ws + WS_CTL) + CW_BAR; { unsigned so_ = MISC_OFF + 32; asm volatile("" : "+s"(so_)); b2_.st = (volatile LAS unsigned*)(F.lds + so_); } xcd_barrier_idle(b2_, F, F.tid); } } while (0)
#endif
    size_t zero_o = 0; const int wave_s = __builtin_amdgcn_readfirstlane(threadIdx.x >> 6);
#define FRESH() do { asm volatile("" : "+s"(zero_o)); int l_; asm volatile("v_mbcnt_lo_u32_b32 %0, -1, 0\n\tv_mbcnt_hi_u32_b32 %0, -1, %0" : "=v"(l_)); F.ws = args.ws + zero_o; F.lane = l_; F.wave = wave_s; F.tid = (wave_s << 6) | l_; } while (0)
#if defined(START_DELAY)
    if (IN(0)) { const unsigned long long t0 = wall_clock64(); while (wall_clock64() - t0 < 100ull * START_DELAY) __builtin_amdgcn_s_sleep(32); }
#endif
    if (INP(0, 0)) REP(0) { FRESH(); p0_prologue(F); }
    SEAM(0);
    for (int l = 0; l < DEPTH; ++l) {
        const int pb = 1 + PH_PER_LAYER * l;
        if (INP(1, pb + 0)) REP(1) { FRESH(); unsigned char* wl = F.ws + WS_W + (size_t)l * W_LAYER;
            pg8::Gemm gm{(const pg8::bf16_t*)(F.ws + WS_XB), (const pg8::bf16_t*)(wl + W_IN), M, NIN, D}; pg8::StaticOrder S; S.init(M, NIN, NWG, (int)blockIdx.x);
#if defined(G1_REV)
            pg8::RevOrder SR; SR.base = S;
#endif
            pg8::Unit u0; S.next(0, u0); const LAS float* rstab = (const LAS float*)(F.lds + RSTAB_OFF); pg8::rstd_table((const float*)(F.ws + WS_SS), u0.pm, (LAS float*)(F.lds + RSTAB_OFF), F.tid);
            pg8::EpiIn E{(const float*)(F.ws + WS_SS), (const float*)(F.ws + WS_ROPE), (pg8::bf16_t*)(F.ws + WS_Q), (pg8::bf16_t*)(F.ws + WS_K), (pg8::bf16_t*)(F.ws + WS_O2048), (float*)(F.ws + WS_LS), rstab, u0.pm};
#if defined(TIMING_NULL_G1)
#if defined(TIMING_SAME_TILE)
            if (rep_ == 1) { pg8::EpiNull EN{(float*)(F.ws + WS_SLOC)}; pg8::SameTileOrder ST{14}; pg8::gemm_phase<pg8::EpiNull, pg8::SameTileOrder, true, true>(F.lds + RING_OFF, gm, ST, EN, F.tid); } else
#else
#if defined(TIMING_NOSP2)
            if (rep_ == 1) { pg8::EpiNull EN{(float*)(F.ws + WS_SLOC)}; pg8::gemm_phase<pg8::EpiNull, pg8::StaticOrder, true, false>(F.lds + RING_OFF, gm, S, EN, F.tid); } else
#elif defined(TIMING_MM32)
            if (rep_ == 1) { pg8::EpiNull EN{(float*)(F.ws + WS_SLOC)}; pg8::gemm_phase<pg8::EpiNull, pg8::StaticOrder, true, true, true>(F.lds + RING_OFF, gm, S, EN, F.tid); } else
#else
            if (rep_ == 1) { pg8::EpiNull EN{(float*)(F.ws + WS_SLOC)}; pg8::gemm_phase<pg8::EpiNull, pg8::StaticOrder, true, true>(F.lds + RING_OFF, gm, S, EN, F.tid); } else
#endif
#endif
#endif
#if defined(G1_REV)
            pg8::gemm_phase<pg8::EpiIn, pg8::RevOrder, true, true>(F.lds + RING_OFF, gm, SR, E, F.tid);
#else
            pg8::gemm_phase<pg8::EpiIn, pg8::StaticOrder, true, true>(F.lds + RING_OFF, gm, S, E, F.tid);
#endif
        }
        SEAM(pb + 0);
        if (INP(2, pb + 1)) REP(2) { FRESH();
#if !defined(SKIP_R1)
#if defined(DUPSKIP_R1)
            if (rep_ == 0)
#endif
            for (int u = blockIdx.x; u < 256; u += NWG) ret_unit<false>(F, u, l);
#endif
#if defined(SLEEP_R1)
            { const unsigned long long t0 = wall_clock64(); while (wall_clock64() - t0 < 100ull * SLEEP_R1) __builtin_amdgcn_s_sleep(32); }
#endif
#if defined(DUMMY_R1)
            { const GAS v4u* src = (const GAS v4u*)(F.ws + WS_K); unsigned a_ = 0;
              for (size_t i = (size_t)blockIdx.x * 512 + F.tid; i < (size_t)96 * MiB / 16; i += (size_t)NWG * 512) { const v4u t = src[i]; a_ += t.x ^ t.y ^ t.z ^ t.w; }
              if (a_ == 0x12345678u) ((float*)(F.ws + WS_SLOC))[0] = 1.f; }
#endif
#if !defined(SGU_AFTER_R3)
            FRESH();
#if !defined(SKIP_SGU)
#if defined(DUPSKIP_SGU)
            if (rep_ == 0)
#endif
            sgu_phase(F, l);
#endif
#endif
        }
        SEAM(pb + 1);
        if (INP(3, pb + 2)) { FRESH(); ret_scan(F); }
        SEAM(pb + 2);
#if defined(SGU_AFTER_R3)
        if (INP(4, pb + 3)) REP(4) { FRESH(); for (int u = blockIdx.x; u < 256; u += NWG) ret_unit<true>(F, u, l); FRESH(); sgu_phase(F, l); }
#else
        if (INP(4, pb + 3)) REP(4) { FRESH(); for (int u = blockIdx.x; u < 256; u += NWG) ret_unit<true>(F, u, l); }
#endif
        SEAM(pb + 3);
        if (INP(5, pb + 4)) REP(5) { FRESH(); unsigned char* wl = F.ws + WS_W + (size_t)l * W_LAYER;
            pg8::Gemm gm{(const pg8::bf16_t*)(F.ws + WS_RA), (const pg8::bf16_t*)(wl + W_R), M, D, D}; pg8::PairOrder S; S.base.init(M, D, NWG, (int)blockIdx.x);
            pg8::EpiMerge E{(const pg8::bf16_t*)(F.ws + WS_GA), (const pg8::bf16_t*)(F.ws + WS_GB), (pg8::bf16_t*)(F.ws + WS_MG)};
            pg8::gemm_phase<pg8::EpiMerge, pg8::PairOrder, true, true>(F.lds + RING_OFF, gm, S, E, F.tid);
        }
        SEAM(pb + 4);
        if (INP(6, pb + 5)) REP(6) { FRESH(); unsigned char* wl = F.ws + WS_W + (size_t)l * W_LAYER;
            pg8::Gemm gm{(const pg8::bf16_t*)(F.ws + WS_MG), (const pg8::bf16_t*)(wl + W_O), M, D, D}; pg8::StaticOrder S; S.init(M, D, NWG, (int)blockIdx.x);
            pg8::EpiResid E{(pg8::bf16_t*)(F.ws + WS_XB), (float*)(F.ws + WS_SS2), (rep_ == 1) ? 0.f : 1.f};
#if defined(TIMING_NULL_G35)
            if (rep_ == 1) { pg8::EpiNull EN{(float*)(F.ws + WS_SLOC)}; pg8::gemm_phase<pg8::EpiNull, pg8::StaticOrder, true, true>(F.lds + RING_OFF, gm, S, EN, F.tid); } else
#endif
            pg8::gemm_phase<pg8::EpiResid, pg8::StaticOrder, true, true>(F.lds + RING_OFF, gm, S, E, F.tid);
        }
        SEAM(pb + 5);
        if (INP(7, pb + 6)) REP(7) { FRESH(); unsigned char* wl = F.ws + WS_W + (size_t)l * W_LAYER;
            pg8::Gemm gm{(const pg8::bf16_t*)(F.ws + WS_XB), (const pg8::bf16_t*)(wl + W_F1), M, NFF, D}; pg8::StaticOrder S; S.init(M, NFF, NWG, (int)blockIdx.x);
            pg8::Unit u0; S.next(0, u0); const LAS float* rstab = (const LAS float*)(F.lds + RSTAB_OFF); pg8::rstd_table((const float*)(F.ws + WS_SS2), u0.pm, (LAS float*)(F.lds + RSTAB_OFF), F.tid);
            pg8::EpiSwiglu E{(const float*)(F.ws + WS_SS2), (pg8::bf16_t*)(F.ws + WS_H), rstab, u0.pm};
#if defined(G4_REV)
            { pg8::RevOrder SR; SR.base = S; pg8::gemm_phase<pg8::EpiSwiglu, pg8::RevOrder, true, true>(F.lds + RING_OFF, gm, SR, E, F.tid); }
#else
            pg8::gemm_phase<pg8::EpiSwiglu, pg8::StaticOrder, true, true>(F.lds + RING_OFF, gm, S, E, F.tid);
#endif
        }
        SEAM(pb + 6);
        if (INP(8, pb + 7)) REP(8) { FRESH(); unsigned char* wl = F.ws + WS_W + (size_t)l * W_LAYER;
            pg8::Gemm gm{(const pg8::bf16_t*)(F.ws + WS_H), (const pg8::bf16_t*)(wl + W_F2), M, D, DFF}; pg8::StaticOrder S; S.init(M, D, NWG, (int)blockIdx.x);
            pg8::EpiResid E{(pg8::bf16_t*)(F.ws + WS_XB), (float*)(F.ws + WS_SS), (rep_ == 1) ? 0.f : 1.f};
#if defined(TIMING_NULL_G35)
            if (rep_ == 1) { pg8::EpiNull EN{(float*)(F.ws + WS_SLOC)}; pg8::gemm_phase<pg8::EpiNull, pg8::StaticOrder, true, true>(F.lds + RING_OFF, gm, S, EN, F.tid); } else
#endif
            pg8::gemm_phase<pg8::EpiResid, pg8::StaticOrder, true, true>(F.lds + RING_OFF, gm, S, E, F.tid);
        }
        if (IN(pb + 7) && l + 1 < DEPTH) conv_finish(F, l + 1);
        SEAM(pb + 7);
    }
#if defined(TAIL_PROBE)
    if (hi - lo > 1) { unsigned long long* accp = (unsigned long long*)(ctl + 2048);
#if defined(TAIL_MIN)
        if (F.tid == 0) atomicMin(accp + 1, wait_sum);
#else
        if (F.tid == 0) atomicAdd(accp, wait_sum);
#endif
        xcd_barrier(bar);
        if (blockIdx.x == 0 && F.tid == 0) {
#if defined(TAIL_MIN)
            const unsigned long long avg = __hip_atomic_load(accp + 1, __ATOMIC_RELAXED, __HIP_MEMORY_SCOPE_AGENT);
#else
            const unsigned long long tot = __hip_atomic_load(accp, __ATOMIC_RELAXED, __HIP_MEMORY_SCOPE_AGENT); const unsigned long long avg = tot / gridDim.x;
#endif
            const unsigned long long t0_ = wall_clock64(); while (wall_clock64() - t0_ < avg * TAIL_PROBE) __builtin_amdgcn_s_sleep(32); } }
#endif
#if defined(END_WB)
    asm volatile("s_waitcnt vmcnt(0)" ::: "memory"); __builtin_amdgcn_fence(__ATOMIC_RELEASE, "agent"); asm volatile("s_waitcnt vmcnt(0)" ::: "memory");
#endif
#if defined(PROBE_STOP)
    if (hi - lo > 1) xcd_barrier(bar);
    if (IN(NPHASES - 1)) { FRESH(); probe_dump(F); }
#else
    if (INP(9, NPHASES - 1)) { FRESH(); final_norm(F); }
#endif
#undef IN
#undef INP
#undef FRESH
#undef SEAM
}

extern "C" void kernel_launch(void* const* d_in, const int* in_sizes, int n_in, void* d_out, int out_size, void* d_ws, size_t ws_size, hipStream_t stream) {
    static int grid = 0;
    if (grid == 0) {
        if (n_in != 15 || in_sizes[0] != M * D || out_size != M * D || ws_size < WS_END) { fprintf(stderr, "kernel_launch: unexpected sizes (n_in %d, in0 %d, out %d, ws %zu < %zu?)\n", n_in, n_in > 0 ? in_sizes[0] : -1, out_size, ws_size, (size_t)WS_END); grid = -1; return; }
        int dev = 0, cus = 0, per_cu = 0;
        if (hipGetDevice(&dev) != hipSuccess || hipDeviceGetAttribute(&cus, hipDeviceAttributeMultiprocessorCount, dev) != hipSuccess) { grid = -1; return; }
        if (hipFuncSetAttribute((const void*)mk_fwd, hipFuncAttributeMaxDynamicSharedMemorySize, LDS_BYTES) != hipSuccess) { fprintf(stderr, "kernel_launch: hipFuncSetAttribute failed\n"); grid = -1; return; }
        if (hipOccupancyMaxActiveBlocksPerMultiprocessor(&per_cu, (const void*)mk_fwd, NWAVES * 64, LDS_BYTES) != hipSuccess || per_cu < 1) fprintf(stderr, "kernel_launch: occupancy query reports %d\n", per_cu);
        (void)hipGetLastError();
        if (cus < NWG) { fprintf(stderr, "kernel_launch: built for a %d-CU device (one resident workgroup per CU), this one has %d; nothing launched\n", NWG, cus); grid = -1; return; }
        grid = NWG;
    }
    if (grid < 0) return;
    if (hipMemsetAsync((char*)d_ws + WS_CTL, 0, CTL_ZERO_BYTES, stream) != hipSuccess) return;
    Args a{};
    for (int i = 0; i < 15; ++i) a.in[i] = (const float*)d_in[i];
    a.out = (float*)d_out; a.ws = (unsigned char*)d_ws;
#if MK_PER_PHASE
    for (int p = 0; p < NPHASES; ++p) { a.ph_lo = p; a.ph_hi = p + 1; hipLaunchKernelGGL(mk_fwd, dim3(grid), dim3(NWAVES * 64), LDS_BYTES, stream, a); }
#else
    a.ph_lo = 0; a.ph_hi = NPHASES; hipLaunchKernelGGL(mk_fwd, dim3(grid), dim3(NWAVES * 64), LDS_BYTES, stream, a);
#endif
}
```

```cpp
#define G1_REV 1
#define G4_REV 1
#include <hip/hip_runtime.h>
#include <cstdio>
#include <cstdint>
namespace pg8 {
#define PG8_LAS __attribute__((address_space(3)))
typedef unsigned short bf16_t;
typedef short bf16x8 __attribute__((ext_vector_type(8)));
typedef float f32x4 __attribute__((ext_vector_type(4)));
typedef float f32x16 __attribute__((ext_vector_type(16)));
typedef unsigned u32x4 __attribute__((ext_vector_type(4)));
constexpr int BM = 256, BK = 64, HALF = 128, HTB = HALF * BK * 2  , STAGE_BYTES = 8 * HTB, NXCD = 8, WGM = 8;

__host__ __device__ __forceinline__ int lds_byte(int r, int c) { const int st = (r >> 4) * 2 + (c >> 5), rr = r & 15, cc = c & 31, ob = rr * 64 + cc * 2; return st * 1024 + (ob ^ (((ob >> 9) & 1) << 5)); }
__host__ __device__ __forceinline__ void stage_rc(int b, int& R, int& C) { const int st = b / 1024, sb = b % 1024, swz = sb ^ (((sb >> 9) & 1) << 5); R = (st >> 1) * 16 + swz / 64; C = (st & 1) * 32 + (swz % 64) / 2; }
__host__ __device__ __forceinline__ int perm32(int rho) { const int n = rho >> 4, i = rho & 15; return 8 * (i >> 2) + 4 * n + (i & 3); }

struct Unit { int pm, pn; };
struct Gemm { const bf16_t* A; const bf16_t* Bt; int M, N, K; };

struct StaticOrder {
    int nM, nN, nwg, G, c;
    __host__ __device__ __forceinline__ void init(int M, int N, int G_, int c_) { nM = M / BM; nN = N / BM; nwg = nM * nN; G = G_; c = c_; }
    __host__ __device__ __forceinline__ bool next(int i, Unit& u) const {
        const long L = (long)i * G + c; if (L >= nwg) return false;
        int wgid = (int)L; { const int q = nwg / NXCD, r = nwg % NXCD, xcd = wgid % NXCD, off = wgid / NXCD; wgid = (xcd < r ? xcd * (q + 1) : r * (q + 1) + (xcd - r) * q) + off; }
        const int nig = WGM * nN, gid = wgid / nig, fm = gid * WGM, gsz = (nM - fm) < WGM ? (nM - fm) : WGM;
        u.pm = fm + ((wgid % nig) % gsz); u.pn = (wgid % nig) / gsz; return true;
    }
    __device__ __forceinline__ void a_ready(const Unit&) const {}
    __device__ __forceinline__ void done(const Unit&) const {}
};

typedef float f32x2c_t __attribute__((ext_vector_type(2))); typedef __bf16 bf16x2c_t __attribute__((ext_vector_type(2)));
__device__ __forceinline__ unsigned cvt_pk_bf16(float lo, float hi) { const f32x2c_t v = {lo, hi}; const bf16x2c_t b = __builtin_convertvector(v, bf16x2c_t); return __builtin_bit_cast(unsigned, b); }
typedef float f32x2 __attribute__((ext_vector_type(2)));
__device__ __forceinline__ f32x2 gelu_pk(f32x2 v) {
    const f32x2 av = __builtin_elementwise_abs(v), d = av * 0.2316418882f + 1.0f;
    f32x2 t; t.x = __builtin_amdgcn_rcpf(d.x); t.y = __builtin_amdgcn_rcpf(d.y);
    f32x2 q = t * 0.5307027145f + (-0.7265760135f); q = q * t + 0.7107068705f; q = q * t + (-0.142248368f); q = q * t + 0.127414796f; q = q * t;
    const f32x2 s = (v * v) * (-0.72134752044f);
    f32x2 e; e.x = __builtin_amdgcn_exp2f(s.x); e.y = __builtin_amdgcn_exp2f(s.y);
    const f32x2 m = v * (q * e), r = v - m;
    f32x2 o; o.x = v.x < 0.f ? m.x : r.x; o.y = v.y < 0.f ? m.y : r.y; return o;
}

constexpr int MROWS = 16384, DM = 2048;
constexpr float RMS_EPS = 1e-6f;
__device__ __forceinline__ float shx(float v, int o, int lane) { return __builtin_bit_cast(float, __builtin_amdgcn_ds_bpermute((lane ^ o) << 2, __builtin_bit_cast(int, v))); }
__device__ __forceinline__ float sigm_f(float x) { return __builtin_amdgcn_rcpf(1.0f + __builtin_amdgcn_exp2f(x * -1.44269504089f)); }
__device__ __forceinline__ float silu_f(float x) { return x * sigm_f(x); }
__device__ __forceinline__ float bf_lo(unsigned w) { return __uint_as_float(w << 16); }
__device__ __forceinline__ float bf_hi(unsigned w) { return __uint_as_float(w & 0xffff0000u); }
__device__ __forceinline__ u32x4 pack8(const f32x4& a, const f32x4& b) { u32x4 w; w.x = cvt_pk_bf16(a[0], a[1]); w.y = cvt_pk_bf16(a[2], a[3]); w.z = cvt_pk_bf16(b[0], b[1]); w.w = cvt_pk_bf16(b[2], b[3]); return w; }
__device__ __forceinline__ float row_rstd1(const float* ss, int row, int fq) {
    const float* p = ss + (size_t)row * 32 + 8 * fq; const f32x4 a = *(const f32x4*)p, b = *(const f32x4*)(p + 4);
    float s = ((a[0] + a[1]) + (a[2] + a[3])) + ((b[0] + b[1]) + (b[2] + b[3])); { int ln; asm volatile("v_mbcnt_lo_u32_b32 %0, -1, 0\n\tv_mbcnt_hi_u32_b32 %0, -1, %0" : "=v"(ln)); s += shx(s, 16, ln); s += shx(s, 32, ln); }
    return 1.0f / sqrtf(s * (1.0f / 2048.0f) + RMS_EPS);
}

__device__ __forceinline__ void rstd_table(const float* ss, int pm0, PG8_LAS float* tab, int tid) {
    if (tid < 256) { const f32x4* p = (const f32x4*)(ss + (size_t)(pm0 * BM + tid) * 32); float s = 0.f;
#pragma unroll
        for (int i = 0; i < 8; ++i) { const f32x4 a = p[i]; s += (a[0] + a[1]) + (a[2] + a[3]); }
        tab[tid] = 1.0f / sqrtf(s * (1.0f / 2048.0f) + RMS_EPS); }
    __syncthreads();
}
#define ROW_RSTD(ss_, tab_, pm0_, u_, rl_, row_, fq_) (((u_).pm == (pm0_)) ? (tab_)[(rl_)] : row_rstd1((ss_), (row_), (fq_)))

struct EpiIn {
    static constexpr bool PERM = true, AFTER_DRAIN = false, CARRY = false;
    const float* ss;
    const float* rope;
    bf16_t* q; bf16_t* k;
    bf16_t* o2048;
    float* ls;
    const PG8_LAS float* rstab; int pm0;
    template <int ACT> __device__ __forceinline__ void emit(const f32x4 (&acc)[2][2][4][2], const Unit& u, bf16_t* base, int row0, int rl0, int col0, int slot0, int fq) const {
#pragma unroll
        for (int ai = 0; ai < 2; ++ai)
#pragma unroll
            for (int m = 0; m < 4; ++m) { const int row = row0 + ai * HALF + m * 16; const float r = ROW_RSTD(ss, rstab, pm0, u, rl0 + ai * HALF + m * 16, row, fq); bf16_t* rowp = base + (size_t)row * DM + col0; float s1 = 0.f, s2 = 0.f;
#pragma unroll
                for (int bj = 0; bj < 2; ++bj) { f32x4 v0 = acc[ai][bj][m][0] * r, v1 = acc[ai][bj][m][1] * r;
                    if (ACT == 1) {
#pragma unroll
                        for (int j = 0; j < 4; ++j) { v0[j] = silu_f(v0[j]); v1[j] = silu_f(v1[j]); } }
                    if (ACT == 2 || ACT == 3) { const f32x2 a = gelu_pk((f32x2){v0[0], v0[1]}), b = gelu_pk((f32x2){v0[2], v0[3]}), c = gelu_pk((f32x2){v1[0], v1[1]}), d = gelu_pk((f32x2){v1[2], v1[3]});
                        v0 = (f32x4){a.x, a.y, b.x, b.y}; v1 = (f32x4){c.x, c.y, d.x, d.y}; }
                    if (ACT == 4) {
#pragma unroll
                        for (int j = 0; j < 4; ++j) { v0[j] = sigm_f(v0[j]); v1[j] = sigm_f(v1[j]); } }
                    if (ACT == 3) { s1 += ((v0[0] + v0[1]) + (v0[2] + v0[3])) + ((v1[0] + v1[1]) + (v1[2] + v1[3]));
                        s2 += ((v0[0] * v0[0] + v0[1] * v0[1]) + (v0[2] * v0[2] + v0[3] * v0[3])) + ((v1[0] * v1[0] + v1[1] * v1[1]) + (v1[2] * v1[2] + v1[3] * v1[3])); }
                    *(u32x4*)(rowp + bj * HALF) = pack8(v0, v1); }
                if (ACT == 3) { const int ln = (row0 & 15) | (fq << 4); s1 += shx(s1, 16, ln); s1 += shx(s1, 32, ln); s2 += shx(s2, 16, ln); s2 += shx(s2, 32, ln);
                    if (fq == 0) *(f32x2*)(ls + ((size_t)row * 32 + slot0) * 2) = (f32x2){s1, s2}; } }
    }
    __device__ __forceinline__ void operator()(const f32x4 (&acc)[2][2][4][2], const Unit& u, int wr, int wc, int fr, int fq) const {
        const int rl0 = wr * 64 + fr, row0 = u.pm * BM + rl0, pn = u.pn;
        if (pn < 8) {
            bf16_t* base = (pn < 4) ? q : k; const int col0 = (pn & 3) * BM + wc * 32 + 8 * fq;
#pragma unroll
            for (int ai = 0; ai < 2; ++ai) { f32x4 tt[4][2];
#pragma unroll
                for (int m = 0; m < 4; ++m) { const int pos = (row0 + ai * HALF + m * 16) & 8191; const f32x4* tp = (const f32x4*)(rope + ((size_t)pos * 64 + 16 * wc + 4 * fq) * 2); tt[m][0] = tp[0]; tt[m][1] = tp[1]; }
#pragma unroll
                for (int m = 0; m < 4; ++m) { const int row = row0 + ai * HALF + m * 16; const float r = ROW_RSTD(ss, rstab, pm0, u, rl0 + ai * HALF + m * 16, row, fq);
                    const f32x4 t0 = tt[m][0], t1 = tt[m][1];
                    bf16_t* rowp = base + (size_t)row * 1024 + col0;
#pragma unroll
                    for (int bj = 0; bj < 2; ++bj) { const f32x4 v0 = acc[ai][bj][m][0] * r, v1 = acc[ai][bj][m][1] * r; f32x4 y0, y1;
                        y0[0] = v0[0] * t0[0] - v0[1] * t0[1]; y0[1] = v0[1] * t0[0] + v0[0] * t0[1]; y0[2] = v0[2] * t0[2] - v0[3] * t0[3]; y0[3] = v0[3] * t0[2] + v0[2] * t0[3];
                        y1[0] = v1[0] * t1[0] - v1[1] * t1[1]; y1[1] = v1[1] * t1[0] + v1[0] * t1[1]; y1[2] = v1[2] * t1[2] - v1[3] * t1[3]; y1[3] = v1[3] * t1[2] + v1[2] * t1[3];
                        *(u32x4*)(rowp + bj * HALF) = pack8(y0, y1); } }
                asm volatile("" ::: "memory"); }
        } else {
            const int s = (pn - 8) >> 3, tile = (pn - 8) & 7; bf16_t* base = o2048 + (size_t)s * ((size_t)MROWS * DM); const int col0 = tile * BM + wc * 32 + 8 * fq, slot0 = tile * 4 + wc;
            if (s == 0) emit<0>(acc, u, base, row0, rl0, col0, slot0, fq);
            else if (s == 1) emit<1>(acc, u, base, row0, rl0, col0, slot0, fq);
            else if (s == 2) emit<2>(acc, u, base, row0, rl0, col0, slot0, fq);
            else if (s == 3) emit<3>(acc, u, base, row0, rl0, col0, slot0, fq);
            else emit<4>(acc, u, base, row0, rl0, col0, slot0, fq);
        }
    }
};

struct EpiMerge {
    static constexpr bool PERM = true, AFTER_DRAIN = false, CARRY = true;
    const bf16_t* ga; const bf16_t* gb; bf16_t* mg;
    __device__ __forceinline__ bool carry(f32x4 (&acc)[2][2][4][2], const Unit& u, int wr, int wc, int fr, int fq) const {
        if (u.pn >= 8) return false;
        const int row0 = u.pm * BM + wr * 64 + fr, col0 = u.pn * BM + wc * 32 + 8 * fq;
        u32x4 a[2][2][2], b[2][2][2];
#define EM_LOAD(q) do { _Pragma("unroll") for (int mm = 0; mm < 2; ++mm) _Pragma("unroll") for (int bj = 0; bj < 2; ++bj) { \
            const size_t off = (size_t)(row0 + ((q) >> 1) * HALF + (2 * ((q) & 1) + mm) * 16) * DM + col0 + bj * HALF; a[(q) & 1][mm][bj] = *(const u32x4*)(ga + off); b[(q) & 1][mm][bj] = *(const u32x4*)(gb + off); } } while (0)
        EM_LOAD(0);
#pragma unroll
        for (int q = 0; q < 4; ++q) { const int ai = q >> 1, mp = q & 1;
            if (q < 3) EM_LOAD(q + 1);
            __builtin_amdgcn_sched_barrier(0);
#pragma unroll
            for (int mm = 0; mm < 2; ++mm)
#pragma unroll
                for (int bj = 0; bj < 2; ++bj) { const int m = 2 * mp + mm; const u32x4 x = a[q & 1][mm][bj], y = b[q & 1][mm][bj]; f32x4& v0 = acc[ai][bj][m][0]; f32x4& v1 = acc[ai][bj][m][1];
                    v0[0] *= bf_lo(x.x) * __builtin_amdgcn_rcpf(fmaxf(bf_lo(y.x), 1e-20f)); v0[1] *= bf_hi(x.x) * __builtin_amdgcn_rcpf(fmaxf(bf_hi(y.x), 1e-20f));
                    v0[2] *= bf_lo(x.y) * __builtin_amdgcn_rcpf(fmaxf(bf_lo(y.y), 1e-20f)); v0[3] *= bf_hi(x.y) * __builtin_amdgcn_rcpf(fmaxf(bf_hi(y.y), 1e-20f));
                    v1[0] *= bf_lo(x.z) * __builtin_amdgcn_rcpf(fmaxf(bf_lo(y.z), 1e-20f)); v1[1] *= bf_hi(x.z) * __builtin_amdgcn_rcpf(fmaxf(bf_hi(y.z), 1e-20f));
                    v1[2] *= bf_lo(x.w) * __builtin_amdgcn_rcpf(fmaxf(bf_lo(y.w), 1e-20f)); v1[3] *= bf_hi(x.w) * __builtin_amdgcn_rcpf(fmaxf(bf_hi(y.w), 1e-20f)); }
            __builtin_amdgcn_sched_barrier(0); }
#undef EM_LOAD
        return true;
    }
    __device__ __forceinline__ void operator()(const f32x4 (&acc)[2][2][4][2], const Unit& u, int wr, int wc, int fr, int fq) const {
        const int pm = u.pm & 63, pn = u.pn & 7;
        typedef __attribute__((address_space(1))) unsigned char gchar;
        const size_t tile = ((size_t)(pm * BM + wr * 64) * DM + (size_t)(pn * BM + wc * 32)) * 2;
        const gchar* gbase = (const gchar*)gb + tile; gchar* mbase = (gchar*)mg + tile;
        const unsigned voff = (unsigned)((fr * DM + 8 * fq) * 2);
        u32x4 g8[2][4][2];
#pragma unroll
        for (int ai = 0; ai < 2; ++ai)
#pragma unroll
            for (int m = 0; m < 4; ++m)
#pragma unroll
                for (int bj = 0; bj < 2; ++bj) g8[ai][m][bj] = *(const __attribute__((address_space(1))) u32x4*)(gbase + (size_t)(((ai * HALF + m * 16) * DM + bj * HALF) * 2) + voff);
        __builtin_amdgcn_sched_barrier(0);
#pragma unroll
        for (int ai = 0; ai < 2; ++ai) {
#pragma unroll
            for (int m = 0; m < 4; ++m) {
#pragma unroll
                for (int bj = 0; bj < 2; ++bj) { const u32x4 g = g8[ai][m][bj]; f32x4 v0 = acc[ai][bj][m][0], v1 = acc[ai][bj][m][1];
                    v0[0] *= fmaxf(bf_lo(g.x), 1e-20f); v0[1] *= fmaxf(bf_hi(g.x), 1e-20f); v0[2] *= fmaxf(bf_lo(g.y), 1e-20f); v0[3] *= fmaxf(bf_hi(g.y), 1e-20f);
                    v1[0] *= fmaxf(bf_lo(g.z), 1e-20f); v1[1] *= fmaxf(bf_hi(g.z), 1e-20f); v1[2] *= fmaxf(bf_lo(g.w), 1e-20f); v1[3] *= fmaxf(bf_hi(g.w), 1e-20f);
                    *(__attribute__((address_space(1))) u32x4*)(mbase + (size_t)(((ai * HALF + m * 16) * DM + bj * HALF) * 2) + voff) = pack8(v0, v1); } }
            asm volatile("" ::: "memory"); }
    }
};
struct RevOrder {
    StaticOrder base;
    __device__ __forceinline__ bool next(int i, Unit& u) const { if (!base.next(i, u)) return false; u.pn = base.nN - 1 - u.pn; return true; }
    __device__ __forceinline__ void a_ready(const Unit&) const {}
    __device__ __forceinline__ void done(const Unit&) const {}
};
struct PairOrder {
    StaticOrder base;
    __device__ __forceinline__ bool next(int i, Unit& u) const { if (!base.next(i >> 1, u)) return false; if (i & 1) { u.pm += 64; u.pn += 8; } return true; }
    __device__ __forceinline__ void a_ready(const Unit&) const {}
    __device__ __forceinline__ void done(const Unit&) const {}
};

struct EpiResid {
    static constexpr bool PERM = true, AFTER_DRAIN = false, CARRY = false;
    bf16_t* xb; float* ssout; float scale;
    __device__ __forceinline__ void operator()(const f32x4 (&acc)[2][2][4][2], const Unit& u, int wr, int wc, int fr, int fq) const {
        const int row0 = u.pm * BM + wr * 64 + fr;
        typedef __attribute__((address_space(1))) unsigned char gchar;
        gchar* base = (gchar*)xb + ((size_t)(u.pm * BM + wr * 64) * DM + (size_t)(u.pn * BM + wc * 32)) * 2;
        const unsigned voff = (unsigned)((fr * DM + 8 * fq) * 2);
        u32x4 xo[2][4][2];
#pragma unroll
        for (int ai = 0; ai < 2; ++ai)
#pragma unroll
            for (int m = 0; m < 4; ++m)
#pragma unroll
                for (int bj = 0; bj < 2; ++bj) xo[ai][m][bj] = *(const __attribute__((address_space(1))) u32x4*)(base + (size_t)(((ai * HALF + m * 16) * DM + bj * HALF) * 2) + voff);
        __builtin_amdgcn_sched_barrier(0);
#pragma unroll
        for (int ai = 0; ai < 2; ++ai) {
#pragma unroll
            for (int m = 0; m < 4; ++m) { const int row = row0 + ai * HALF + m * 16; float s2 = 0.f;
#pragma unroll
                for (int bj = 0; bj < 2; ++bj) { const u32x4 g = xo[ai][m][bj]; f32x4 a0 = acc[ai][bj][m][0] * scale, a1 = acc[ai][bj][m][1] * scale;
                    a0[0] += bf_lo(g.x); a0[1] += bf_hi(g.x); a0[2] += bf_lo(g.y); a0[3] += bf_hi(g.y); a1[0] += bf_lo(g.z); a1[1] += bf_hi(g.z); a1[2] += bf_lo(g.w); a1[3] += bf_hi(g.w);
                    s2 += ((a0[0] * a0[0] + a0[1] * a0[1]) + (a0[2] * a0[2] + a0[3] * a0[3])) + ((a1[0] * a1[0] + a1[1] * a1[1]) + (a1[2] * a1[2] + a1[3] * a1[3]));
                    *(__attribute__((address_space(1))) u32x4*)(base + (size_t)(((ai * HALF + m * 16) * DM + bj * HALF) * 2) + voff) = pack8(a0, a1); }
                { const int ln = fr | (fq << 4); s2 += shx(s2, 16, ln); s2 += shx(s2, 32, ln); }
                if (fq == 0) ssout[(size_t)row * 32 + u.pn * 4 + wc] = s2; }
            asm volatile("" ::: "memory"); }
    }
};

struct EpiSwiglu {
    static constexpr bool PERM = true, AFTER_DRAIN = false, CARRY = false;
    const float* ss; bf16_t* h; const PG8_LAS float* rstab; int pm0;
    __device__ __forceinline__ void operator()(const f32x4 (&acc)[2][2][4][2], const Unit& u, int wr, int wc, int fr, int fq) const {
        const int rl0 = wr * 64 + fr, row0 = u.pm * BM + rl0, col0 = u.pn * HALF + wc * 32 + 8 * fq;
#pragma unroll
        for (int ai = 0; ai < 2; ++ai)
#pragma unroll
            for (int m = 0; m < 4; ++m) { const float r = ROW_RSTD(ss, rstab, pm0, u, rl0 + ai * HALF + m * 16, row0 + ai * HALF + m * 16, fq); f32x4 a0 = acc[ai][0][m][0] * r, a1 = acc[ai][0][m][1] * r; const f32x4 c0 = acc[ai][1][m][0] * r, c1 = acc[ai][1][m][1] * r;
#pragma unroll
                for (int j = 0; j < 4; ++j) { a0[j] = silu_f(a0[j]) * c0[j]; a1[j] = silu_f(a1[j]) * c1[j]; }
                *(u32x4*)(h + (size_t)(row0 + ai * HALF + m * 16) * 5632 + col0) = pack8(a0, a1); }
    }
};

struct EpiNull {
    static constexpr bool PERM = true, AFTER_DRAIN = false, CARRY = false;
    float* sink;
    __device__ __forceinline__ void operator()(const f32x4 (&acc)[2][2][4][2], const Unit& u, int wr, int wc, int fr, int fq) const {
        float s = 0.f;
#pragma unroll
        for (int ai = 0; ai < 2; ++ai)
#pragma unroll
            for (int bj = 0; bj < 2; ++bj)
#pragma unroll
                for (int m = 0; m < 4; ++m)
#pragma unroll
                    for (int n = 0; n < 2; ++n) s += (acc[ai][bj][m][n][0] + acc[ai][bj][m][n][1]) + (acc[ai][bj][m][n][2] + acc[ai][bj][m][n][3]);
        if (s == 123456.789f) sink[u.pm * 64 + u.pn] = s;
    }
};

struct SameTileOrder {
    int nunits;
    __device__ __forceinline__ bool next(int i, Unit& u) const { if (i >= nunits) return false; u.pm = 0; u.pn = 0; return true; }
    __device__ __forceinline__ void a_ready(const Unit&) const {}
    __device__ __forceinline__ void done(const Unit&) const {}
};
template <class Epi, class Sched, bool ALIGN_EPI = false, bool SP2 = false, bool MM32 = false>
__device__ __forceinline__ void gemm_phase(PG8_LAS unsigned char* lds, const Gemm g, const Sched& S, const Epi& E, const int tid_in) {
    const int tid = tid_in, wid = __builtin_amdgcn_readfirstlane(tid >> 6), lane = tid & 63, wr = wid >> 2, wc = wid & 3, fr = lane & 15, fq = lane >> 4;
    const int K = g.K, nt = K / BK;
    unsigned voffA[2], voffB[2];
#pragma unroll
    for (int i = 0; i < 2; ++i) { int R, C; stage_rc(tid * 16 + i * 8192, R, C); const int Rb = Epi::PERM ? ((R & ~31) + perm32(R & 31)) : R;
        voffA[i] = (unsigned)(R * K + C) * 2u; voffB[i] = (unsigned)(Rb * K + C) * 2u; }
    const size_t kstep = (size_t)(BK * 2);
    const size_t hstep = (size_t)HALF * K * 2;
    const size_t tstep = 2 * hstep;
    const unsigned ldsw = (unsigned)wid * 1024u;
    const int aoff = lds_byte(wr * 64 + fr, fq * 8), boff = lds_byte(wc * 32 + fr, fq * 8);
#ifndef PG8_DMA_AUX
#define PG8_DMA_AUX 0
#endif
#define PG8_SA(b, h) (((b) * 2 + (h)) * HTB)
#define PG8_SB(b, h) ((4 + (b) * 2 + (h)) * HTB)
#define PG8_STAGE(bufoff, gbase, voff) do { _Pragma("unroll") for (int _i = 0; _i < 2; ++_i) \
        __builtin_amdgcn_global_load_lds((const unsigned*)((const char*)(gbase) + (voff)[_i]), (PG8_LAS unsigned*)(lds + (bufoff) + ldsw + _i * 8192), 16, 0, PG8_DMA_AUX); } while (0)
#define PG8_LDA(dst, b, h) do { _Pragma("unroll") for (int m = 0; m < 4; ++m) _Pragma("unroll") for (int k = 0; k < 2; ++k) dst[m][k] = *(const PG8_LAS bf16x8*)(lds + PG8_SA(b, h) + aoff + m * 2048 + k * 1024); } while (0)
#define PG8_LDB(dst, b, h) do { _Pragma("unroll") for (int n = 0; n < 2; ++n) _Pragma("unroll") for (int k = 0; k < 2; ++k) dst[n][k] = *(const PG8_LAS bf16x8*)(lds + PG8_SB(b, h) + boff + n * 2048 + k * 1024); } while (0)
#define PG8_MMA(ai, bj, At, Bt) do { __builtin_amdgcn_s_setprio(1); if constexpr (MM32) { _Pragma("unroll") for (int j = 0; j < 4; ++j) _Pragma("unroll") for (int p = 0; p < 2; ++p) \
        acc16[ai][bj][p] = __builtin_amdgcn_mfma_f32_32x32x16_bf16(Bt[p][j & 1], At[j][j >> 1], acc16[ai][bj][p], 0, 0, 0); } else { \
        _Pragma("unroll") for (int m = 0; m < 4; ++m) _Pragma("unroll") for (int n = 0; n < 2; ++n) _Pragma("unroll") for (int k = 0; k < 2; ++k) \
        acc[ai][bj][m][n] = __builtin_amdgcn_mfma_f32_16x16x32_bf16(Bt[n][k], At[m][k], acc[ai][bj][m][n], 0, 0, 0); } __builtin_amdgcn_s_setprio(0); } while (0)
#define PG8_WAIT_V(n) asm volatile("s_waitcnt vmcnt(" #n ")" ::: "memory")
#define PG8_WAIT_L(n) asm volatile("s_waitcnt lgkmcnt(" #n ")" ::: "memory")
#define PG8_BAR __builtin_amdgcn_s_barrier()
#define PG8_SCHED __builtin_amdgcn_sched_barrier(0)
    Unit cur, nxt; int ui = 0;
    if (!S.next(0, cur)) return;
    f32x4 acc[2][2][4][2];
#pragma unroll
    for (int a = 0; a < 2; ++a)
#pragma unroll
        for (int b = 0; b < 2; ++b)
#pragma unroll
            for (int m = 0; m < 4; ++m)
#pragma unroll
                for (int n = 0; n < 2; ++n) acc[a][b][m][n] = (f32x4){0.f, 0.f, 0.f, 0.f};
    f32x16 acc16[2][2][2];
    if constexpr (MM32) {
#pragma unroll
        for (int a = 0; a < 2; ++a)
#pragma unroll
            for (int b = 0; b < 2; ++b)
#pragma unroll
                for (int p = 0; p < 2; ++p)
#pragma unroll
                    for (int e = 0; e < 16; ++e) acc16[a][b][p][e] = 0.f;
    }
    bf16x8 At[4][2], B0[2][2], B1[2][2];
    const char* cA = (const char*)g.A + (size_t)cur.pm * tstep; const char* cB = (const char*)g.Bt + (size_t)cur.pn * tstep;
    S.a_ready(cur);
    if constexpr (SP2) {
        PG8_STAGE(PG8_SB(0, 0), cB, voffB); PG8_STAGE(PG8_SB(0, 1), cB + hstep, voffB); PG8_STAGE(PG8_SA(0, 0), cA, voffA); PG8_STAGE(PG8_SA(0, 1), cA + hstep, voffA);
        if (wr == 1) PG8_BAR;
        PG8_WAIT_V(2); PG8_BAR;
        PG8_STAGE(PG8_SB(1, 0), cB + kstep, voffB); PG8_STAGE(PG8_SA(1, 0), cA + kstep, voffA); PG8_STAGE(PG8_SB(1, 1), cB + hstep + kstep, voffB);
        PG8_WAIT_V(6); PG8_BAR;
    } else {
        PG8_STAGE(PG8_SB(0, 0), cB, voffB); PG8_STAGE(PG8_SA(0, 0), cA, voffA); PG8_STAGE(PG8_SB(0, 1), cB + hstep, voffB); PG8_STAGE(PG8_SA(0, 1), cA + hstep, voffA);
        if (wr == 1) PG8_BAR;
        PG8_WAIT_V(4); PG8_BAR;
        PG8_STAGE(PG8_SB(1, 0), cB + kstep, voffB); PG8_STAGE(PG8_SA(1, 0), cA + kstep, voffA); PG8_STAGE(PG8_SB(1, 1), cB + hstep + kstep, voffB);
        PG8_WAIT_V(6); PG8_BAR;
    }
    for (;;) {
        const bool has_next = S.next(ui + 1, nxt);
        const char* nA = has_next ? (const char*)g.A + (size_t)nxt.pm * tstep : cA; const char* nB = has_next ? (const char*)g.Bt + (size_t)nxt.pn * tstep : cB;
        for (int t = 0; t < nt; t += 2) {
            const bool last = (t == nt - 2);
            const char* a1 = cA + (size_t)(t + 1) * kstep;
            const char* a2 = last ? nA : cA + (size_t)(t + 2) * kstep; const char* b2 = last ? nB : cB + (size_t)(t + 2) * kstep;
            const char* a3 = a2 + kstep; const char* b3 = b2 + kstep;
            if (last && has_next) S.a_ready(nxt);
            if constexpr (SP2) {
            PG8_LDB(B0, 0, 0); PG8_LDB(B1, 0, 1); PG8_SCHED; PG8_LDA(At, 0, 0); PG8_STAGE(PG8_SA(1, 1), a1 + hstep, voffA);
            PG8_WAIT_V(8); PG8_WAIT_L(0); PG8_BAR; PG8_MMA(0, 0, At, B0); PG8_MMA(0, 1, At, B1); PG8_BAR; PG8_SCHED;
            PG8_LDA(At, 0, 1); PG8_STAGE(PG8_SB(0, 0), b2, voffB); PG8_STAGE(PG8_SB(0, 1), b2 + hstep, voffB); PG8_STAGE(PG8_SA(0, 0), a2, voffA);
            PG8_WAIT_V(8); PG8_WAIT_L(0); PG8_BAR; PG8_MMA(1, 0, At, B0); PG8_MMA(1, 1, At, B1); PG8_BAR; PG8_SCHED;
            PG8_LDB(B0, 1, 0); PG8_LDB(B1, 1, 1); PG8_SCHED; PG8_LDA(At, 1, 0); PG8_STAGE(PG8_SA(0, 1), a2 + hstep, voffA);
            PG8_WAIT_V(8); PG8_WAIT_L(0); PG8_BAR; PG8_MMA(0, 0, At, B0); PG8_MMA(0, 1, At, B1); PG8_BAR; PG8_SCHED;
            PG8_LDA(At, 1, 1); PG8_STAGE(PG8_SB(1, 0), b3, voffB); PG8_STAGE(PG8_SB(1, 1), b3 + hstep, voffB); PG8_STAGE(PG8_SA(1, 0), a3, voffA);
            PG8_WAIT_V(8); PG8_WAIT_L(0); PG8_BAR; PG8_MMA(1, 0, At, B0); PG8_MMA(1, 1, At, B1); PG8_BAR; PG8_SCHED;
            } else {
            PG8_LDB(B0, 0, 0); PG8_SCHED; PG8_LDA(At, 0, 0); PG8_STAGE(PG8_SA(1, 1), a1 + hstep, voffA);
            PG8_WAIT_L(8); PG8_BAR; PG8_WAIT_L(0); PG8_MMA(0, 0, At, B0); PG8_BAR; PG8_SCHED;
            PG8_LDB(B1, 0, 1); PG8_STAGE(PG8_SB(0, 0), b2, voffB);
            PG8_BAR; PG8_WAIT_L(0); PG8_MMA(0, 1, At, B1); PG8_BAR;
            PG8_LDA(At, 0, 1); PG8_STAGE(PG8_SA(0, 0), a2, voffA);
            PG8_BAR; PG8_WAIT_L(0); PG8_MMA(1, 0, At, B0); PG8_BAR; PG8_SCHED;
            PG8_STAGE(PG8_SB(0, 1), b2 + hstep, voffB);
            PG8_WAIT_V(6); PG8_BAR; PG8_MMA(1, 1, At, B1); PG8_BAR;
            PG8_LDB(B0, 1, 0); PG8_SCHED; PG8_LDA(At, 1, 0); PG8_STAGE(PG8_SA(0, 1), a2 + hstep, voffA);
            PG8_WAIT_L(8); PG8_BAR; PG8_WAIT_L(0); PG8_MMA(0, 0, At, B0); PG8_BAR; PG8_SCHED;
            PG8_LDB(B1, 1, 1); PG8_STAGE(PG8_SB(1, 0), b3, voffB);
            PG8_BAR; PG8_WAIT_L(0); PG8_MMA(0, 1, At, B1); PG8_BAR;
            PG8_LDA(At, 1, 1); PG8_STAGE(PG8_SA(1, 0), a3, voffA);
            PG8_BAR; PG8_WAIT_L(0); PG8_MMA(1, 0, At, B0); PG8_BAR; PG8_SCHED;
            PG8_STAGE(PG8_SB(1, 1), b3 + hstep, voffB);
            PG8_WAIT_V(6); PG8_BAR; PG8_MMA(1, 1, At, B1); PG8_BAR;
            }
        }
        if constexpr (ALIGN_EPI) { if (wr == 0) PG8_BAR; }
        if constexpr (MM32) {
#pragma unroll
            for (int a = 0; a < 2; ++a)
#pragma unroll
                for (int b = 0; b < 2; ++b)
#pragma unroll
                    for (int m = 0; m < 4; ++m)
#pragma unroll
                        for (int n = 0; n < 2; ++n)
#pragma unroll
                            for (int e = 0; e < 4; ++e) acc[a][b][m][n][e] = acc16[a][b][m >> 1][(m & 1) * 8 + n * 4 + e];
        }
        bool keep = false;
        if constexpr (!Epi::AFTER_DRAIN) { if constexpr (Epi::CARRY) keep = E.carry(acc, cur, wr, wc, fr, fq); if (!keep) E(acc, cur, wr, wc, fr, fq); S.done(cur); }
        if (!has_next) break;
        if (!keep)
#pragma unroll
        for (int a = 0; a < 2; ++a)
#pragma unroll
            for (int b = 0; b < 2; ++b)
#pragma unroll
                for (int m = 0; m < 4; ++m)
#pragma unroll
                    for (int n = 0; n < 2; ++n) acc[a][b][m][n] = (f32x4){0.f, 0.f, 0.f, 0.f};
        cur = nxt; cA = nA; cB = nB; ++ui;
        if constexpr (ALIGN_EPI) { if (wr == 1) PG8_BAR; }
    }
    PG8_WAIT_V(0);
    if constexpr (!ALIGN_EPI) { if (wr == 0) PG8_BAR; }
    PG8_BAR;
    if constexpr (Epi::AFTER_DRAIN) { E.fused(acc, cur, wr, wc, fr, fq, lds, wid, lane); S.done(cur); }
#undef PG8_SA
#undef PG8_SB
#undef PG8_STAGE
#undef PG8_LDA
#undef PG8_LDB
#undef PG8_MMA
#undef PG8_WAIT_V
#undef PG8_WAIT_L
#undef PG8_BAR
#undef PG8_SCHED
}
}

#ifndef MK_PER_PHASE
#define MK_PER_PHASE 0
#endif
constexpr int NWAVES = 8;
constexpr int NWG = 256;
constexpr int BATCH = 2, T = 8192, D = 2048, M = BATCH * T, DEPTH = 4;
constexpr int NIN = 14336, DFF = 5632, NFF = 2 * DFF;
constexpr float EPS = 1e-6f;
static_assert(M == pg8::MROWS && D == pg8::DM, "shapes");

constexpr size_t MiB = 1u << 20;
constexpr size_t WS_CTL = 0, CTL_ZERO_BYTES = 1 * MiB;
constexpr size_t WS_ROPE = 1 * MiB;
constexpr size_t WS_SS = 5 * MiB, WS_SS2 = 7 * MiB;
constexpr size_t WS_LS = 9 * MiB;
constexpr size_t WS_W = 16 * MiB, W_LAYER = 146 * MiB;
constexpr size_t W_IN = 0, W_R = 56 * MiB, W_S = 64 * MiB, W_O = 72 * MiB, W_F1 = 80 * MiB, W_F2 = 124 * MiB;
static_assert((size_t)NIN * D * 2 == 56 * MiB && (size_t)NFF * D * 2 == 44 * MiB && (size_t)D * DFF * 2 == 22 * MiB, "weight map");
constexpr size_t WS_X = 600 * MiB;
constexpr size_t WS_XB = 728 * MiB;
constexpr size_t WS_Q = 792 * MiB, WS_K = 824 * MiB;
constexpr size_t WS_O2048 = 856 * MiB;
constexpr size_t WS_V = WS_O2048, WS_SG = WS_V + 64 * MiB, WS_ZU = WS_SG + 64 * MiB, WS_ZV = WS_ZU + 64 * MiB, WS_GA = WS_ZV + 64 * MiB, WS_GB = WS_GA + 64 * MiB;
constexpr size_t WS_RA = 1240 * MiB, WS_SB = 1304 * MiB;
constexpr size_t WS_P = 1368 * MiB, WS_MG = 1432 * MiB;
constexpr size_t WS_SLOC = 1496 * MiB;
constexpr size_t WS_END = 1528 * MiB;
constexpr size_t WS_H = WS_Q;
static_assert(WS_W + DEPTH * W_LAYER <= WS_X && WS_GB + 64 * MiB == WS_RA && WS_SB == WS_RA + 64 * MiB && WS_H + (size_t)M * DFF * 2 <= WS_ZU, "d_ws map");
constexpr int CW_TMO = 0, CW_CODE = 1, CW_BAR = 4096;

constexpr int RING_OFF = 0, RING_BYTES = 131072;
constexpr int LDSCTL_OFF = RING_BYTES, MISC_OFF = LDSCTL_OFF + 320, RSTAB_OFF = LDSCTL_OFF + 1024;
constexpr int LDS_BYTES = 147456;
constexpr int PQ = 288, PV = 528, PP = 144;
constexpr int R_Q = 0, R_K = 64 * PQ, R_KS = 2 * 64 * PQ, R_V = 3 * 64 * PQ, R_P = R_V + 64 * PV, R_RED = R_P + 64 * PP, R_END = R_RED + 4096;
constexpr int R1_KS = 0, R1_V = 64 * PQ, R1_BUF = R1_V + 64 * PV;
static_assert(2 * R1_BUF <= RING_BYTES, "LDS map");
constexpr int S_W = 0, S_VN = 128 * PQ, S_ST = S_VN + 128 * PV, S_END = S_ST + 2048;
static_assert(R_END <= RING_BYTES && S_END <= RING_BYTES, "LDS map");

#define GAS __attribute__((address_space(1)))
#define LAS __attribute__((address_space(3)))
typedef unsigned short bf16;
typedef unsigned v4u __attribute__((ext_vector_type(4)));
typedef unsigned v2u __attribute__((ext_vector_type(2)));
typedef float f32x4 __attribute__((ext_vector_type(4)));
typedef float f32x2 __attribute__((ext_vector_type(2)));
typedef short bf16x8 __attribute__((ext_vector_type(8)));
typedef short s16x4 __attribute__((ext_vector_type(4)));
typedef GAS unsigned gu32;
#define RLX_AGENT __ATOMIC_RELAXED, __HIP_MEMORY_SCOPE_AGENT
#define LDS_WAIT() asm volatile("s_waitcnt lgkmcnt(0)" ::: "memory")
#define VM_WAIT() asm volatile("s_waitcnt vmcnt(0)" ::: "memory")
__device__ __forceinline__ unsigned f2bf(float f) { unsigned u = __builtin_bit_cast(unsigned, f); return (u + 0x7fffu + ((u >> 16) & 1u)) >> 16; }
__device__ __forceinline__ unsigned pk2(float lo, float hi) { typedef float f2_ __attribute__((ext_vector_type(2))); typedef __bf16 b2_ __attribute__((ext_vector_type(2))); const f2_ v = {lo, hi}; return __builtin_bit_cast(unsigned, __builtin_convertvector(v, b2_)); }
__device__ __forceinline__ float blo(unsigned w) { return __uint_as_float(w << 16); }
__device__ __forceinline__ float bhi(unsigned w) { return __uint_as_float(w & 0xffff0000u); }
__device__ __forceinline__ float ex2(float x) { return __builtin_amdgcn_exp2f(x); }
__device__ __forceinline__ float l2gamma(int h) {
    const float t0 = (h & 1) ? -0.02272007650008353f : -0.04580368961312479f, t1 = (h & 1) ? -0.005646563141142063f : -0.011315313227834146f;
    const float t2 = (h & 1) ? -0.0014095702546713536f : -0.0028205190623786626f, t3 = (h & 1) ? -0.0003522634716290214f : -0.0007046129765893727f;
    const float a = (h & 2) ? t1 : t0, b = (h & 2) ? t3 : t2; return (h & 4) ? b : a; }
#define MFMA16(a, b, c) __builtin_amdgcn_mfma_f32_16x16x32_bf16((a), (b), (c), 0, 0, 0)

#define XB_TMO      128
#define XB_XCNT(j)  (256  + 64 * (j))
#define XB_XSUB(j)  (1280 + 64 * (j))
#define XB_XGEN(j)  (2304 + 64 * (j))
#define XB_TOP      3328
#define XB_TOPGEN   3392
#define XCD_BAR_WORDS 3456
#define XB_SPIN_CAP (1u << 18)

__device__ __forceinline__ unsigned xb_ld(unsigned* p)              { return __hip_atomic_load(p, __ATOMIC_RELAXED, __HIP_MEMORY_SCOPE_AGENT); }
__device__ __forceinline__ unsigned xb_add(unsigned* p, unsigned v) { return __hip_atomic_fetch_add(p, v, __ATOMIC_RELAXED, __HIP_MEMORY_SCOPE_AGENT); }
__device__ __forceinline__ unsigned xb_xcc_id() { return (unsigned)__builtin_amdgcn_s_getreg((3 << 11) | 20) & 0xFu; }
#define XB_SPIN(cond, bar) do { unsigned _sp = 0; while (cond) { __builtin_amdgcn_s_sleep(1); \
    if ((++_sp & 255u) == 0u) { if (xb_ld(&(bar)[XB_TMO])) break; if (_sp > XB_SPIN_CAP) { atomicAdd(&(bar)[XB_TMO], 1u); break; } } } } while (0)

struct XcdBarrier {
    unsigned* bar; unsigned x;
    volatile LAS unsigned* st;
};

__device__ __forceinline__ XcdBarrier xcd_barrier_post(unsigned* bar, volatile LAS unsigned* st) {
    XcdBarrier b; b.bar = bar; b.x = xb_xcc_id(); b.st = st;
    if (threadIdx.x == 0) (void)xb_add(&bar[XB_XCNT(b.x)], 1u);
    return b;
}
__device__ __forceinline__ void xcd_barrier_complete(unsigned* bar, unsigned x, unsigned& nloc, unsigned& nx) {
    const unsigned G = gridDim.x * gridDim.y * gridDim.z;
    unsigned sum, cnt, mine, sp = 0u;
    for (;;) {
        sum = 0u; cnt = 0u; mine = 0u;
#pragma unroll
        for (unsigned j = 0; j < 16; ++j) { const unsigned c = xb_ld(&bar[XB_XCNT(j)]); sum += c; cnt += (c > 0u) ? 1u : 0u; mine = (j == x) ? c : mine; }
        if (sum == G) break;
        __builtin_amdgcn_s_sleep(1);
        if ((++sp & 255u) == 0u) { if (xb_ld(&bar[XB_TMO])) break; if (sp > XB_SPIN_CAP) { atomicAdd(&bar[XB_TMO], 1u); break; } }
    }
    nloc = mine > 0u ? mine : 1u; nx = cnt > 0u ? cnt : 1u;
}

__device__ __forceinline__ void xcd_barrier(const XcdBarrier& b) {
    asm volatile("s_waitcnt vmcnt(0)" ::: "memory");
    __syncthreads();
    if (threadIdx.x == 0) {
        unsigned* bar = b.bar;
        __builtin_amdgcn_s_waitcnt(0);
        unsigned nloc = b.st[0], nx = b.st[1];
        if (nloc == 0u) { xcd_barrier_complete(bar, b.x, nloc, nx); b.st[0] = nloc; b.st[1] = nx; }
        const unsigned old = xb_add(&bar[XB_XSUB(b.x)], 1u);
        const unsigned gen = old / nloc;
        if (old + 1u == (gen + 1u) * nloc) {
            __builtin_amdgcn_fence(__ATOMIC_RELEASE, "agent");
            asm volatile("s_waitcnt vmcnt(0)" ::: "memory");
            const unsigned og = xb_add(&bar[XB_TOP], 1u);
            const unsigned tg = og / nx;
            if (og + 1u == (tg + 1u) * nx) xb_add(&bar[XB_TOPGEN], 1u);
            else XB_SPIN(xb_ld(&bar[XB_TOPGEN]) == tg, bar);
            __builtin_amdgcn_fence(__ATOMIC_ACQUIRE, "agent");
            xb_add(&bar[XB_XGEN(b.x)], 1u);
            asm volatile("s_waitcnt vmcnt(0)" ::: "memory");
        } else {
            XB_SPIN(xb_ld(&bar[XB_XGEN(b.x)]) == gen, bar);
            __builtin_amdgcn_fence(__ATOMIC_ACQUIRE, "agent");
            asm volatile("s_waitcnt vmcnt(0)" ::: "memory");
        }
    }
    __syncthreads();
}

struct Frame;
__device__ __forceinline__ bool conv_work_one(Frame& F, int max_layer);
__device__ __forceinline__ void xcd_barrier_idle(const XcdBarrier& b, Frame& F, const int tid_) {
    asm volatile("s_waitcnt vmcnt(0)" ::: "memory");
    __syncthreads();
    if (tid_ == 0) {
        unsigned* bar = b.bar;
        __builtin_amdgcn_s_waitcnt(0);
        unsigned nloc = b.st[0], nx = b.st[1];
        if (nloc == 0u) { xcd_barrier_complete(bar, b.x, nloc, nx); b.st[0] = nloc; b.st[1] = nx; }
        const unsigned old = xb_add(&bar[XB_XSUB(b.x)], 1u);
        const unsigned gen = old / nloc;
        if (old + 1u == (gen + 1u) * nloc) {
            __builtin_amdgcn_fence(__ATOMIC_RELEASE, "agent");
            asm volatile("s_waitcnt vmcnt(0)" ::: "memory");
            const unsigned og = xb_add(&bar[XB_TOP], 1u);
            const unsigned tg = og / nx;
            if (og + 1u == (tg + 1u) * nx) xb_add(&bar[XB_TOPGEN], 1u);
            else XB_SPIN(xb_ld(&bar[XB_TOPGEN]) == tg, bar);
            __builtin_amdgcn_fence(__ATOMIC_ACQUIRE, "agent");
            xb_add(&bar[XB_XGEN(b.x)], 1u);
            asm volatile("s_waitcnt vmcnt(0)" ::: "memory");
            b.st[2] = 0u;
        } else { b.st[2] = 1u; b.st[3] = gen;
#if defined(PRE_WB)
            { const unsigned pos = old - gen * nloc;
              if (pos + 1u == nloc / 2u || pos + 4u == nloc || pos + 2u == nloc) asm volatile("buffer_wbl2 sc1" ::: "memory"); }
#endif
        }
    }
    __syncthreads();
    if (b.st[2] != 0u) {
        unsigned* bar = b.bar; const unsigned gen = b.st[3]; bool more = true;
        for (unsigned it = 0; it < (1u << 20); ++it) {
            if (tid_ == 0) b.st[4] = (xb_ld(&bar[XB_XGEN(b.x)]) != gen || xb_ld(&bar[XB_TMO]) != 0u) ? 1u : 0u;
            __syncthreads();
            const unsigned rel = b.st[4];
            if (rel) break;
            if (more) { const unsigned w_ = conv_work_one(F, DEPTH - 1) ? 1u : 0u; volatile LAS unsigned* wf = b.st + 16;
                if ((tid_ & 63) == 0) wf[tid_ >> 6] = w_;
                __syncthreads();
                more = (wf[0] | wf[1] | wf[2] | wf[3] | wf[4] | wf[5] | wf[6] | wf[7]) != 0u; }
            else { if (tid_ == 0) XB_SPIN(xb_ld(&bar[XB_XGEN(b.x)]) == gen, bar); __syncthreads(); break; }
        }
        if (tid_ == 0) { __builtin_amdgcn_fence(__ATOMIC_ACQUIRE, "agent"); asm volatile("s_waitcnt vmcnt(0)" ::: "memory"); }
    }
    __syncthreads();
}

__device__ __forceinline__ bf16x8 tr_frag(LAS const unsigned char* img, int pitch, int k0, int n0, int lane) {
    const int g = lane >> 4, q = (lane & 15) >> 2, p = lane & 3;
    LAS const unsigned char* a = img + (k0 + 8 * g + q) * pitch + (n0 + 4 * p) * 2;
    const s16x4 lo = __builtin_bit_cast(s16x4, __builtin_amdgcn_ds_read_tr16_b64_v4i16((LAS s16x4*)a));
    const s16x4 hi = __builtin_bit_cast(s16x4, __builtin_amdgcn_ds_read_tr16_b64_v4i16((LAS s16x4*)(a + 4 * pitch)));
    return __builtin_shufflevector(lo, hi, 0, 1, 2, 3, 4, 5, 6, 7);
}
__device__ __forceinline__ bf16x8 pack_f8(const f32x4& a, const f32x4& b) { v4u w; w.x = pg8::cvt_pk_bf16(a[0], a[1]); w.y = pg8::cvt_pk_bf16(a[2], a[3]); w.z = pg8::cvt_pk_bf16(b[0], b[1]); w.w = pg8::cvt_pk_bf16(b[2], b[3]); return __builtin_bit_cast(bf16x8, w); }
__device__ __forceinline__ float wave_sum(float v, int lane) {
#pragma unroll
    for (int o = 1; o < 64; o <<= 1) v += pg8::shx(v, o, lane);
    return v;
}

struct Frame {
    LAS unsigned char* lds;
    int tid, lane, wave;
    const float *x, *norm_mix_w, *w_in, *ret_gn_w, *ret_proj, *sgu_ln_w, *sgu_ln_b, *sgu_w_s, *sgu_b_s, *sgu_proj, *w_out, *norm_ffn_w, *w_ffn_in, *w_ffn_out, *final_norm_w;
    float* out; unsigned char* ws;
};

__device__ __forceinline__ int p0_rowmap(int mode, int c) {
    if (mode == 1) { if (c < 2048) { const int d = c & 127; return (c & ~127) + 2 * (d & 63) + (d >> 6); } return c; }
    if (mode == 2) { const int half = c >= DFF ? 1 : 0, j = c - half * DFF; return 256 * (j >> 7) + 128 * half + (j & 127); }
    return c;
}
__device__ __forceinline__ void p0_transpose_item(const float* W, int Nsrc, int K, bf16* WT, int mode, const float* kscale, float qs, LAS float* scr, int kb, int cb, int lane) {
    const int k0 = 64 * kb, c0 = 64 * cb, c4 = (lane & 15) * 4;
    f32x4 w[16];
#pragma unroll
    for (int i = 0; i < 16; ++i) { const int kk = 4 * i + (lane >> 4); w[i] = *(const GAS f32x4*)(W + (size_t)(k0 + kk) * Nsrc + c0 + c4); }
#pragma unroll
    for (int i = 0; i < 16; ++i) { const int kk = 4 * i + (lane >> 4); const float ks = kscale ? kscale[k0 + kk] : 1.f;
        *(LAS f32x4*)(scr + kk * 64 + (c4 ^ (((kk >> 3) & 7) << 3))) = w[i] * ks; }
    LDS_WAIT(); asm volatile("" ::: "memory");
    const int c = lane & 7;
#pragma unroll
    for (int j = 0; j < 8; ++j) { const int n = (lane >> 3) + 8 * j, row = p0_rowmap(mode, c0 + n); const float cs = (mode == 1 && row < 1024) ? qs : 1.f;
        const LAS float* s = scr + (8 * c) * 64 + (n ^ (c << 3));
        v4u o; o.x = pk2(s[0 * 64] * cs, s[1 * 64] * cs); o.y = pk2(s[2 * 64] * cs, s[3 * 64] * cs); o.z = pk2(s[4 * 64] * cs, s[5 * 64] * cs); o.w = pk2(s[6 * 64] * cs, s[7 * 64] * cs);
        *(GAS v4u*)(WT + (size_t)row * K + k0 + 8 * c) = o; }
    LDS_WAIT(); asm volatile("" ::: "memory");
}
constexpr int I_IN = 32 * (NIN / 64), I_SQ = 32 * 32, I_F1 = 32 * (NFF / 64), I_F2 = (DFF / 64) * 32, I_LAYER = I_IN + 3 * I_SQ + I_F1 + I_F2;
__device__ __forceinline__ void conv_item(Frame& F, int it, LAS float* scr) {
    const int l = it / I_LAYER; int r = it % I_LAYER;
    unsigned char* wl = F.ws + WS_W + (size_t)l * W_LAYER;
    const float* W; int Nsrc = D, K = D, mode = 0, nb = 32; bf16* WT; const float* ks = nullptr; float qs = 1.f;
    if (r < I_IN) { W = F.w_in + (size_t)l * D * NIN; Nsrc = NIN; WT = (bf16*)(wl + W_IN); mode = 1; ks = F.norm_mix_w + l * D; qs = 0.08838834764831845f; nb = NIN / 64; }
    else if ((r -= I_IN) < I_SQ) { W = F.ret_proj + (size_t)l * D * D; WT = (bf16*)(wl + W_R); }
    else if ((r -= I_SQ) < I_SQ) { W = F.sgu_proj + (size_t)l * D * D; WT = (bf16*)(wl + W_S); }
    else if ((r -= I_SQ) < I_SQ) { W = F.w_out + (size_t)l * D * D; WT = (bf16*)(wl + W_O); }
    else if ((r -= I_SQ) < I_F1) { W = F.w_ffn_in + (size_t)l * D * NFF; Nsrc = NFF; WT = (bf16*)(wl + W_F1); mode = 2; ks = F.norm_ffn_w + l * D; nb = NFF / 64; }
    else { r -= I_F1; W = F.w_ffn_out + (size_t)l * DFF * D; K = DFF; WT = (bf16*)(wl + W_F2); }
    p0_transpose_item(W, Nsrc, K, WT, mode, ks, qs, scr, r / nb, r % nb, F.lane);
}
constexpr int CW_CONV_DONE = 2624;
constexpr int CONV_CUR_OFF = MISC_OFF + 64;
__device__ __forceinline__ bool conv_work_one(Frame& F, int max_layer = DEPTH - 1) {
    volatile LAS unsigned* cur = (volatile LAS unsigned*)(F.lds + CONV_CUR_OFF) + F.wave;
    const int NGW = NWG * NWAVES, gw = blockIdx.x * NWAVES + F.wave;
    const int k = __builtin_amdgcn_readfirstlane((int)*cur);
    if (k >= (DEPTH * I_LAYER) / NGW + 1) return false;
    const int it = I_LAYER + gw + k * NGW;
    if (it >= DEPTH * I_LAYER) return false;
    const int layer = it / I_LAYER;
    if (layer > max_layer) return false;
    conv_item(F, it, (LAS float*)(F.lds + RING_OFF + F.wave * 16384));
    if (F.lane == 0) *cur = (unsigned)(k + 1);
    if ((it + NGW) / I_LAYER != layer) {
        asm volatile("s_waitcnt vmcnt(0)" ::: "memory");
        if (F.lane == 0) __hip_atomic_fetch_add((unsigned*)(F.ws + WS_CTL) + CW_CONV_DONE + 64 * layer, 1u, __ATOMIC_RELAXED, __HIP_MEMORY_SCOPE_AGENT); }
    return true;
}
__device__ __forceinline__ void conv_finish(Frame& F, int layer) {
    while (conv_work_one(F, layer)) { }
    unsigned* cnt = (unsigned*)(F.ws + WS_CTL) + CW_CONV_DONE + 64 * layer; const unsigned want = (unsigned)(NWG * NWAVES);
    for (unsigned spins = 0; spins < (1u << 22); ++spins) {
        unsigned d = 0; if (F.lane == 0) d = __hip_atomic_load(cnt, __ATOMIC_RELAXED, __HIP_MEMORY_SCOPE_AGENT);
        d = (unsigned)__builtin_amdgcn_readfirstlane((int)d);
        if (d >= want) break;
        __builtin_amdgcn_s_sleep(8);
    }
    __syncthreads();
}
__device__ __forceinline__ void p0_prologue(Frame& F) {
    LAS float* scr = (LAS float*)(F.lds + RING_OFF + F.wave * 16384);
    const int gw = blockIdx.x * NWAVES + F.wave, NGW = NWG * NWAVES;
    for (int it = gw; it < I_LAYER; it += NGW) conv_item(F, it, scr);
    bf16* XB = (bf16*)(F.ws + WS_XB); float* SS = (float*)(F.ws + WS_SS);
    for (int m = gw; m < M; m += NGW) {
        const GAS f32x4* xr = (const GAS f32x4*)(F.x + (size_t)m * D) + F.lane; GAS v2u* bo = (GAS v2u*)(XB + (size_t)m * D) + F.lane;
        float s = 0.f;
#pragma unroll
        for (int j = 0; j < 8; ++j) { const f32x4 v = xr[64 * j]; s += (v[0] * v[0] + v[1] * v[1]) + (v[2] * v[2] + v[3] * v[3]); v2u w; w.x = pk2(v[0], v[1]); w.y = pk2(v[2], v[3]); bo[64 * j] = w; }
        s = wave_sum(s, F.lane);
        if (F.lane < 32) SS[(size_t)m * 32 + F.lane] = (F.lane == 0) ? s : 0.f;
    }
    float* rope = (float*)(F.ws + WS_ROPE);
    for (int t = blockIdx.x * (NWAVES * 64) + F.tid; t < T * 64; t += NWG * NWAVES * 64) {
        const int pos = t >> 6, i = t & 63; const float inv = powf(10000.0f, -(float)i * (1.0f / 64.0f)); const float ang = (float)pos * inv;
        float sn, cs; sincosf(ang, &sn, &cs); rope[2 * t] = cs; rope[2 * t + 1] = sn;
    }
}

template <bool P2> __device__ __forceinline__ void ret_unit(Frame& F, int u, int layer) {
    LAS unsigned char* lds = F.lds + RING_OFF;
    const int w = F.wave, lane_u = F.lane;
    int lane = lane_u, g = lane >> 4, c16 = lane & 15;
    const int bh = u >> 4, seg = u & 15, b = bh >> 3, h = bh & 7;
    const size_t tb = (size_t)b * T + (size_t)seg * 512;
    const float l2g = l2gamma(h);
    const float cdec = ex2(l2g * 64.0f);
    const bf16* Qg = (const bf16*)(F.ws + WS_Q); const bf16* Kg = (const bf16*)(F.ws + WS_K); const bf16* Vg = (const bf16*)(F.ws + WS_V); const bf16* SGg = (const bf16*)(F.ws + WS_SG);
    bf16* RA = (bf16*)(F.ws + WS_RA);
    float* sp = (float*)(F.ws + WS_SLOC) + (size_t)(bh * 16 + seg) * (128 * 256);
    const float* gnw = F.ret_gn_w + (size_t)layer * 2048 + h * 256;
    f32x4 st[8][2];
    { int so = (32 * w + c16) * 128 + 4 * g;
#pragma unroll
      for (int dt = 0; dt < 8; ++dt) {
        asm volatile("" : "+v"(so));
        const GAS float* spl = (const GAS float*)sp + so;
#pragma unroll
        for (int et = 0; et < 2; ++et) {
            if (P2) st[dt][et] = *(const GAS f32x4*)(spl + et * 2048);
            else st[dt][et] = (f32x4){0.f, 0.f, 0.f, 0.f}; }
        so += 16; } }
    const float l2g_u = l2g;
    v4u qr[2], kr[2], vr[4];
    { const int tid = (w << 6) | lane_u;
#pragma unroll
    for (int i = 0; i < 2; ++i) { const int ch = tid + 512 * i, row = ch >> 4, c8 = ch & 15;
        if (P2) qr[i] = *(const GAS v4u*)(Qg + (tb + row) * 1024 + h * 128 + c8 * 8);
        kr[i] = *(const GAS v4u*)(Kg + (tb + row) * 1024 + h * 128 + c8 * 8); }
#pragma unroll
    for (int i = 0; i < 4; ++i) { const int ch = tid + 512 * i, row = ch >> 5, c8 = ch & 31; vr[i] = *(const GAS v4u*)(Vg + (tb + row) * 2048 + h * 256 + c8 * 8); } }
    for (int cc = 0; cc < 8; ++cc) {
        const size_t r0 = tb + (size_t)cc * 64;
        float l2g = l2g_u; asm volatile("" : "+v"(l2g));
        lane = lane_u; asm volatile("" : "+v"(lane)); g = lane >> 4; c16 = lane & 15;
        const int tid = (w << 6) | lane;
        LAS unsigned char* img = P2 ? lds : lds + (cc & 1) * R1_BUF;
#pragma unroll
        for (int i = 0; i < 2; ++i) { const int ch = tid + 512 * i, row = ch >> 4, c8 = ch & 15;
            if (P2) { *(LAS v4u*)(img + R_Q + row * PQ + c8 * 16) = qr[i]; *(LAS v4u*)(img + R_K + row * PQ + c8 * 16) = kr[i]; }
            const v4u kv = kr[i]; const float kd = ex2(l2g * (float)(63 - row));
            v4u ks; ks.x = pk2(blo(kv.x) * kd, bhi(kv.x) * kd); ks.y = pk2(blo(kv.y) * kd, bhi(kv.y) * kd); ks.z = pk2(blo(kv.z) * kd, bhi(kv.z) * kd); ks.w = pk2(blo(kv.w) * kd, bhi(kv.w) * kd);
            *(LAS v4u*)(img + (P2 ? R_KS : R1_KS) + row * PQ + c8 * 16) = ks; }
#pragma unroll
        for (int i = 0; i < 4; ++i) { const int ch = tid + 512 * i, row = ch >> 5, c8 = ch & 31; { LAS unsigned char* vp = img + (P2 ? R_V : R1_V) + row * PV + ((c8 >> 2) * 32 + (c8 & 3) * 4) * 2;
            v2u lo_, hi_; lo_.x = vr[i].x; lo_.y = vr[i].y; hi_.x = vr[i].z; hi_.y = vr[i].w; *(LAS v2u*)vp = lo_; *(LAS v2u*)(vp + 32) = hi_; } }
        __syncthreads();
        if (cc < 7) { const size_t rn = r0 + 64;
#pragma unroll
            for (int i = 0; i < 2; ++i) { const int ch = tid + 512 * i, row = ch >> 4, c8 = ch & 15;
                if (P2) qr[i] = *(const GAS v4u*)(Qg + (rn + row) * 1024 + h * 128 + c8 * 8);
                kr[i] = *(const GAS v4u*)(Kg + (rn + row) * 1024 + h * 128 + c8 * 8); }
#pragma unroll
            for (int i = 0; i < 4; ++i) { const int ch = tid + 512 * i, row = ch >> 5, c8 = ch & 31; vr[i] = *(const GAS v4u*)(Vg + (rn + row) * 2048 + h * 256 + c8 * 8); } }
        f32x4 o[2][4];
        if (P2) {
#pragma unroll
            for (int tt = 0; tt < 2; ++tt) { const int t16 = 2 * w + tt, jt = t16 >> 2, it = t16 & 3; f32x4 a = (f32x4){0.f, 0.f, 0.f, 0.f};
#pragma unroll
                for (int ks = 0; ks < 4; ++ks) { const bf16x8 A = *(const LAS bf16x8*)(lds + R_K + (16 * jt + c16) * PQ + (32 * ks + 8 * g) * 2); const bf16x8 B = *(const LAS bf16x8*)(lds + R_Q + (16 * it + c16) * PQ + (32 * ks + 8 * g) * 2);
                    a = MFMA16(A, B, a); }
                const int ii = 16 * it + c16;
#pragma unroll
                for (int r = 0; r < 4; ++r) { const int jj = 16 * jt + 4 * g + r; a[r] *= ex2(l2g * fabsf((float)(ii - jj))); }
                v2u pw; pw.x = pg8::cvt_pk_bf16(a[0], a[1]); pw.y = pg8::cvt_pk_bf16(a[2], a[3]);
                *(LAS v2u*)(lds + R_P + ii * PP + (16 * jt + 4 * g) * 2) = pw; }
            __syncthreads();
#pragma unroll
            for (int et = 0; et < 2; ++et)
#pragma unroll
                for (int it = 0; it < 4; ++it) o[et][it] = (f32x4){0.f, 0.f, 0.f, 0.f};
#pragma unroll
            for (int ks = 0; ks < 4; ++ks) { bf16x8 A[2];
#pragma unroll
                for (int et = 0; et < 2; ++et) A[et] = pack_f8(st[2 * ks][et], st[2 * ks + 1][et]);
#pragma unroll
                for (int it = 0; it < 4; ++it) { LAS const unsigned char* qp = lds + R_Q + (16 * it + c16) * PQ + (32 * ks + 4 * g) * 2;
                    const s16x4 lo = *(const LAS s16x4*)qp, hi = *(const LAS s16x4*)(qp + 32); const bf16x8 B = __builtin_shufflevector(lo, hi, 0, 1, 2, 3, 4, 5, 6, 7);
#pragma unroll
                    for (int et = 0; et < 2; ++et) o[et][it] = MFMA16(A[et], B, o[et][it]); }
                __builtin_amdgcn_sched_barrier(0); }
#pragma unroll
            for (int it = 0; it < 4; ++it) { const float qd = ex2(l2g * (float)(16 * it + c16 + 1));
#pragma unroll
                for (int et = 0; et < 2; ++et) o[et][it] *= qd; }
        }
        if (P2) {
#pragma unroll
            for (int ks2 = 0; ks2 < 2; ++ks2) { bf16x8 vf[2];
#pragma unroll
                for (int et = 0; et < 2; ++et) vf[et] = tr_frag(img + (P2 ? R_V : R1_V), PV, 32 * ks2, 32 * w + 16 * et, lane);
#pragma unroll
                for (int it = 0; it < 4; ++it) { const bf16x8 B = *(const LAS bf16x8*)(lds + R_P + (16 * it + c16) * PP + (32 * ks2 + 8 * g) * 2);
#pragma unroll
                    for (int et = 0; et < 2; ++et) o[et][it] = MFMA16(vf[et], B, o[et][it]); __builtin_amdgcn_sched_barrier(0); } }
        }
#pragma unroll
        for (int dt = 0; dt < 8; ++dt)
#pragma unroll
            for (int et = 0; et < 2; ++et) st[dt][et] *= cdec;
#pragma unroll
        for (int ks2 = 0; ks2 < 2; ++ks2) { bf16x8 vf[2];
#pragma unroll
            for (int et = 0; et < 2; ++et) vf[et] = tr_frag(img + (P2 ? R_V : R1_V), PV, 32 * ks2, 32 * w + 16 * et, lane);
#pragma unroll
            for (int dt = 0; dt < 8; ++dt) { const bf16x8 A = tr_frag(img + (P2 ? R_KS : R1_KS), PQ, 32 * ks2, 16 * dt, lane);
#pragma unroll
                for (int et = 0; et < 2; ++et) st[dt][et] = MFMA16(A, vf[et], st[dt][et]); __builtin_amdgcn_sched_barrier(0); } }
        if (P2) {
            LAS f32x2* red = (LAS f32x2*)(lds + R_RED);
            v4u sgr[4];
#pragma unroll
            for (int it = 0; it < 4; ++it) sgr[it] = *(const GAS v4u*)(SGg + (r0 + 16 * it + c16) * 2048 + h * 256 + 32 * w + 8 * g);
#pragma unroll
            for (int it = 0; it < 4; ++it) { float s1 = 0.f, s2 = 0.f;
#pragma unroll
                for (int et = 0; et < 2; ++et)
#pragma unroll
                    for (int r = 0; r < 4; ++r) { const float v = o[et][it][r]; s1 += v; s2 += v * v; }
                s1 += pg8::shx(s1, 16, lane); s1 += pg8::shx(s1, 32, lane); s2 += pg8::shx(s2, 16, lane); s2 += pg8::shx(s2, 32, lane);
                if (g == 0) red[w * 64 + 16 * it + c16] = (f32x2){s1, s2}; }
            __syncthreads();
#pragma unroll
            for (int it = 0; it < 4; ++it) { const int ii = 16 * it + c16; float S1 = 0.f, S2 = 0.f;
#pragma unroll
                for (int w8 = 0; w8 < 8; ++w8) { const f32x2 t = red[w8 * 64 + ii]; S1 += t.x; S2 += t.y; }
                const float mu = S1 * (1.0f / 256.0f), var = fmaxf(S2 * (1.0f / 256.0f) - mu * mu, 0.f), rstd = 1.0f / sqrtf(var + EPS);
                { const int col = h * 256 + 32 * w + 8 * g; const size_t off = (r0 + ii) * 2048 + col; const v4u sg = sgr[it]; v4u ow;
                  { const f32x4 gw4 = *(const f32x4*)(gnw + 32 * w + 8 * g);
                    const float y0 = (o[0][it][0] - mu) * rstd * gw4[0] * blo(sg.x), y1 = (o[0][it][1] - mu) * rstd * gw4[1] * bhi(sg.x), y2 = (o[0][it][2] - mu) * rstd * gw4[2] * blo(sg.y), y3 = (o[0][it][3] - mu) * rstd * gw4[3] * bhi(sg.y);
                    ow.x = pg8::cvt_pk_bf16(y0, y1); ow.y = pg8::cvt_pk_bf16(y2, y3); }
                  { const f32x4 gw4 = *(const f32x4*)(gnw + 32 * w + 8 * g + 4);
                    const float y0 = (o[1][it][0] - mu) * rstd * gw4[0] * blo(sg.z), y1 = (o[1][it][1] - mu) * rstd * gw4[1] * bhi(sg.z), y2 = (o[1][it][2] - mu) * rstd * gw4[2] * blo(sg.w), y3 = (o[1][it][3] - mu) * rstd * gw4[3] * bhi(sg.w);
                    ow.z = pg8::cvt_pk_bf16(y0, y1); ow.w = pg8::cvt_pk_bf16(y2, y3); }
                  *(GAS v4u*)(RA + off) = ow; } }
        }
    }
    __syncthreads();
#if !defined(SKIP_R1_STORE)
    if (!P2) {
        int so = (32 * w + c16) * 128 + 4 * g;
#pragma unroll
        for (int dt = 0; dt < 8; ++dt) {
            asm volatile("" : "+v"(so));
            GAS float* spl = (GAS float*)sp + so;
#pragma unroll
            for (int et = 0; et < 2; ++et) *(GAS f32x4*)(spl + et * 2048) = st[dt][et];
            so += 16; }
    }
#else
    if (!P2) { float acc_ = 0.f;
#pragma unroll
        for (int dt = 0; dt < 8; ++dt)
#pragma unroll
            for (int et = 0; et < 2; ++et)
#pragma unroll
                for (int r = 0; r < 4; ++r) acc_ += st[dt][et][r];
        if (acc_ == 123.456f) sp[0] = acc_; }
#endif
}
__device__ __forceinline__ void ret_scan(Frame& F) {
    float* sl = (float*)(F.ws + WS_SLOC);
    for (int idx = blockIdx.x * (NWAVES * 64) + F.tid; idx < 16 * 8192; idx += NWG * NWAVES * 64) {
        const int bh = idx >> 13, e4 = idx & 8191, h = bh & 7;
        const float l2g = l2gamma(h); const float cd8 = ex2(l2g * 512.0f);
        f32x4 carry = (f32x4){0.f, 0.f, 0.f, 0.f}; asm volatile("" : "+v"(carry));
        for (int seg = 0; seg < 16; ++seg) { GAS f32x4* p = (GAS f32x4*)(sl + (size_t)(bh * 16 + seg) * 32768) + e4; const f32x4 t = *p; *p = carry; carry = carry * cd8 + t; }
    }
}

__device__ __forceinline__ void sgu_stats(const float* LS, size_t r0, LAS f32x2* stt, int tid) {
    if (tid < 128) { const GAS f32x4* p = (const GAS f32x4*)(LS + (r0 + tid) * 64); float S1 = 0.f, S2 = 0.f;
#pragma unroll
        for (int i = 0; i < 16; ++i) { const f32x4 t = p[i]; S1 += t[0] + t[2]; S2 += t[1] + t[3]; }
        const float mu = S1 * (1.0f / 2048.0f), var = fmaxf(S2 * (1.0f / 2048.0f) - mu * mu, 0.f); stt[tid] = (f32x2){mu, 1.0f / sqrtf(var + EPS)}; }
}
__device__ __forceinline__ void sgu_phase(Frame& F, int layer) {
    LAS unsigned char* lds = F.lds + RING_OFF;
    const int w = F.wave, lane_u = F.lane;
    int lane = lane_u, tid = (w << 6) | lane, g = lane >> 4, c16 = lane & 15;
    const bf16* ZU = (const bf16*)(F.ws + WS_ZU); const bf16* ZV = (const bf16*)(F.ws + WS_ZV); bf16* SB = (bf16*)(F.ws + WS_SB);
    const float* LS = (const float*)(F.ws + WS_LS);
    int cg_loaded = -1;
    v4u zvr[8];
    int u = blockIdx.x;
    if (u < 1024) { const int cg = u & 7; const size_t r0 = (size_t)(u >> 3) * 128;
#pragma unroll
        for (int i = 0; i < 8; ++i) { const int ch = tid + 512 * i, j = ch >> 5, c8 = ch & 31; zvr[i] = *(const GAS v4u*)(ZV + (r0 + j) * 2048 + 256 * cg + 8 * c8); }
        sgu_stats(LS, r0, (LAS f32x2*)(lds + S_ST), tid); }
    for (int it_u = 0; u < 1024; u += NWG, ++it_u) {
        lane = lane_u; asm volatile("" : "+v"(lane)); tid = (w << 6) | lane; g = lane >> 4; c16 = lane & 15;
        const int cg = u & 7, rg = u >> 3; const size_t r0 = (size_t)rg * 128; const int ch0 = 256 * cg;
        const float* lnw = F.sgu_ln_w + (size_t)layer * 2048 + ch0; const float* lnb = F.sgu_ln_b + (size_t)layer * 2048 + ch0;
        const float* bs = F.sgu_b_s + ((size_t)layer * 8 + cg) * 128;
        LAS f32x2* stt = (LAS f32x2*)(lds + S_ST + (it_u & 1) * 1024);
        if (cg != cg_loaded) { const float* wsrc = F.sgu_w_s + ((size_t)layer * 8 + cg) * (128 * 128); cg_loaded = cg;
#pragma unroll
            for (int i = 0; i < 8; ++i) { const int idx4 = tid + 512 * i, ir = idx4 >> 5, j4 = (idx4 & 31) * 4; f32x4 wv = *(const GAS f32x4*)(wsrc + ir * 128 + j4);
                if ((j4 >> 6) > (ir >> 6)) wv = (f32x4){0.f, 0.f, 0.f, 0.f};
                v2u pw; pw.x = pk2(wv[0], wv[1]); pw.y = pk2(wv[2], wv[3]); *(LAS v2u*)(lds + S_W + ir * PQ + j4 * 2) = pw; } }
        if (it_u == 0) __syncthreads();
#pragma unroll
        for (int i = 0; i < 8; ++i) { const int ch = tid + 512 * i, j = ch >> 5, c8 = ch & 31; const v4u zv = zvr[i];
            const f32x4 w0 = *(const f32x4*)(lnw + 8 * c8), w1 = *(const f32x4*)(lnw + 8 * c8 + 4), b0 = *(const f32x4*)(lnb + 8 * c8), b1 = *(const f32x4*)(lnb + 8 * c8 + 4);
            const f32x2 ms = stt[j]; const float mu = ms.x, rs = ms.y;
            v4u o; o.x = pk2((blo(zv.x) - mu) * rs * w0[0] + b0[0], (bhi(zv.x) - mu) * rs * w0[1] + b0[1]); o.y = pk2((blo(zv.y) - mu) * rs * w0[2] + b0[2], (bhi(zv.y) - mu) * rs * w0[3] + b0[3]);
            o.z = pk2((blo(zv.z) - mu) * rs * w1[0] + b1[0], (bhi(zv.z) - mu) * rs * w1[1] + b1[1]); o.w = pk2((blo(zv.w) - mu) * rs * w1[2] + b1[2], (bhi(zv.w) - mu) * rs * w1[3] + b1[3]);
            { LAS unsigned char* vp = lds + S_VN + j * PV + ((c8 >> 2) * 32 + (c8 & 3) * 4) * 2;
              v2u lo_, hi_; lo_.x = o.x; lo_.y = o.y; hi_.x = o.z; hi_.y = o.w; *(LAS v2u*)vp = lo_; *(LAS v2u*)(vp + 32) = hi_; } }
        __syncthreads();
        const int un = u + NWG;
        if (un < 1024) { const size_t rn = (size_t)(un >> 3) * 128; const int cgn = un & 7;
#pragma unroll
            for (int i = 0; i < 8; ++i) { const int ch = tid + 512 * i, j = ch >> 5, c8 = ch & 31; zvr[i] = *(const GAS v4u*)(ZV + (rn + j) * 2048 + 256 * cgn + 8 * c8); }
            sgu_stats(LS, rn, (LAS f32x2*)(lds + S_ST + ((it_u + 1) & 1) * 1024), tid); }
        v4u zur[8];
#pragma unroll
        for (int it = 0; it < 8; ++it) zur[it] = *(const GAS v4u*)(ZU + (r0 + 16 * it + c16) * 2048 + ch0 + 32 * w + 8 * g);
        f32x4 acc[2][8];
#pragma unroll
        for (int ct = 0; ct < 2; ++ct)
#pragma unroll
            for (int it = 0; it < 8; ++it) acc[ct][it] = (f32x4){0.f, 0.f, 0.f, 0.f};
#pragma unroll
        for (int ks = 0; ks < 4; ++ks) { bf16x8 A[2];
#pragma unroll
            for (int ct = 0; ct < 2; ++ct) A[ct] = tr_frag(lds + S_VN, PV, 32 * ks, 32 * w + 16 * ct, lane);
#pragma unroll
            for (int it = 0; it < 8; ++it) { if (it < 4 && ks >= 2) continue;
                const bf16x8 B = *(const LAS bf16x8*)(lds + S_W + (16 * it + c16) * PQ + (32 * ks + 8 * g) * 2);
#pragma unroll
                for (int ct = 0; ct < 2; ++ct) acc[ct][it] = MFMA16(A[ct], B, acc[ct][it]); __builtin_amdgcn_sched_barrier(0); } }
#pragma unroll
        for (int it = 0; it < 8; ++it) { const int ii = 16 * it + c16; const float bsv = bs[ii];
            { const size_t off = (r0 + ii) * 2048 + ch0 + 32 * w + 8 * g; const v4u zu = zur[it];
                v4u ow; ow.x = pg8::cvt_pk_bf16(blo(zu.x) * (acc[0][it][0] + bsv), bhi(zu.x) * (acc[0][it][1] + bsv)); ow.y = pg8::cvt_pk_bf16(blo(zu.y) * (acc[0][it][2] + bsv), bhi(zu.y) * (acc[0][it][3] + bsv));
                ow.z = pg8::cvt_pk_bf16(blo(zu.z) * (acc[1][it][0] + bsv), bhi(zu.z) * (acc[1][it][1] + bsv)); ow.w = pg8::cvt_pk_bf16(blo(zu.w) * (acc[1][it][2] + bsv), bhi(zu.w) * (acc[1][it][3] + bsv));
                *(GAS v4u*)(SB + off) = ow; } }
        __syncthreads();
    }
}

__device__ __forceinline__ void final_norm(Frame& F) {
    const int gw = blockIdx.x * NWAVES + F.wave, NGW = NWG * NWAVES;
    const bf16* XB = (const bf16*)(F.ws + WS_XB); const float* SS = (const float*)(F.ws + WS_SS);
    for (int m = gw; m < M; m += NGW) {
        const float s = wave_sum(F.lane < 32 ? SS[(size_t)m * 32 + F.lane] : 0.f, F.lane); const float rstd = 1.0f / sqrtf(s * (1.0f / 2048.0f) + EPS);
        const GAS v2u* xr = (const GAS v2u*)(XB + (size_t)m * D) + F.lane; const GAS f32x4* fw = (const GAS f32x4*)F.final_norm_w + F.lane; GAS f32x4* o = (GAS f32x4*)(F.out + (size_t)m * D) + F.lane;
#pragma unroll
        for (int j = 0; j < 8; ++j) { const v2u w = xr[64 * j]; const f32x4 g = fw[64 * j]; o[64 * j] = (f32x4){blo(w.x) * rstd * g[0], bhi(w.x) * rstd * g[1], blo(w.y) * rstd * g[2], bhi(w.y) * rstd * g[3]}; }
    }
}

#if defined(PROBE_STOP)
__device__ __forceinline__ void probe_dump(Frame& F) {
    const size_t offs[12] = {WS_V, WS_SG, WS_ZU, WS_ZV, WS_GA, WS_GB, WS_RA, WS_SB, WS_MG, WS_XB, WS_P, 0};
    for (size_t i = (size_t)blockIdx.x * 512 + F.tid; i < (size_t)M * D; i += (size_t)NWG * 512) {
        float a = 0.f; const size_t m = i >> 11, c = i & 2047;
#pragma unroll
        for (int b = 0; b < 11; ++b) if (PROBE_MASK & (1 << b)) a += blo((unsigned)((const bf16*)(F.ws + offs[b]))[i]);
        if (PROBE_MASK & (1 << 11)) { if (c < 1024) a += blo((unsigned)((const bf16*)(F.ws + WS_Q))[m * 1024 + c]) + blo((unsigned)((const bf16*)(F.ws + WS_K))[m * 1024 + c]); }
        if (PROBE_MASK & (1 << 12)) a += blo((unsigned)((const bf16*)(F.ws + WS_H))[m * 5632 + c]) + blo((unsigned)((const bf16*)(F.ws + WS_H))[m * 5632 + 2048 + c]) + ((c < 1536) ? blo((unsigned)((const bf16*)(F.ws + WS_H))[m * 5632 + 4096 + c]) : 0.f);
        if (PROBE_MASK & (1 << 13)) { if (i < (size_t)D * D) a += blo((unsigned)((const bf16*)(F.ws + WS_W + W_R))[i]); }
        if (PROBE_MASK & (1 << 14)) { if (i < (size_t)D * D) a += blo((unsigned)((const bf16*)(F.ws + WS_W + W_S))[i]) + blo((unsigned)((const bf16*)(F.ws + WS_W + W_O))[i]); }
        F.out[i] = a;
    }
}
#endif
constexpr int PH_PER_LAYER = 8, NPHASES = 2 + DEPTH * PH_PER_LAYER;
struct Args { const float* in[15]; float* out; unsigned char* ws; int ph_lo, ph_hi; };
static_assert(sizeof(Args) == 15 * 8 + 8 + 8 + 8, "Args has no padding");
__global__ void __launch_bounds__(NWAVES * 64, 2) mk_fwd(Args args) {
    extern __shared__ __attribute__((aligned(16))) unsigned char lds_raw[];
    Frame F;
    F.lds = (LAS unsigned char*)lds_raw;
    F.tid = threadIdx.x; F.lane = F.tid & 63; F.wave = __builtin_amdgcn_readfirstlane(F.tid >> 6);
    F.x = args.in[0]; F.norm_mix_w = args.in[1]; F.w_in = args.in[2]; F.ret_gn_w = args.in[3]; F.ret_proj = args.in[4]; F.sgu_ln_w = args.in[5]; F.sgu_ln_b = args.in[6]; F.sgu_w_s = args.in[7];
    F.sgu_b_s = args.in[8]; F.sgu_proj = args.in[9]; F.w_out = args.in[10]; F.norm_ffn_w = args.in[11]; F.w_ffn_in = args.in[12]; F.w_ffn_out = args.in[13]; F.final_norm_w = args.in[14];
    F.out = args.out; F.ws = args.ws;
#if defined(ZERO_LDS)
    for (int u = F.tid; u < LDS_BYTES / 4; u += NWAVES * 64) ((LAS unsigned*)(F.lds))[u] = 0u;
#else
    for (int u = F.tid; u < (LDS_BYTES - LDSCTL_OFF) / 4; u += NWAVES * 64) ((LAS unsigned*)(F.lds + LDSCTL_OFF))[u] = 0u;
#endif
    __syncthreads();
#if MK_PER_PHASE || defined(PROBE_STOP)
    const int lo = args.ph_lo, hi = args.ph_hi;
#else
    constexpr int lo = 0, hi = NPHASES;
#endif
    unsigned* ctl = (unsigned*)(F.ws + WS_CTL);
#if defined(TAIL_MIN)
    if (blockIdx.x == 0 && threadIdx.x == 0) ((unsigned long long*)(ctl + 2048))[1] = ~0ull;
#endif
    XcdBarrier bar; bar.bar = ctl + CW_BAR; bar.x = 0; bar.st = nullptr;
    if (hi - lo > 1) bar = xcd_barrier_post(ctl + CW_BAR, (volatile LAS unsigned*)(F.lds + MISC_OFF) + 8);
#ifndef MK_ONLY
#define MK_ONLY -1
#endif
#if defined(PROBE_STOP)
#define IN(k) (lo <= (k) && (k) < hi && ((k) <= PROBE_STOP || (k) == NPHASES - 1))
#elif MK_PER_PHASE
#define IN(k) (lo <= (k) && (k) < hi)
#else
#define IN(k) true
#endif
#define INP(slot, k) ((MK_ONLY < 0 || MK_ONLY == (slot)) && IN(k))
#ifndef DUP_SLOT
#define DUP_SLOT -1
#endif
#define REP(slot) for (int rep_ = 0; rep_ < ((DUP_SLOT == (slot)) ? 2 : 1); ++rep_)
#if defined(TAIL_PROBE)
    unsigned long long wait_sum = 0ull;
#ifndef TAIL_MASK
#define TAIL_MASK 0x1ff
#endif
#define SEAM(k) do { if (IN(k) && IN((k) + 1)) { const unsigned long long t0_ = wall_clock64(); xcd_barrier(bar); const int st_ = ((k) == 0) ? 8 : (((k) - 1) & 7); if ((TAIL_MASK >> st_) & 1) wait_sum += wall_clock64() - t0_; } } while (0)
#elif defined(DUP_BARRIER)
#define SEAM(k) do { if (IN(k) && IN((k) + 1)) { xcd_barrier(bar); xcd_barrier(bar); } } while (0)
#else
#define SEAM(k) do { if (IN(k) && IN((k) + 1)) { FRESH(); XcdBarrier b2_ = bar; b2_.bar = (unsigned*)(F.ws + WS_CTL) + CW_BAR; { unsigned so_ = MISC_OFF + 32; asm volatile("" : "+s"(so_)); b2_.st = (volatile LAS unsigned*)(F.lds + so_); } xcd_barrier_idle(b2_, F, F.tid); } } while (0)
#endif
    size_t zero_o = 0; const int wave_s = __builtin_amdgcn_readfirstlane(threadIdx.x >> 6);
#define FRESH() do { asm volatile("" : "+s"(zero_o)); int l_; asm volatile("v_mbcnt_lo_u32_b32 %0, -1, 0\n\tv_mbcnt_hi_u32_b32 %0, -1, %0" : "=v"(l_)); F.ws = args.ws + zero_o; F.lane = l_; F.wave = wave_s; F.tid = (wave_s << 6) | l_; } while (0)
#if defined(START_DELAY)
    if (IN(0)) { const unsigned long long t0 = wall_clock64(); while (wall_clock64() - t0 < 100ull * START_DELAY) __builtin_amdgcn_s_sleep(32); }
#endif
    if (INP(0, 0)) REP(0) { FRESH(); p0_prologue(F); }
    SEAM(0);
    for (int l = 0; l < DEPTH; ++l) {
        const int pb = 1 + PH_PER_LAYER * l;
        if (INP(1, pb + 0)) REP(1) { FRESH(); unsigned char* wl = F.ws + WS_W + (size_t)l * W_LAYER;
            pg8::Gemm gm{(const pg8::bf16_t*)(F.ws + WS_XB), (const pg8::bf16_t*)(wl + W_IN), M, NIN, D}; pg8::StaticOrder S; S.init(M, NIN, NWG, (int)blockIdx.x);
#if defined(G1_REV)
            pg8::RevOrder SR; SR.base = S;
#endif
            pg8::Unit u0; S.next(0, u0); const LAS float* rstab = (const LAS float*)(F.lds + RSTAB_OFF); pg8::rstd_table((const float*)(F.ws + WS_SS), u0.pm, (LAS float*)(F.lds + RSTAB_OFF), F.tid);
            pg8::EpiIn E{(const float*)(F.ws + WS_SS), (const float*)(F.ws + WS_ROPE), (pg8::bf16_t*)(F.ws + WS_Q), (pg8::bf16_t*)(F.ws + WS_K), (pg8::bf16_t*)(F.ws + WS_O2048), (float*)(F.ws + WS_LS), rstab, u0.pm};
#if defined(TIMING_NULL_G1)
#if defined(TIMING_SAME_TILE)
            if (rep_ == 1) { pg8::EpiNull EN{(float*)(F.ws + WS_SLOC)}; pg8::SameTileOrder ST{14}; pg8::gemm_phase<pg8::EpiNull, pg8::SameTileOrder, true, true>(F.lds + RING_OFF, gm, ST, EN, F.tid); } else
#else
#if defined(TIMING_NOSP2)
            if (rep_ == 1) { pg8::EpiNull EN{(float*)(F.ws + WS_SLOC)}; pg8::gemm_phase<pg8::EpiNull, pg8::StaticOrder, true, false>(F.lds + RING_OFF, gm, S, EN, F.tid); } else
#elif defined(TIMING_MM32)
            if (rep_ == 1) { pg8::EpiNull EN{(float*)(F.ws + WS_SLOC)}; pg8::gemm_phase<pg8::EpiNull, pg8::StaticOrder, true, true, true>(F.lds + RING_OFF, gm, S, EN, F.tid); } else
#else
            if (rep_ == 1) { pg8::EpiNull EN{(float*)(F.ws + WS_SLOC)}; pg8::gemm_phase<pg8::EpiNull, pg8::StaticOrder, true, true>(F.lds + RING_OFF, gm, S, EN, F.tid); } else
#endif
#endif
#endif
#if defined(G1_REV)
            pg8::gemm_phase<pg8::EpiIn, pg8::RevOrder, true, true>(F.lds + RING_OFF, gm, SR, E, F.tid);
#else
            pg8::gemm_phase<pg8::EpiIn, pg8::StaticOrder, true, true>(F.lds + RING_OFF, gm, S, E, F.tid);
#endif
        }
        SEAM(pb + 0);
        if (INP(2, pb + 1)) REP(2) { FRESH();
#if !defined(SKIP_R1)
#if defined(DUPSKIP_R1)
            if (rep_ == 0)
#endif
            for (int u = blockIdx.x; u < 256; u += NWG) ret_unit<false>(F, u, l);
#endif
#if defined(SLEEP_R1)
            { const unsigned long long t0 = wall_clock64(); while (wall_clock64() - t0 < 100ull * SLEEP_R1) __builtin_amdgcn_s_sleep(32); }
#endif
#if defined(DUMMY_R1)
            { const GAS v4u* src = (const GAS v4u*)(F.ws + WS_K); unsigned a_ = 0;
              for (size_t i = (size_t)blockIdx.x * 512 + F.tid; i < (size_t)96 * MiB / 16; i += (size_t)NWG * 512) { const v4u t = src[i]; a_ += t.x ^ t.y ^ t.z ^ t.w; }
              if (a_ == 0x12345678u) ((float*)(F.ws + WS_SLOC))[0] = 1.f; }
#endif
#if !defined(SGU_AFTER_R3)
            FRESH();
#if !defined(SKIP_SGU)
#if defined(DUPSKIP_SGU)
            if (rep_ == 0)
#endif
            sgu_phase(F, l);
#endif
#endif
        }
        SEAM(pb + 1);
        if (INP(3, pb + 2)) { FRESH(); ret_scan(F); }
        SEAM(pb + 2);
#if defined(SGU_AFTER_R3)
        if (INP(4, pb + 3)) REP(4) { FRESH(); for (int u = blockIdx.x; u < 256; u += NWG) ret_unit<true>(F, u, l); FRESH(); sgu_phase(F, l); }
#else
        if (INP(4, pb + 3)) REP(4) { FRESH(); for (int u = blockIdx.x; u < 256; u += NWG) ret_unit<true>(F, u, l); }
#endif
        SEAM(pb + 3);
        if (INP(5, pb + 4)) REP(5) { FRESH(); unsigned char* wl = F.ws + WS_W + (size_t)l * W_LAYER;
            pg8::Gemm gm{(const pg8::bf16_t*)(F.ws + WS_RA), (const pg8::bf16_t*)(wl + W_R), M, D, D}; pg8::PairOrder S; S.base.init(M, D, NWG, (int)blockIdx.x);
            pg8::EpiMerge E{(const pg8::bf16_t*)(F.ws + WS_GA), (const pg8::bf16_t*)(F.ws + WS_GB), (pg8::bf16_t*)(F.ws + WS_MG)};
            pg8::gemm_phase<pg8::EpiMerge, pg8::PairOrder, true, true>(F.lds + RING_OFF, gm, S, E, F.tid);
        }
        SEAM(pb + 4);
        if (INP(6, pb + 5)) REP(6) { FRESH(); unsigned char* wl = F.ws + WS_W + (size_t)l * W_LAYER;
            pg8::Gemm gm{(const pg8::bf16_t*)(F.ws + WS_MG), (const pg8::bf16_t*)(wl + W_O), M, D, D}; pg8::StaticOrder S; S.init(M, D, NWG, (int)blockIdx.x);
            pg8::EpiResid E{(pg8::bf16_t*)(F.ws + WS_XB), (float*)(F.ws + WS_SS2), (rep_ == 1) ? 0.f : 1.f};
#if defined(TIMING_NULL_G35)
            if (rep_ == 1) { pg8::EpiNull EN{(float*)(F.ws + WS_SLOC)}; pg8::gemm_phase<pg8::EpiNull, pg8::StaticOrder, true, true>(F.lds + RING_OFF, gm, S, EN, F.tid); } else
#endif
            pg8::gemm_phase<pg8::EpiResid, pg8::StaticOrder, true, true>(F.lds + RING_OFF, gm, S, E, F.tid);
        }
        SEAM(pb + 5);
        if (INP(7, pb + 6)) REP(7) { FRESH(); unsigned char* wl = F.ws + WS_W + (size_t)l * W_LAYER;
            pg8::Gemm gm{(const pg8::bf16_t*)(F.ws + WS_XB), (const pg8::bf16_t*)(wl + W_F1), M, NFF, D}; pg8::StaticOrder S; S.init(M, NFF, NWG, (int)blockIdx.x);
            pg8::Unit u0; S.next(0, u0); const LAS float* rstab = (const LAS float*)(F.lds + RSTAB_OFF); pg8::rstd_table((const float*)(F.ws + WS_SS2), u0.pm, (LAS float*)(F.lds + RSTAB_OFF), F.tid);
            pg8::EpiSwiglu E{(const float*)(F.ws + WS_SS2), (pg8::bf16_t*)(F.ws + WS_H), rstab, u0.pm};
#if defined(G4_REV)
            { pg8::RevOrder SR; SR.base = S; pg8::gemm_phase<pg8::EpiSwiglu, pg8::RevOrder, true, true>(F.lds + RING_OFF, gm, SR, E, F.tid); }
#else
            pg8::gemm_phase<pg8::EpiSwiglu, pg8::StaticOrder, true, true>(F.lds + RING_OFF, gm, S, E, F.tid);
#endif
        }
        SEAM(pb + 6);
        if (INP(8, pb + 7)) REP(8) { FRESH(); unsigned char* wl = F.ws + WS_W + (size_t)l * W_LAYER;
            pg8::Gemm gm{(const pg8::bf16_t*)(F.ws + WS_H), (const pg8::bf16_t*)(wl + W_F2), M, D, DFF}; pg8::StaticOrder S; S.init(M, D, NWG, (int)blockIdx.x);
            pg8::EpiResid E{(pg8::bf16_t*)(F.ws + WS_XB), (float*)(F.ws + WS_SS), (rep_ == 1) ? 0.f : 1.f};
#if defined(TIMING_NULL_G35)
            if (rep_ == 1) { pg8::EpiNull EN{(float*)(F.ws + WS_SLOC)}; pg8::gemm_phase<pg8::EpiNull, pg8::StaticOrder, true, true>(F.lds + RING_OFF, gm, S, EN, F.tid); } else
#endif
            pg8::gemm_phase<pg8::EpiResid, pg8::StaticOrder, true, true>(F.lds + RING_OFF, gm, S, E, F.tid);
        }
        if (IN(pb + 7) && l + 1 < DEPTH) conv_finish(F, l + 1);
        SEAM(pb + 7);
    }
#if defined(TAIL_PROBE)
    if (hi - lo > 1) { unsigned long long* accp = (unsigned long long*)(ctl + 2048);
#if defined(TAIL_MIN)
        if (F.tid == 0) atomicMin(accp + 1, wait_sum);
#else
        if (F.tid == 0) atomicAdd(accp, wait_sum);
#endif
        xcd_barrier(bar);
        if (blockIdx.x == 0 && F.tid == 0) {
#if defined(TAIL_MIN)
            const unsigned long long avg = __hip_atomic_load(accp + 1, __ATOMIC_RELAXED, __HIP_MEMORY_SCOPE_AGENT);
#else
            const unsigned long long tot = __hip_atomic_load(accp, __ATOMIC_RELAXED, __HIP_MEMORY_SCOPE_AGENT); const unsigned long long avg = tot / gridDim.x;
#endif
            const unsigned long long t0_ = wall_clock64(); while (wall_clock64() - t0_ < avg * TAIL_PROBE) __builtin_amdgcn_s_sleep(32); } }
#endif
#if defined(END_WB)
    asm volatile("s_waitcnt vmcnt(0)" ::: "memory"); __builtin_amdgcn_fence(__ATOMIC_RELEASE, "agent"); asm volatile("s_waitcnt vmcnt(0)" ::: "memory");
#endif
#if defined(PROBE_STOP)
    if (hi - lo > 1) xcd_barrier(bar);
    if (IN(NPHASES - 1)) { FRESH(); probe_dump(F); }
#else
    if (INP(9, NPHASES - 1)) { FRESH(); final_norm(F); }
#endif
#undef IN
#undef INP
#undef FRESH
#undef SEAM
}

extern "C" void kernel_launch(void* const* d_in, const int* in_sizes, int n_in, void* d_out, int out_size, void* d_ws, size_t ws_size, hipStream_t stream) {
    static int grid = 0;
    if (grid == 0) {
        if (n_in != 15 || in_sizes[0] != M * D || out_size != M * D || ws_size < WS_END) { fprintf(stderr, "kernel_launch: unexpected sizes (n_in %d, in0 %d, out %d, ws %zu < %zu?)\n", n_in, n_in > 0 ? in_sizes[0] : -1, out_size, ws_size, (size_t)WS_END); grid = -1; return; }
        int dev = 0, cus = 0, per_cu = 0;
        if (hipGetDevice(&dev) != hipSuccess || hipDeviceGetAttribute(&cus, hipDeviceAttributeMultiprocessorCount, dev) != hipSuccess) { grid = -1; return; }
        if (hipFuncSetAttribute((const void*)mk_fwd, hipFuncAttributeMaxDynamicSharedMemorySize, LDS_BYTES) != hipSuccess) { fprintf(stderr, "kernel_launch: hipFuncSetAttribute failed\n"); grid = -1; return; }
        if (hipOccupancyMaxActiveBlocksPerMultiprocessor(&per_cu, (const void*)mk_fwd, NWAVES * 64, LDS_BYTES) != hipSuccess || per_cu < 1) fprintf(stderr, "kernel_launch: occupancy query reports %d\n", per_cu);
        (void)hipGetLastError();
        if (cus < NWG) { fprintf(stderr, "kernel_launch: built for a %d-CU device (one resident workgroup per CU), this one has %d; nothing launched\n", NWG, cus); grid = -1; return; }
        grid = NWG;
    }
    if (grid < 0) return;
    if (hipMemsetAsync((char*)d_ws + WS_CTL, 0, CTL_ZERO_BYTES, stream) != hipSuccess) return;
    Args a{};
    for (int i = 0; i < 15; ++i) a.in[i] = (const float*)d_in[i];
    a.out = (float*)d_out; a.ws = (unsigned char*)d_ws;
#if MK_PER_PHASE
    for (int p = 0; p < NPHASES; ++p) { a.ph_lo = p; a.ph_hi = p + 1; hipLaunchKernelGGL(mk_fwd, dim3(grid), dim3(NWAVES * 64), LDS_BYTES, stream, a); }
#else
    a.ph_lo = 0; a.ph_hi = NPHASES; hipLaunchKernelGGL(mk_fwd, dim3(grid), dim3(NWAVES * 64), LDS_BYTES, stream, a);
#endif
}
```

```cpp
#define G1_REV 1
#define G4_REV 1
#define FP8_L0 3
#include <hip/hip_runtime.h>
#include <cstdio>
#include <cstdint>
namespace pg8 {
#define PG8_LAS __attribute__((address_space(3)))
typedef unsigned short bf16_t;
typedef short bf16x8 __attribute__((ext_vector_type(8)));
typedef float f32x4 __attribute__((ext_vector_type(4)));
typedef float f32x16 __attribute__((ext_vector_type(16)));
typedef unsigned u32x4 __attribute__((ext_vector_type(4)));
constexpr int BM = 256, BK = 64, HALF = 128, HTB = HALF * BK * 2  , STAGE_BYTES = 8 * HTB, NXCD = 8, WGM = 8;

__host__ __device__ __forceinline__ int lds_byte(int r, int c) { const int st = (r >> 4) * 2 + (c >> 5), rr = r & 15, cc = c & 31, ob = rr * 64 + cc * 2; return st * 1024 + (ob ^ (((ob >> 9) & 1) << 5)); }
__host__ __device__ __forceinline__ void stage_rc(int b, int& R, int& C) { const int st = b / 1024, sb = b % 1024, swz = sb ^ (((sb >> 9) & 1) << 5); R = (st >> 1) * 16 + swz / 64; C = (st & 1) * 32 + (swz % 64) / 2; }
__host__ __device__ __forceinline__ int perm32(int rho) { const int n = rho >> 4, i = rho & 15; return 8 * (i >> 2) + 4 * n + (i & 3); }

struct Unit { int pm, pn; };
struct Gemm { const bf16_t* A; const bf16_t* Bt; int M, N, K; };

struct StaticOrder {
    int nM, nN, nwg, G, c;
    __host__ __device__ __forceinline__ void init(int M, int N, int G_, int c_) { nM = M / BM; nN = N / BM; nwg = nM * nN; G = G_; c = c_; }
    __host__ __device__ __forceinline__ bool next(int i, Unit& u) const {
        const long L = (long)i * G + c; if (L >= nwg) return false;
        int wgid = (int)L; { const int q = nwg / NXCD, r = nwg % NXCD, xcd = wgid % NXCD, off = wgid / NXCD; wgid = (xcd < r ? xcd * (q + 1) : r * (q + 1) + (xcd - r) * q) + off; }
        const int nig = WGM * nN, gid = wgid / nig, fm = gid * WGM, gsz = (nM - fm) < WGM ? (nM - fm) : WGM;
        u.pm = fm + ((wgid % nig) % gsz); u.pn = (wgid % nig) / gsz; return true;
    }
    __device__ __forceinline__ void a_ready(const Unit&) const {}
    __device__ __forceinline__ void done(const Unit&) const {}
};

typedef float f32x2c_t __attribute__((ext_vector_type(2))); typedef __bf16 bf16x2c_t __attribute__((ext_vector_type(2)));
__device__ __forceinline__ unsigned cvt_pk_bf16(float lo, float hi) { const f32x2c_t v = {lo, hi}; const bf16x2c_t b = __builtin_convertvector(v, bf16x2c_t); return __builtin_bit_cast(unsigned, b); }
typedef float f32x2 __attribute__((ext_vector_type(2)));
__device__ __forceinline__ f32x2 gelu_pk(f32x2 v) {
    const f32x2 av = __builtin_elementwise_abs(v), d = av * 0.2316418882f + 1.0f;
    f32x2 t; t.x = __builtin_amdgcn_rcpf(d.x); t.y = __builtin_amdgcn_rcpf(d.y);
    f32x2 q = t * 0.5307027145f + (-0.7265760135f); q = q * t + 0.7107068705f; q = q * t + (-0.142248368f); q = q * t + 0.127414796f; q = q * t;
    const f32x2 s = (v * v) * (-0.72134752044f);
    f32x2 e; e.x = __builtin_amdgcn_exp2f(s.x); e.y = __builtin_amdgcn_exp2f(s.y);
    const f32x2 m = v * (q * e), r = v - m;
    f32x2 o; o.x = v.x < 0.f ? m.x : r.x; o.y = v.y < 0.f ? m.y : r.y; return o;
}

constexpr int MROWS = 16384, DM = 2048;
constexpr float RMS_EPS = 1e-6f;
__device__ __forceinline__ float shx(float v, int o, int lane) { return __builtin_bit_cast(float, __builtin_amdgcn_ds_bpermute((lane ^ o) << 2, __builtin_bit_cast(int, v))); }
__device__ __forceinline__ float sigm_f(float x) { return __builtin_amdgcn_rcpf(1.0f + __builtin_amdgcn_exp2f(x * -1.44269504089f)); }
__device__ __forceinline__ float silu_f(float x) { return x * sigm_f(x); }
__device__ __forceinline__ float bf_lo(unsigned w) { return __uint_as_float(w << 16); }
__device__ __forceinline__ float bf_hi(unsigned w) { return __uint_as_float(w & 0xffff0000u); }
__device__ __forceinline__ u32x4 pack8(const f32x4& a, const f32x4& b) { u32x4 w; w.x = cvt_pk_bf16(a[0], a[1]); w.y = cvt_pk_bf16(a[2], a[3]); w.z = cvt_pk_bf16(b[0], b[1]); w.w = cvt_pk_bf16(b[2], b[3]); return w; }
__device__ __forceinline__ float row_rstd1(const float* ss, int row, int fq) {
    const float* p = ss + (size_t)row * 32 + 8 * fq; const f32x4 a = *(const f32x4*)p, b = *(const f32x4*)(p + 4);
    float s = ((a[0] + a[1]) + (a[2] + a[3])) + ((b[0] + b[1]) + (b[2] + b[3])); { int ln; asm volatile("v_mbcnt_lo_u32_b32 %0, -1, 0\n\tv_mbcnt_hi_u32_b32 %0, -1, %0" : "=v"(ln)); s += shx(s, 16, ln); s += shx(s, 32, ln); }
    return 1.0f / sqrtf(s * (1.0f / 2048.0f) + RMS_EPS);
}

__device__ __forceinline__ void rstd_table(const float* ss, int pm0, PG8_LAS float* tab, int tid) {
    if (tid < 256) { const f32x4* p = (const f32x4*)(ss + (size_t)(pm0 * BM + tid) * 32); float s = 0.f;
#pragma unroll
        for (int i = 0; i < 8; ++i) { const f32x4 a = p[i]; s += (a[0] + a[1]) + (a[2] + a[3]); }
        tab[tid] = 1.0f / sqrtf(s * (1.0f / 2048.0f) + RMS_EPS); }
    __syncthreads();
}
#define ROW_RSTD(ss_, tab_, pm0_, u_, rl_, row_, fq_) (((u_).pm == (pm0_)) ? (tab_)[(rl_)] : row_rstd1((ss_), (row_), (fq_)))

struct EpiIn {
    static constexpr bool PERM = true, AFTER_DRAIN = false, CARRY = false;
    const float* ss;
    const float* rope;
    bf16_t* q; bf16_t* k;
    bf16_t* o2048;
    float* ls;
    const PG8_LAS float* rstab; int pm0;
    template <int ACT> __device__ __forceinline__ void emit(const f32x4 (&acc)[2][2][4][2], const Unit& u, bf16_t* base, int row0, int rl0, int col0, int slot0, int fq) const {
#pragma unroll
        for (int ai = 0; ai < 2; ++ai)
#pragma unroll
            for (int m = 0; m < 4; ++m) { const int row = row0 + ai * HALF + m * 16; const float r = ROW_RSTD(ss, rstab, pm0, u, rl0 + ai * HALF + m * 16, row, fq); bf16_t* rowp = base + (size_t)row * DM + col0; float s1 = 0.f, s2 = 0.f;
#pragma unroll
                for (int bj = 0; bj < 2; ++bj) { f32x4 v0 = acc[ai][bj][m][0] * r, v1 = acc[ai][bj][m][1] * r;
                    if (ACT == 1) {
#pragma unroll
                        for (int j = 0; j < 4; ++j) { v0[j] = silu_f(v0[j]); v1[j] = silu_f(v1[j]); } }
                    if (ACT == 2 || ACT == 3) { const f32x2 a = gelu_pk((f32x2){v0[0], v0[1]}), b = gelu_pk((f32x2){v0[2], v0[3]}), c = gelu_pk((f32x2){v1[0], v1[1]}), d = gelu_pk((f32x2){v1[2], v1[3]});
                        v0 = (f32x4){a.x, a.y, b.x, b.y}; v1 = (f32x4){c.x, c.y, d.x, d.y}; }
                    if (ACT == 4) {
#pragma unroll
                        for (int j = 0; j < 4; ++j) { v0[j] = sigm_f(v0[j]); v1[j] = sigm_f(v1[j]); } }
                    if (ACT == 3) { s1 += ((v0[0] + v0[1]) + (v0[2] + v0[3])) + ((v1[0] + v1[1]) + (v1[2] + v1[3]));
                        s2 += ((v0[0] * v0[0] + v0[1] * v0[1]) + (v0[2] * v0[2] + v0[3] * v0[3])) + ((v1[0] * v1[0] + v1[1] * v1[1]) + (v1[2] * v1[2] + v1[3] * v1[3])); }
                    *(u32x4*)(rowp + bj * HALF) = pack8(v0, v1); }
                if (ACT == 3) { const int ln = (row0 & 15) | (fq << 4); s1 += shx(s1, 16, ln); s1 += shx(s1, 32, ln); s2 += shx(s2, 16, ln); s2 += shx(s2, 32, ln);
                    if (fq == 0) *(f32x2*)(ls + ((size_t)row * 32 + slot0) * 2) = (f32x2){s1, s2}; } }
    }
    __device__ __forceinline__ void operator()(const f32x4 (&acc)[2][2][4][2], const Unit& u, int wr, int wc, int fr, int fq) const {
        const int rl0 = wr * 64 + fr, row0 = u.pm * BM + rl0, pn = u.pn;
        if (pn < 8) {
            bf16_t* base = (pn < 4) ? q : k; const int col0 = (pn & 3) * BM + wc * 32 + 8 * fq;
#pragma unroll
            for (int ai = 0; ai < 2; ++ai) { f32x4 tt[4][2];
#pragma unroll
                for (int m = 0; m < 4; ++m) { const int pos = (row0 + ai * HALF + m * 16) & 8191; const f32x4* tp = (const f32x4*)(rope + ((size_t)pos * 64 + 16 * wc + 4 * fq) * 2); tt[m][0] = tp[0]; tt[m][1] = tp[1]; }
#pragma unroll
                for (int m = 0; m < 4; ++m) { const int row = row0 + ai * HALF + m * 16; const float r = ROW_RSTD(ss, rstab, pm0, u, rl0 + ai * HALF + m * 16, row, fq);
                    const f32x4 t0 = tt[m][0], t1 = tt[m][1];
                    bf16_t* rowp = base + (size_t)row * 1024 + col0;
#pragma unroll
                    for (int bj = 0; bj < 2; ++bj) { const f32x4 v0 = acc[ai][bj][m][0] * r, v1 = acc[ai][bj][m][1] * r; f32x4 y0, y1;
                        y0[0] = v0[0] * t0[0] - v0[1] * t0[1]; y0[1] = v0[1] * t0[0] + v0[0] * t0[1]; y0[2] = v0[2] * t0[2] - v0[3] * t0[3]; y0[3] = v0[3] * t0[2] + v0[2] * t0[3];
                        y1[0] = v1[0] * t1[0] - v1[1] * t1[1]; y1[1] = v1[1] * t1[0] + v1[0] * t1[1]; y1[2] = v1[2] * t1[2] - v1[3] * t1[3]; y1[3] = v1[3] * t1[2] + v1[2] * t1[3];
                        *(u32x4*)(rowp + bj * HALF) = pack8(y0, y1); } }
                asm volatile("" ::: "memory"); }
        } else {
            const int s = (pn - 8) >> 3, tile = (pn - 8) & 7; bf16_t* base = o2048 + (size_t)s * ((size_t)MROWS * DM); const int col0 = tile * BM + wc * 32 + 8 * fq, slot0 = tile * 4 + wc;
            if (s == 0) emit<0>(acc, u, base, row0, rl0, col0, slot0, fq);
            else if (s == 1) emit<1>(acc, u, base, row0, rl0, col0, slot0, fq);
            else if (s == 2) emit<2>(acc, u, base, row0, rl0, col0, slot0, fq);
            else if (s == 3) emit<3>(acc, u, base, row0, rl0, col0, slot0, fq);
            else emit<4>(acc, u, base, row0, rl0, col0, slot0, fq);
        }
    }
};

struct EpiMerge {
    static constexpr bool PERM = true, AFTER_DRAIN = false, CARRY = true;
    const bf16_t* ga; const bf16_t* gb; bf16_t* mg;
    __device__ __forceinline__ bool carry(f32x4 (&acc)[2][2][4][2], const Unit& u, int wr, int wc, int fr, int fq) const {
        if (u.pn >= 8) return false;
        const int row0 = u.pm * BM + wr * 64 + fr, col0 = u.pn * BM + wc * 32 + 8 * fq;
        u32x4 a[2][2][2], b[2][2][2];
#define EM_LOAD(q) do { _Pragma("unroll") for (int mm = 0; mm < 2; ++mm) _Pragma("unroll") for (int bj = 0; bj < 2; ++bj) { \
            const size_t off = (size_t)(row0 + ((q) >> 1) * HALF + (2 * ((q) & 1) + mm) * 16) * DM + col0 + bj * HALF; a[(q) & 1][mm][bj] = *(const u32x4*)(ga + off); b[(q) & 1][mm][bj] = *(const u32x4*)(gb + off); } } while (0)
        EM_LOAD(0);
#pragma unroll
        for (int q = 0; q < 4; ++q) { const int ai = q >> 1, mp = q & 1;
            if (q < 3) EM_LOAD(q + 1);
            __builtin_amdgcn_sched_barrier(0);
#pragma unroll
            for (int mm = 0; mm < 2; ++mm)
#pragma unroll
                for (int bj = 0; bj < 2; ++bj) { const int m = 2 * mp + mm; const u32x4 x = a[q & 1][mm][bj], y = b[q & 1][mm][bj]; f32x4& v0 = acc[ai][bj][m][0]; f32x4& v1 = acc[ai][bj][m][1];
                    v0[0] *= bf_lo(x.x) * __builtin_amdgcn_rcpf(fmaxf(bf_lo(y.x), 1e-20f)); v0[1] *= bf_hi(x.x) * __builtin_amdgcn_rcpf(fmaxf(bf_hi(y.x), 1e-20f));
                    v0[2] *= bf_lo(x.y) * __builtin_amdgcn_rcpf(fmaxf(bf_lo(y.y), 1e-20f)); v0[3] *= bf_hi(x.y) * __builtin_amdgcn_rcpf(fmaxf(bf_hi(y.y), 1e-20f));
                    v1[0] *= bf_lo(x.z) * __builtin_amdgcn_rcpf(fmaxf(bf_lo(y.z), 1e-20f)); v1[1] *= bf_hi(x.z) * __builtin_amdgcn_rcpf(fmaxf(bf_hi(y.z), 1e-20f));
                    v1[2] *= bf_lo(x.w) * __builtin_amdgcn_rcpf(fmaxf(bf_lo(y.w), 1e-20f)); v1[3] *= bf_hi(x.w) * __builtin_amdgcn_rcpf(fmaxf(bf_hi(y.w), 1e-20f)); }
            __builtin_amdgcn_sched_barrier(0); }
#undef EM_LOAD
        return true;
    }
    __device__ __forceinline__ void operator()(const f32x4 (&acc)[2][2][4][2], const Unit& u, int wr, int wc, int fr, int fq) const {
        const int pm = u.pm & 63, pn = u.pn & 7;
        typedef __attribute__((address_space(1))) unsigned char gchar;
        const size_t tile = ((size_t)(pm * BM + wr * 64) * DM + (size_t)(pn * BM + wc * 32)) * 2;
        const gchar* gbase = (const gchar*)gb + tile; gchar* mbase = (gchar*)mg + tile;
        const unsigned voff = (unsigned)((fr * DM + 8 * fq) * 2);
        u32x4 g8[2][4][2];
#pragma unroll
        for (int ai = 0; ai < 2; ++ai)
#pragma unroll
            for (int m = 0; m < 4; ++m)
#pragma unroll
                for (int bj = 0; bj < 2; ++bj) g8[ai][m][bj] = *(const __attribute__((address_space(1))) u32x4*)(gbase + (size_t)(((ai * HALF + m * 16) * DM + bj * HALF) * 2) + voff);
        __builtin_amdgcn_sched_barrier(0);
#pragma unroll
        for (int ai = 0; ai < 2; ++ai) {
#pragma unroll
            for (int m = 0; m < 4; ++m) {
#pragma unroll
                for (int bj = 0; bj < 2; ++bj) { const u32x4 g = g8[ai][m][bj]; f32x4 v0 = acc[ai][bj][m][0], v1 = acc[ai][bj][m][1];
                    v0[0] *= fmaxf(bf_lo(g.x), 1e-20f); v0[1] *= fmaxf(bf_hi(g.x), 1e-20f); v0[2] *= fmaxf(bf_lo(g.y), 1e-20f); v0[3] *= fmaxf(bf_hi(g.y), 1e-20f);
                    v1[0] *= fmaxf(bf_lo(g.z), 1e-20f); v1[1] *= fmaxf(bf_hi(g.z), 1e-20f); v1[2] *= fmaxf(bf_lo(g.w), 1e-20f); v1[3] *= fmaxf(bf_hi(g.w), 1e-20f);
                    *(__attribute__((address_space(1))) u32x4*)(mbase + (size_t)(((ai * HALF + m * 16) * DM + bj * HALF) * 2) + voff) = pack8(v0, v1); } }
            asm volatile("" ::: "memory"); }
    }
};
struct RevOrder {
    StaticOrder base;
    __device__ __forceinline__ bool next(int i, Unit& u) const { if (!base.next(i, u)) return false; u.pn = base.nN - 1 - u.pn; return true; }
    __device__ __forceinline__ void a_ready(const Unit&) const {}
    __device__ __forceinline__ void done(const Unit&) const {}
};
struct PairOrder {
    StaticOrder base;
    __device__ __forceinline__ bool next(int i, Unit& u) const { if (!base.next(i >> 1, u)) return false; if (i & 1) { u.pm += 64; u.pn += 8; } return true; }
    __device__ __forceinline__ void a_ready(const Unit&) const {}
    __device__ __forceinline__ void done(const Unit&) const {}
};

struct EpiResid {
    static constexpr bool PERM = true, AFTER_DRAIN = false, CARRY = false;
    bf16_t* xb; float* ssout; float scale;
    __device__ __forceinline__ void operator()(const f32x4 (&acc)[2][2][4][2], const Unit& u, int wr, int wc, int fr, int fq) const {
        const int row0 = u.pm * BM + wr * 64 + fr;
        typedef __attribute__((address_space(1))) unsigned char gchar;
        gchar* base = (gchar*)xb + ((size_t)(u.pm * BM + wr * 64) * DM + (size_t)(u.pn * BM + wc * 32)) * 2;
        const unsigned voff = (unsigned)((fr * DM + 8 * fq) * 2);
        u32x4 xo[2][4][2];
#pragma unroll
        for (int ai = 0; ai < 2; ++ai)
#pragma unroll
            for (int m = 0; m < 4; ++m)
#pragma unroll
                for (int bj = 0; bj < 2; ++bj) xo[ai][m][bj] = *(const __attribute__((address_space(1))) u32x4*)(base + (size_t)(((ai * HALF + m * 16) * DM + bj * HALF) * 2) + voff);
        __builtin_amdgcn_sched_barrier(0);
#pragma unroll
        for (int ai = 0; ai < 2; ++ai) {
#pragma unroll
            for (int m = 0; m < 4; ++m) { const int row = row0 + ai * HALF + m * 16; float s2 = 0.f;
#pragma unroll
                for (int bj = 0; bj < 2; ++bj) { const u32x4 g = xo[ai][m][bj]; f32x4 a0 = acc[ai][bj][m][0] * scale, a1 = acc[ai][bj][m][1] * scale;
                    a0[0] += bf_lo(g.x); a0[1] += bf_hi(g.x); a0[2] += bf_lo(g.y); a0[3] += bf_hi(g.y); a1[0] += bf_lo(g.z); a1[1] += bf_hi(g.z); a1[2] += bf_lo(g.w); a1[3] += bf_hi(g.w);
                    s2 += ((a0[0] * a0[0] + a0[1] * a0[1]) + (a0[2] * a0[2] + a0[3] * a0[3])) + ((a1[0] * a1[0] + a1[1] * a1[1]) + (a1[2] * a1[2] + a1[3] * a1[3]));
                    *(__attribute__((address_space(1))) u32x4*)(base + (size_t)(((ai * HALF + m * 16) * DM + bj * HALF) * 2) + voff) = pack8(a0, a1); }
                { const int ln = fr | (fq << 4); s2 += shx(s2, 16, ln); s2 += shx(s2, 32, ln); }
                if (fq == 0) ssout[(size_t)row * 32 + u.pn * 4 + wc] = s2; }
            asm volatile("" ::: "memory"); }
    }
};

struct EpiSwiglu {
    static constexpr bool PERM = true, AFTER_DRAIN = false, CARRY = false;
    const float* ss; bf16_t* h; const PG8_LAS float* rstab; int pm0;
    __device__ __forceinline__ void operator()(const f32x4 (&acc)[2][2][4][2], const Unit& u, int wr, int wc, int fr, int fq) const {
        const int rl0 = wr * 64 + fr, row0 = u.pm * BM + rl0, col0 = u.pn * HALF + wc * 32 + 8 * fq;
#pragma unroll
        for (int ai = 0; ai < 2; ++ai)
#pragma unroll
            for (int m = 0; m < 4; ++m) { const float r = ROW_RSTD(ss, rstab, pm0, u, rl0 + ai * HALF + m * 16, row0 + ai * HALF + m * 16, fq); f32x4 a0 = acc[ai][0][m][0] * r, a1 = acc[ai][0][m][1] * r; const f32x4 c0 = acc[ai][1][m][0] * r, c1 = acc[ai][1][m][1] * r;
#pragma unroll
                for (int j = 0; j < 4; ++j) { a0[j] = silu_f(a0[j]) * c0[j]; a1[j] = silu_f(a1[j]) * c1[j]; }
                *(u32x4*)(h + (size_t)(row0 + ai * HALF + m * 16) * 5632 + col0) = pack8(a0, a1); }
    }
};

struct EpiSwiglu8 {
    static constexpr bool PERM = true, AFTER_DRAIN = false, CARRY = false;
    const float* ss; unsigned char* h8; const PG8_LAS float* rstab; int pm0;
    __device__ __forceinline__ void operator()(const f32x4 (&acc)[2][2][4][2], const Unit& u, int wr, int wc, int fr, int fq) const {
        const int rl0 = wr * 64 + fr, row0 = u.pm * BM + rl0, col0 = u.pn * HALF + wc * 32 + 8 * fq;
#pragma unroll
        for (int ai = 0; ai < 2; ++ai)
#pragma unroll
            for (int m = 0; m < 4; ++m) { const float r = ROW_RSTD(ss, rstab, pm0, u, rl0 + ai * HALF + m * 16, row0 + ai * HALF + m * 16, fq); f32x4 a0 = acc[ai][0][m][0] * r, a1 = acc[ai][0][m][1] * r; const f32x4 c0 = acc[ai][1][m][0] * (r * 8.0f), c1 = acc[ai][1][m][1] * (r * 8.0f);
#pragma unroll
                for (int j = 0; j < 4; ++j) { a0[j] = silu_f(a0[j]) * c0[j]; a1[j] = silu_f(a1[j]) * c1[j]; }
                int w0 = __builtin_amdgcn_cvt_pk_fp8_f32(a0[0], a0[1], 0, false); w0 = __builtin_amdgcn_cvt_pk_fp8_f32(a0[2], a0[3], w0, true);
                int w1 = __builtin_amdgcn_cvt_pk_fp8_f32(a1[0], a1[1], 0, false); w1 = __builtin_amdgcn_cvt_pk_fp8_f32(a1[2], a1[3], w1, true);
                typedef unsigned u32x2_ __attribute__((ext_vector_type(2))); u32x2_ o; o.x = (unsigned)w0; o.y = (unsigned)w1;
                *(u32x2_*)(h8 + (size_t)(row0 + ai * HALF + m * 16) * 5632 + col0) = o; }
    }
};

struct EpiNull {
    static constexpr bool PERM = true, AFTER_DRAIN = false, CARRY = false;
    float* sink;
    __device__ __forceinline__ void operator()(const f32x4 (&acc)[2][2][4][2], const Unit& u, int wr, int wc, int fr, int fq) const {
        float s = 0.f;
#pragma unroll
        for (int ai = 0; ai < 2; ++ai)
#pragma unroll
            for (int bj = 0; bj < 2; ++bj)
#pragma unroll
                for (int m = 0; m < 4; ++m)
#pragma unroll
                    for (int n = 0; n < 2; ++n) s += (acc[ai][bj][m][n][0] + acc[ai][bj][m][n][1]) + (acc[ai][bj][m][n][2] + acc[ai][bj][m][n][3]);
        if (s == 123456.789f) sink[u.pm * 64 + u.pn] = s;
    }
};

struct SameTileOrder {
    int nunits;
    __device__ __forceinline__ bool next(int i, Unit& u) const { if (i >= nunits) return false; u.pm = 0; u.pn = 0; return true; }
    __device__ __forceinline__ void a_ready(const Unit&) const {}
    __device__ __forceinline__ void done(const Unit&) const {}
};
typedef int pg8_v4i __attribute__((ext_vector_type(4))); typedef int pg8_v8i __attribute__((ext_vector_type(8)));
__device__ __forceinline__ pg8_v8i pg8_cat8(const bf16x8& lo, const bf16x8& hi) { return __builtin_shufflevector(__builtin_bit_cast(pg8_v4i, lo), __builtin_bit_cast(pg8_v4i, hi), 0, 1, 2, 3, 4, 5, 6, 7); }
template <class Epi, class Sched, bool ALIGN_EPI = false, bool SP2 = false, bool MM32 = false, bool FP8 = false>
__device__ __forceinline__ void gemm_phase(PG8_LAS unsigned char* lds, const Gemm g, const Sched& S, const Epi& E, const int tid_in) {
    const int tid = tid_in, wid = __builtin_amdgcn_readfirstlane(tid >> 6), lane = tid & 63, wr = wid >> 2, wc = wid & 3, fr = lane & 15, fq = lane >> 4;
    const int K = g.K, nt = K / BK;
    unsigned voffA[2], voffB[2];
#pragma unroll
    for (int i = 0; i < 2; ++i) { int R, C; stage_rc(tid * 16 + i * 8192, R, C); const int Rb = Epi::PERM ? ((R & ~31) + perm32(R & 31)) : R;
        voffA[i] = (unsigned)(R * K + C) * 2u; voffB[i] = (unsigned)(Rb * K + C) * 2u; }
    const size_t kstep = (size_t)(BK * 2);
    const size_t hstep = (size_t)HALF * K * 2;
    const size_t tstep = 2 * hstep;
    const unsigned ldsw = (unsigned)wid * 1024u; const unsigned ldsu = (unsigned)(unsigned long)lds + ldsw;
    const int aoff = lds_byte(wr * 64 + fr, fq * 8), boff = lds_byte(wc * 32 + fr, fq * 8);
#ifndef PG8_DMA_AUX
#define PG8_DMA_AUX 0
#endif
#define PG8_SA(b, h) (((b) * 2 + (h)) * HTB)
#define PG8_SB(b, h) ((4 + (b) * 2 + (h)) * HTB)
#define PG8_STAGE(bufoff, gbase, voff) do { _Pragma("unroll") for (int _i = 0; _i < 2; ++_i) \
        asm volatile("s_mov_b32 m0, %0\n\ts_nop 0\n\tglobal_load_lds_dwordx4 %1, %2" :: "s"(ldsu + (unsigned)((bufoff) + _i * 8192)), "v"((voff)[_i]), "s"((unsigned long long)(gbase)) : "m0", "memory"); } while (0)
#define PG8_LDA(dst, b, h) do { _Pragma("unroll") for (int m = 0; m < 4; ++m) _Pragma("unroll") for (int k = 0; k < 2; ++k) dst[m][k] = *(const PG8_LAS bf16x8*)(lds + PG8_SA(b, h) + aoff + m * 2048 + k * 1024); } while (0)
#define PG8_LDB(dst, b, h) do { _Pragma("unroll") for (int n = 0; n < 2; ++n) _Pragma("unroll") for (int k = 0; k < 2; ++k) dst[n][k] = *(const PG8_LAS bf16x8*)(lds + PG8_SB(b, h) + boff + n * 2048 + k * 1024); } while (0)
#define PG8_MMA(ai, bj, At, Bt) do { __builtin_amdgcn_s_setprio(1); if constexpr (MM32) { _Pragma("unroll") for (int j = 0; j < 4; ++j) _Pragma("unroll") for (int p = 0; p < 2; ++p) \
        acc16[ai][bj][p] = __builtin_amdgcn_mfma_f32_32x32x16_bf16(Bt[p][j & 1], At[j][j >> 1], acc16[ai][bj][p], 0, 0, 0); } else if constexpr (FP8) { \
        _Pragma("unroll") for (int m = 0; m < 4; ++m) _Pragma("unroll") for (int n = 0; n < 2; ++n) \
        acc[ai][bj][m][n] = __builtin_amdgcn_mfma_scale_f32_16x16x128_f8f6f4(pg8_cat8(Bt[n][0], Bt[n][1]), pg8_cat8(At[m][0], At[m][1]), acc[ai][bj][m][n], 0, 0, 0, 0x7f7f7f7f, 0, 0x7f7f7f7f); } else { \
        _Pragma("unroll") for (int m = 0; m < 4; ++m) _Pragma("unroll") for (int n = 0; n < 2; ++n) _Pragma("unroll") for (int k = 0; k < 2; ++k) \
        acc[ai][bj][m][n] = __builtin_amdgcn_mfma_f32_16x16x32_bf16(Bt[n][k], At[m][k], acc[ai][bj][m][n], 0, 0, 0); } __builtin_amdgcn_s_setprio(0); } while (0)
#define PG8_WAIT_V(n) asm volatile("s_waitcnt vmcnt(" #n ")" ::: "memory")
#define PG8_WAIT_L(n) asm volatile("s_waitcnt lgkmcnt(" #n ")" ::: "memory")
#define PG8_BAR __builtin_amdgcn_s_barrier()
#define PG8_SCHED __builtin_amdgcn_sched_barrier(0)
    Unit cur, nxt; int ui = 0;
    if (!S.next(0, cur)) return;
    f32x4 acc[2][2][4][2];
#pragma unroll
    for (int a = 0; a < 2; ++a)
#pragma unroll
        for (int b = 0; b < 2; ++b)
#pragma unroll
            for (int m = 0; m < 4; ++m)
#pragma unroll
                for (int n = 0; n < 2; ++n) acc[a][b][m][n] = (f32x4){0.f, 0.f, 0.f, 0.f};
    f32x16 acc16[2][2][2];
    if constexpr (MM32) {
#pragma unroll
        for (int a = 0; a < 2; ++a)
#pragma unroll
            for (int b = 0; b < 2; ++b)
#pragma unroll
                for (int p = 0; p < 2; ++p)
#pragma unroll
                    for (int e = 0; e < 16; ++e) acc16[a][b][p][e] = 0.f;
    }
    bf16x8 At[4][2], B0[2][2], B1[2][2];
    const char* cA = (const char*)g.A + (size_t)cur.pm * tstep; const char* cB = (const char*)g.Bt + (size_t)cur.pn * tstep;
    S.a_ready(cur);
    if constexpr (SP2) {
        PG8_STAGE(PG8_SB(0, 0), cB, voffB); PG8_STAGE(PG8_SB(0, 1), cB + hstep, voffB); PG8_STAGE(PG8_SA(0, 0), cA, voffA); PG8_STAGE(PG8_SA(0, 1), cA + hstep, voffA);
        if (wr == 1) PG8_BAR;
        PG8_WAIT_V(2); PG8_BAR;
        PG8_STAGE(PG8_SB(1, 0), cB + kstep, voffB); PG8_STAGE(PG8_SA(1, 0), cA + kstep, voffA); PG8_STAGE(PG8_SB(1, 1), cB + hstep + kstep, voffB);
        PG8_WAIT_V(6); PG8_BAR;
    } else {
        PG8_STAGE(PG8_SB(0, 0), cB, voffB); PG8_STAGE(PG8_SA(0, 0), cA, voffA); PG8_STAGE(PG8_SB(0, 1), cB + hstep, voffB); PG8_STAGE(PG8_SA(0, 1), cA + hstep, voffA);
        if (wr == 1) PG8_BAR;
        PG8_WAIT_V(4); PG8_BAR;
        PG8_STAGE(PG8_SB(1, 0), cB + kstep, voffB); PG8_STAGE(PG8_SA(1, 0), cA + kstep, voffA); PG8_STAGE(PG8_SB(1, 1), cB + hstep + kstep, voffB);
        PG8_WAIT_V(6); PG8_BAR;
    }
    for (;;) {
        const bool has_next = S.next(ui + 1, nxt);
        const char* nA = has_next ? (const char*)g.A + (size_t)nxt.pm * tstep : cA; const char* nB = has_next ? (const char*)g.Bt + (size_t)nxt.pn * tstep : cB;
        for (int t = 0; t < nt; t += 2) {
            const bool last = (t == nt - 2);
            const char* a1 = cA + (size_t)(t + 1) * kstep;
            const char* a2 = last ? nA : cA + (size_t)(t + 2) * kstep; const char* b2 = last ? nB : cB + (size_t)(t + 2) * kstep;
            const char* a3 = a2 + kstep; const char* b3 = b2 + kstep;
            if (last && has_next) S.a_ready(nxt);
            if constexpr (SP2) {
            PG8_LDB(B0, 0, 0); PG8_LDB(B1, 0, 1); PG8_SCHED; PG8_LDA(At, 0, 0); PG8_STAGE(PG8_SA(1, 1), a1 + hstep, voffA);
            PG8_WAIT_V(8); PG8_WAIT_L(0); PG8_BAR; PG8_MMA(0, 0, At, B0); PG8_MMA(0, 1, At, B1); PG8_BAR; PG8_SCHED;
            PG8_LDA(At, 0, 1); PG8_STAGE(PG8_SB(0, 0), b2, voffB); PG8_STAGE(PG8_SB(0, 1), b2 + hstep, voffB); PG8_STAGE(PG8_SA(0, 0), a2, voffA);
            PG8_WAIT_V(8); PG8_WAIT_L(0); PG8_BAR; PG8_MMA(1, 0, At, B0); PG8_MMA(1, 1, At, B1); PG8_BAR; PG8_SCHED;
            PG8_LDB(B0, 1, 0); PG8_LDB(B1, 1, 1); PG8_SCHED; PG8_LDA(At, 1, 0); PG8_STAGE(PG8_SA(0, 1), a2 + hstep, voffA);
            PG8_WAIT_V(8); PG8_WAIT_L(0); PG8_BAR; PG8_MMA(0, 0, At, B0); PG8_MMA(0, 1, At, B1); PG8_BAR; PG8_SCHED;
            PG8_LDA(At, 1, 1); PG8_STAGE(PG8_SB(1, 0), b3, voffB); PG8_STAGE(PG8_SB(1, 1), b3 + hstep, voffB); PG8_STAGE(PG8_SA(1, 0), a3, voffA);
            PG8_WAIT_V(8); PG8_WAIT_L(0); PG8_BAR; PG8_MMA(1, 0, At, B0); PG8_MMA(1, 1, At, B1); PG8_BAR; PG8_SCHED;
            } else {
            PG8_LDB(B0, 0, 0); PG8_SCHED; PG8_LDA(At, 0, 0); PG8_STAGE(PG8_SA(1, 1), a1 + hstep, voffA);
            PG8_WAIT_L(8); PG8_BAR; PG8_WAIT_L(0); PG8_MMA(0, 0, At, B0); PG8_BAR; PG8_SCHED;
            PG8_LDB(B1, 0, 1); PG8_STAGE(PG8_SB(0, 0), b2, voffB);
            PG8_BAR; PG8_WAIT_L(0); PG8_MMA(0, 1, At, B1); PG8_BAR;
            PG8_LDA(At, 0, 1); PG8_STAGE(PG8_SA(0, 0), a2, voffA);
            PG8_BAR; PG8_WAIT_L(0); PG8_MMA(1, 0, At, B0); PG8_BAR; PG8_SCHED;
            PG8_STAGE(PG8_SB(0, 1), b2 + hstep, voffB);
            PG8_WAIT_V(6); PG8_BAR; PG8_MMA(1, 1, At, B1); PG8_BAR;
            PG8_LDB(B0, 1, 0); PG8_SCHED; PG8_LDA(At, 1, 0); PG8_STAGE(PG8_SA(0, 1), a2 + hstep, voffA);
            PG8_WAIT_L(8); PG8_BAR; PG8_WAIT_L(0); PG8_MMA(0, 0, At, B0); PG8_BAR; PG8_SCHED;
            PG8_LDB(B1, 1, 1); PG8_STAGE(PG8_SB(1, 0), b3, voffB);
            PG8_BAR; PG8_WAIT_L(0); PG8_MMA(0, 1, At, B1); PG8_BAR;
            PG8_LDA(At, 1, 1); PG8_STAGE(PG8_SA(1, 0), a3, voffA);
            PG8_BAR; PG8_WAIT_L(0); PG8_MMA(1, 0, At, B0); PG8_BAR; PG8_SCHED;
            PG8_STAGE(PG8_SB(1, 1), b3 + hstep, voffB);
            PG8_WAIT_V(6); PG8_BAR; PG8_MMA(1, 1, At, B1); PG8_BAR;
            }
        }
        if constexpr (ALIGN_EPI) { if (wr == 0) PG8_BAR; }
        if constexpr (MM32) {
#pragma unroll
            for (int a = 0; a < 2; ++a)
#pragma unroll
                for (int b = 0; b < 2; ++b)
#pragma unroll
                    for (int m = 0; m < 4; ++m)
#pragma unroll
                        for (int n = 0; n < 2; ++n)
#pragma unroll
                            for (int e = 0; e < 4; ++e) acc[a][b][m][n][e] = acc16[a][b][m >> 1][(m & 1) * 8 + n * 4 + e];
        }
        bool keep = false;
        int tl_ = tid; asm volatile("" : "+v"(tl_)); const int fr_e = tl_ & 15, fq_e = (tl_ >> 4) & 3;
        if constexpr (!Epi::AFTER_DRAIN) { if constexpr (Epi::CARRY) keep = E.carry(acc, cur, wr, wc, fr_e, fq_e); if (!keep) E(acc, cur, wr, wc, fr_e, fq_e); S.done(cur); }
        if (!has_next) break;
        if (!keep)
#pragma unroll
        for (int a = 0; a < 2; ++a)
#pragma unroll
            for (int b = 0; b < 2; ++b)
#pragma unroll
                for (int m = 0; m < 4; ++m)
#pragma unroll
                    for (int n = 0; n < 2; ++n) acc[a][b][m][n] = (f32x4){0.f, 0.f, 0.f, 0.f};
        cur = nxt; cA = nA; cB = nB; ++ui;
        if constexpr (ALIGN_EPI) { if (wr == 1) PG8_BAR; }
    }
    PG8_WAIT_V(0);
    if constexpr (!ALIGN_EPI) { if (wr == 0) PG8_BAR; }
    PG8_BAR;
    if constexpr (Epi::AFTER_DRAIN) { E.fused(acc, cur, wr, wc, fr, fq, lds, wid, lane); S.done(cur); }
#undef PG8_SA
#undef PG8_SB
#undef PG8_STAGE
#undef PG8_LDA
#undef PG8_LDB
#undef PG8_MMA
#undef PG8_WAIT_V
#undef PG8_WAIT_L
#undef PG8_BAR
#undef PG8_SCHED
}
}

#ifndef MK_PER_PHASE
#define MK_PER_PHASE 0
#endif
constexpr int NWAVES = 8;
constexpr int NWG = 256;
constexpr int BATCH = 2, T = 8192, D = 2048, M = BATCH * T, DEPTH = 4;
constexpr int NIN = 14336, DFF = 5632, NFF = 2 * DFF;
constexpr float EPS = 1e-6f;
static_assert(M == pg8::MROWS && D == pg8::DM, "shapes");

constexpr size_t MiB = 1u << 20;
constexpr size_t WS_CTL = 0, CTL_ZERO_BYTES = 1 * MiB;
constexpr size_t WS_ROPE = 1 * MiB;
constexpr size_t WS_SS = 5 * MiB, WS_SS2 = 7 * MiB;
constexpr size_t WS_LS = 9 * MiB;
constexpr size_t WS_W = 16 * MiB, W_LAYER = 146 * MiB;
constexpr size_t W_IN = 0, W_R = 56 * MiB, W_S = 64 * MiB, W_O = 72 * MiB, W_F1 = 80 * MiB, W_F2 = 124 * MiB;
static_assert((size_t)NIN * D * 2 == 56 * MiB && (size_t)NFF * D * 2 == 44 * MiB && (size_t)D * DFF * 2 == 22 * MiB, "weight map");
constexpr size_t WS_X = 600 * MiB;
constexpr size_t WS_XB = 728 * MiB;
constexpr size_t WS_Q = 792 * MiB, WS_K = 824 * MiB;
constexpr size_t WS_O2048 = 856 * MiB;
constexpr size_t WS_V = WS_O2048, WS_SG = WS_V + 64 * MiB, WS_ZU = WS_SG + 64 * MiB, WS_ZV = WS_ZU + 64 * MiB, WS_GA = WS_ZV + 64 * MiB, WS_GB = WS_GA + 64 * MiB;
constexpr size_t WS_RA = 1240 * MiB, WS_SB = 1304 * MiB;
constexpr size_t WS_P = 1368 * MiB, WS_MG = 1432 * MiB;
constexpr size_t WS_SLOC = 1496 * MiB;
constexpr size_t WS_END = 1528 * MiB;
constexpr size_t WS_H = WS_Q;
static_assert(WS_W + DEPTH * W_LAYER <= WS_X && WS_GB + 64 * MiB == WS_RA && WS_SB == WS_RA + 64 * MiB && WS_H + (size_t)M * DFF * 2 <= WS_ZU, "d_ws map");
constexpr int CW_TMO = 0, CW_CODE = 1, CW_BAR = 4096;

constexpr int RING_OFF = 0, RING_BYTES = 131072;
constexpr int LDSCTL_OFF = RING_BYTES, MISC_OFF = LDSCTL_OFF + 320, RSTAB_OFF = LDSCTL_OFF + 1024;
constexpr int LDS_BYTES = 147456;
constexpr int R_Q = 0, R_K = 17408, R_KS = 34816, R_V = 52224, R_P = 86016, R_RED = 95232, R_END = 99328;
constexpr int PQ = 272, PV = 528, PP = 144;
constexpr int R1_KS = 0, R1_V = 17408, R1_BUF = 51200;
static_assert(2 * R1_BUF <= RING_BYTES, "LDS map");
constexpr int S_W = 0, S_VN = 34816, S_ST = 102400, S_END = 104448;
static_assert(R_END <= RING_BYTES && S_END <= RING_BYTES, "LDS map");

#define GAS __attribute__((address_space(1)))
#define LAS __attribute__((address_space(3)))
typedef unsigned short bf16;
typedef unsigned v4u __attribute__((ext_vector_type(4)));
typedef unsigned v2u __attribute__((ext_vector_type(2)));
typedef float f32x4 __attribute__((ext_vector_type(4)));
typedef float f32x2 __attribute__((ext_vector_type(2)));
typedef short bf16x8 __attribute__((ext_vector_type(8)));
typedef short s16x4 __attribute__((ext_vector_type(4)));
typedef GAS unsigned gu32;
#define RLX_AGENT __ATOMIC_RELAXED, __HIP_MEMORY_SCOPE_AGENT
#define LDS_WAIT() asm volatile("s_waitcnt lgkmcnt(0)" ::: "memory")
#define VM_WAIT() asm volatile("s_waitcnt vmcnt(0)" ::: "memory")
__device__ __forceinline__ unsigned f2bf(float f) { unsigned u = __builtin_bit_cast(unsigned, f); return (u + 0x7fffu + ((u >> 16) & 1u)) >> 16; }
__device__ __forceinline__ unsigned pk2(float lo, float hi) { typedef float f2_ __attribute__((ext_vector_type(2))); typedef __bf16 b2_ __attribute__((ext_vector_type(2))); const f2_ v = {lo, hi}; return __builtin_bit_cast(unsigned, __builtin_convertvector(v, b2_)); }
__device__ __forceinline__ float blo(unsigned w) { return __uint_as_float(w << 16); }
__device__ __forceinline__ float bhi(unsigned w) { return __uint_as_float(w & 0xffff0000u); }
__device__ __forceinline__ float ex2(float x) { return __builtin_amdgcn_exp2f(x); }
__device__ __forceinline__ float l2gamma(int h) {
    const float t0 = (h & 1) ? -0.02272007650008353f : -0.04580368961312479f, t1 = (h & 1) ? -0.005646563141142063f : -0.011315313227834146f;
    const float t2 = (h & 1) ? -0.0014095702546713536f : -0.0028205190623786626f, t3 = (h & 1) ? -0.0003522634716290214f : -0.0007046129765893727f;
    const float a = (h & 2) ? t1 : t0, b = (h & 2) ? t3 : t2; return (h & 4) ? b : a; }
#define MFMA16(a, b, c) __builtin_amdgcn_mfma_f32_16x16x32_bf16((a), (b), (c), 0, 0, 0)

#define XB_TMO      128
#define XB_XCNT(j)  (256  + 64 * (j))
#define XB_XSUB(j)  (1280 + 64 * (j))
#define XB_XGEN(j)  (2304 + 64 * (j))
#define XB_TOP      3328
#define XB_TOPGEN   3392
#define XCD_BAR_WORDS 3456
#define XB_SPIN_CAP (1u << 18)

__device__ __forceinline__ unsigned xb_ld(unsigned* p)              { return __hip_atomic_load(p, __ATOMIC_RELAXED, __HIP_MEMORY_SCOPE_AGENT); }
__device__ __forceinline__ unsigned xb_add(unsigned* p, unsigned v) { return __hip_atomic_fetch_add(p, v, __ATOMIC_RELAXED, __HIP_MEMORY_SCOPE_AGENT); }
__device__ __forceinline__ unsigned xb_xcc_id() { return (unsigned)__builtin_amdgcn_s_getreg((3 << 11) | 20) & 0xFu; }
#define XB_SPIN(cond, bar) do { unsigned _sp = 0; while (cond) { __builtin_amdgcn_s_sleep(1); \
    if ((++_sp & 255u) == 0u) { if (xb_ld(&(bar)[XB_TMO])) break; if (_sp > XB_SPIN_CAP) { atomicAdd(&(bar)[XB_TMO], 1u); break; } } } } while (0)

struct XcdBarrier {
    unsigned* bar; unsigned x;
    volatile LAS unsigned* st;
};

__device__ __forceinline__ XcdBarrier xcd_barrier_post(unsigned* bar, volatile LAS unsigned* st) {
    XcdBarrier b; b.bar = bar; b.x = xb_xcc_id(); b.st = st;
    if (threadIdx.x == 0) (void)xb_add(&bar[XB_XCNT(b.x)], 1u);
    return b;
}
__device__ __forceinline__ void xcd_barrier_complete(unsigned* bar, unsigned x, unsigned& nloc, unsigned& nx) {
    const unsigned G = gridDim.x * gridDim.y * gridDim.z;
    unsigned sum, cnt, mine, sp = 0u;
    for (;;) {
        sum = 0u; cnt = 0u; mine = 0u;
#pragma unroll
        for (unsigned j = 0; j < 16; ++j) { const unsigned c = xb_ld(&bar[XB_XCNT(j)]); sum += c; cnt += (c > 0u) ? 1u : 0u; mine = (j == x) ? c : mine; }
        if (sum == G) break;
        __builtin_amdgcn_s_sleep(1);
        if ((++sp & 255u) == 0u) { if (xb_ld(&bar[XB_TMO])) break; if (sp > XB_SPIN_CAP) { atomicAdd(&bar[XB_TMO], 1u); break; } }
    }
    nloc = mine > 0u ? mine : 1u; nx = cnt > 0u ? cnt : 1u;
}

__device__ __forceinline__ void xcd_barrier(const XcdBarrier& b) {
    asm volatile("s_waitcnt vmcnt(0)" ::: "memory");
    __syncthreads();
    if (threadIdx.x == 0) {
        unsigned* bar = b.bar;
        __builtin_amdgcn_s_waitcnt(0);
        unsigned nloc = b.st[0], nx = b.st[1];
        if (nloc == 0u) { xcd_barrier_complete(bar, b.x, nloc, nx); b.st[0] = nloc; b.st[1] = nx; }
        const unsigned old = xb_add(&bar[XB_XSUB(b.x)], 1u);
        const unsigned gen = old / nloc;
        if (old + 1u == (gen + 1u) * nloc) {
            __builtin_amdgcn_fence(__ATOMIC_RELEASE, "agent");
            asm volatile("s_waitcnt vmcnt(0)" ::: "memory");
            const unsigned og = xb_add(&bar[XB_TOP], 1u);
            const unsigned tg = og / nx;
            if (og + 1u == (tg + 1u) * nx) xb_add(&bar[XB_TOPGEN], 1u);
            else XB_SPIN(xb_ld(&bar[XB_TOPGEN]) == tg, bar);
            __builtin_amdgcn_fence(__ATOMIC_ACQUIRE, "agent");
            xb_add(&bar[XB_XGEN(b.x)], 1u);
            asm volatile("s_waitcnt vmcnt(0)" ::: "memory");
        } else {
            XB_SPIN(xb_ld(&bar[XB_XGEN(b.x)]) == gen, bar);
            __builtin_amdgcn_fence(__ATOMIC_ACQUIRE, "agent");
            asm volatile("s_waitcnt vmcnt(0)" ::: "memory");
        }
    }
    __syncthreads();
}

struct Frame;
__device__ __forceinline__ bool conv_work_one(Frame& F, int max_layer);
__device__ __forceinline__ void xcd_barrier_idle(const XcdBarrier& b, Frame& F, const int tid_) {
    asm volatile("s_waitcnt vmcnt(0)" ::: "memory");
    __syncthreads();
    if (tid_ == 0) {
        unsigned* bar = b.bar;
        __builtin_amdgcn_s_waitcnt(0);
        unsigned nloc = b.st[0], nx = b.st[1];
        if (nloc == 0u) { xcd_barrier_complete(bar, b.x, nloc, nx); b.st[0] = nloc; b.st[1] = nx; }
        const unsigned old = xb_add(&bar[XB_XSUB(b.x)], 1u);
        const unsigned gen = old / nloc;
        if (old + 1u == (gen + 1u) * nloc) {
            __builtin_amdgcn_fence(__ATOMIC_RELEASE, "agent");
            asm volatile("s_waitcnt vmcnt(0)" ::: "memory");
            const unsigned og = xb_add(&bar[XB_TOP], 1u);
            const unsigned tg = og / nx;
            if (og + 1u == (tg + 1u) * nx) xb_add(&bar[XB_TOPGEN], 1u);
            else XB_SPIN(xb_ld(&bar[XB_TOPGEN]) == tg, bar);
            __builtin_amdgcn_fence(__ATOMIC_ACQUIRE, "agent");
            xb_add(&bar[XB_XGEN(b.x)], 1u);
            asm volatile("s_waitcnt vmcnt(0)" ::: "memory");
            b.st[2] = 0u;
        } else { b.st[2] = 1u; b.st[3] = gen;
#if defined(PRE_WB)
            { const unsigned pos = old - gen * nloc;
              if (pos + 1u == nloc / 2u || pos + 4u == nloc || pos + 2u == nloc) asm volatile("buffer_wbl2 sc1" ::: "memory"); }
#endif
        }
    }
    __syncthreads();
    if (b.st[2] != 0u) {
        unsigned* bar = b.bar; const unsigned gen = b.st[3]; bool more = true;
        for (unsigned it = 0; it < (1u << 20); ++it) {
            if (tid_ == 0) b.st[4] = (xb_ld(&bar[XB_XGEN(b.x)]) != gen || xb_ld(&bar[XB_TMO]) != 0u) ? 1u : 0u;
            __syncthreads();
            const unsigned rel = b.st[4];
            if (rel) break;
            if (more) { const unsigned w_ = conv_work_one(F, DEPTH - 1) ? 1u : 0u; volatile LAS unsigned* wf = b.st + 16;
                if ((tid_ & 63) == 0) wf[tid_ >> 6] = w_;
                __syncthreads();
                more = (wf[0] | wf[1] | wf[2] | wf[3] | wf[4] | wf[5] | wf[6] | wf[7]) != 0u; }
            else { if (tid_ == 0) XB_SPIN(xb_ld(&bar[XB_XGEN(b.x)]) == gen, bar); __syncthreads(); break; }
        }
        if (tid_ == 0) { __builtin_amdgcn_fence(__ATOMIC_ACQUIRE, "agent"); asm volatile("s_waitcnt vmcnt(0)" ::: "memory"); }
    }
    __syncthreads();
}

__device__ __forceinline__ bf16x8 tr_frag(LAS const unsigned char* img, int pitch, int k0, int n0, int lane) {
    const int g = lane >> 4, q = (lane & 15) >> 2, p = lane & 3;
    LAS const unsigned char* a = img + (k0 + 8 * g + q) * pitch + (n0 + 4 * p) * 2;
    const s16x4 lo = __builtin_bit_cast(s16x4, __builtin_amdgcn_ds_read_tr16_b64_v4i16((LAS s16x4*)a));
    const s16x4 hi = __builtin_bit_cast(s16x4, __builtin_amdgcn_ds_read_tr16_b64_v4i16((LAS s16x4*)(a + 4 * pitch)));
    return __builtin_shufflevector(lo, hi, 0, 1, 2, 3, 4, 5, 6, 7);
}
__device__ __forceinline__ bf16x8 pack_f8(const f32x4& a, const f32x4& b) { v4u w; w.x = pg8::cvt_pk_bf16(a[0], a[1]); w.y = pg8::cvt_pk_bf16(a[2], a[3]); w.z = pg8::cvt_pk_bf16(b[0], b[1]); w.w = pg8::cvt_pk_bf16(b[2], b[3]); return __builtin_bit_cast(bf16x8, w); }
__device__ __forceinline__ float wave_sum(float v, int lane) {
#pragma unroll
    for (int o = 1; o < 64; o <<= 1) v += pg8::shx(v, o, lane);
    return v;
}

struct Frame {
    LAS unsigned char* lds;
    int tid, lane, wave;
    const float *x, *norm_mix_w, *w_in, *ret_gn_w, *ret_proj, *sgu_ln_w, *sgu_ln_b, *sgu_w_s, *sgu_b_s, *sgu_proj, *w_out, *norm_ffn_w, *w_ffn_in, *w_ffn_out, *final_norm_w;
    float* out; unsigned char* ws;
};

__device__ __forceinline__ int p0_rowmap(int mode, int c) {
    if (mode == 1) { if (c < 2048) { const int d = c & 127; return (c & ~127) + 2 * (d & 63) + (d >> 6); } return c; }
    if (mode == 2) { const int half = c >= DFF ? 1 : 0, j = c - half * DFF; return 256 * (j >> 7) + 128 * half + (j & 127); }
    return c;
}
__device__ __forceinline__ void p0_transpose_item(const float* W, int Nsrc, int K, bf16* WT, int mode, const float* kscale, float qs, LAS float* scr, int kb, int cb, int lane) {
    const int k0 = 64 * kb, c0 = 64 * cb, c4 = (lane & 15) * 4;
    f32x4 w[16];
#pragma unroll
    for (int i = 0; i < 16; ++i) { const int kk = 4 * i + (lane >> 4); w[i] = *(const GAS f32x4*)(W + (size_t)(k0 + kk) * Nsrc + c0 + c4); }
#pragma unroll
    for (int i = 0; i < 16; ++i) { const int kk = 4 * i + (lane >> 4); const float ks = kscale ? kscale[k0 + kk] : 1.f;
        *(LAS f32x4*)(scr + kk * 64 + (c4 ^ (((kk >> 3) & 7) << 3))) = w[i] * ks; }
    LDS_WAIT(); asm volatile("" ::: "memory");
    const int c = lane & 7;
#pragma unroll
    for (int j = 0; j < 8; ++j) { const int n = (lane >> 3) + 8 * j, row = p0_rowmap(mode, c0 + n); const float cs = (mode == 1 && row < 1024) ? qs : 1.f;
        const LAS float* s = scr + (8 * c) * 64 + (n ^ (c << 3));
        if (mode == 3) {
            int w0 = __builtin_amdgcn_cvt_pk_fp8_f32(s[0 * 64] * 256.0f, s[1 * 64] * 256.0f, 0, false); w0 = __builtin_amdgcn_cvt_pk_fp8_f32(s[2 * 64] * 256.0f, s[3 * 64] * 256.0f, w0, true);
            int w1 = __builtin_amdgcn_cvt_pk_fp8_f32(s[4 * 64] * 256.0f, s[5 * 64] * 256.0f, 0, false); w1 = __builtin_amdgcn_cvt_pk_fp8_f32(s[6 * 64] * 256.0f, s[7 * 64] * 256.0f, w1, true);
            v2u o2; o2.x = (unsigned)w0; o2.y = (unsigned)w1; *(GAS v2u*)((GAS unsigned char*)WT + (size_t)row * K + k0 + 8 * c) = o2;
        } else {
        v4u o; o.x = pk2(s[0 * 64] * cs, s[1 * 64] * cs); o.y = pk2(s[2 * 64] * cs, s[3 * 64] * cs); o.z = pk2(s[4 * 64] * cs, s[5 * 64] * cs); o.w = pk2(s[6 * 64] * cs, s[7 * 64] * cs);
        *(GAS v4u*)(WT + (size_t)row * K + k0 + 8 * c) = o; } }
    LDS_WAIT(); asm volatile("" ::: "memory");
}
#ifndef FP8_L0
#define FP8_L0 DEPTH
#endif
constexpr int I_IN = 32 * (NIN / 64), I_SQ = 32 * 32, I_F1 = 32 * (NFF / 64), I_F2 = (DFF / 64) * 32, I_LAYER = I_IN + 3 * I_SQ + I_F1 + I_F2;
__device__ __forceinline__ void conv_item(Frame& F, int it, LAS float* scr) {
    const int l = it / I_LAYER; int r = it % I_LAYER;
    unsigned char* wl = F.ws + WS_W + (size_t)l * W_LAYER;
    const float* W; int Nsrc = D, K = D, mode = 0, nb = 32; bf16* WT; const float* ks = nullptr; float qs = 1.f;
    if (r < I_IN) { W = F.w_in + (size_t)l * D * NIN; Nsrc = NIN; WT = (bf16*)(wl + W_IN); mode = 1; ks = F.norm_mix_w + l * D; qs = 0.08838834764831845f; nb = NIN / 64; }
    else if ((r -= I_IN) < I_SQ) { W = F.ret_proj + (size_t)l * D * D; WT = (bf16*)(wl + W_R); }
    else if ((r -= I_SQ) < I_SQ) { W = F.sgu_proj + (size_t)l * D * D; WT = (bf16*)(wl + W_S); }
    else if ((r -= I_SQ) < I_SQ) { W = F.w_out + (size_t)l * D * D; WT = (bf16*)(wl + W_O); }
    else if ((r -= I_SQ) < I_F1) { W = F.w_ffn_in + (size_t)l * D * NFF; Nsrc = NFF; WT = (bf16*)(wl + W_F1); mode = 2; ks = F.norm_ffn_w + l * D; nb = NFF / 64; }
    else { r -= I_F1; W = F.w_ffn_out + (size_t)l * DFF * D; K = DFF; WT = (bf16*)(wl + W_F2); if (l >= FP8_L0) mode = 3; }
    p0_transpose_item(W, Nsrc, K, WT, mode, ks, qs, scr, r / nb, r % nb, F.lane);
}
constexpr int CW_CONV_DONE = 2624;
constexpr int CONV_CUR_OFF = MISC_OFF + 64;
__device__ __forceinline__ bool conv_work_one(Frame& F, int max_layer = DEPTH - 1) {
    volatile LAS unsigned* cur = (volatile LAS unsigned*)(F.lds + CONV_CUR_OFF) + F.wave;
    const int NGW = NWG * NWAVES, gw = blockIdx.x * NWAVES + F.wave;
    const int k = __builtin_amdgcn_readfirstlane((int)*cur);
    if (k >= (DEPTH * I_LAYER) / NGW + 1) return false;
    const int it = I_LAYER + gw + k * NGW;
    if (it >= DEPTH * I_LAYER) return false;
    const int layer = it / I_LAYER;
    if (layer > max_layer) return false;
    conv_item(F, it, (LAS float*)(F.lds + RING_OFF + F.wave * 16384));
    if (F.lane == 0) *cur = (unsigned)(k + 1);
    if ((it + NGW) / I_LAYER != layer) {
        asm volatile("s_waitcnt vmcnt(0)" ::: "memory");
        if (F.lane == 0) __hip_atomic_fetch_add((unsigned*)(F.ws + WS_CTL) + CW_CONV_DONE + 64 * layer, 1u, __ATOMIC_RELAXED, __HIP_MEMORY_SCOPE_AGENT); }
    return true;
}
__device__ __forceinline__ void conv_finish(Frame& F, int layer) {
    while (conv_work_one(F, layer)) { }
    unsigned* cnt = (unsigned*)(F.ws + WS_CTL) + CW_CONV_DONE + 64 * layer; const unsigned want = (unsigned)(NWG * NWAVES);
    for (unsigned spins = 0; spins < (1u << 22); ++spins) {
        unsigned d = 0; if (F.lane == 0) d = __hip_atomic_load(cnt, __ATOMIC_RELAXED, __HIP_MEMORY_SCOPE_AGENT);
        d = (unsigned)__builtin_amdgcn_readfirstlane((int)d);
        if (d >= want) break;
        __builtin_amdgcn_s_sleep(8);
    }
    __syncthreads();
}
__device__ __forceinline__ void p0_prologue(Frame& F) {
    LAS float* scr = (LAS float*)(F.lds + RING_OFF + F.wave * 16384);
    const int gw = blockIdx.x * NWAVES + F.wave, NGW = NWG * NWAVES;
    for (int it = gw; it < I_LAYER; it += NGW) conv_item(F, it, scr);
    bf16* XB = (bf16*)(F.ws + WS_XB); float* SS = (float*)(F.ws + WS_SS);
    for (int m = gw; m < M; m += NGW) {
        const GAS f32x4* xr = (const GAS f32x4*)(F.x + (size_t)m * D) + F.lane; GAS v2u* bo = (GAS v2u*)(XB + (size_t)m * D) + F.lane;
        float s = 0.f;
#pragma unroll
        for (int j = 0; j < 8; ++j) { const f32x4 v = xr[64 * j]; s += (v[0] * v[0] + v[1] * v[1]) + (v[2] * v[2] + v[3] * v[3]); v2u w; w.x = pk2(v[0], v[1]); w.y = pk2(v[2], v[3]); bo[64 * j] = w; }
        s = wave_sum(s, F.lane);
        if (F.lane < 32) SS[(size_t)m * 32 + F.lane] = (F.lane == 0) ? s : 0.f;
    }
    float* rope = (float*)(F.ws + WS_ROPE);
    for (int t = blockIdx.x * (NWAVES * 64) + F.tid; t < T * 64; t += NWG * NWAVES * 64) {
        const int pos = t >> 6, i = t & 63; const float inv = powf(10000.0f, -(float)i * (1.0f / 64.0f)); const float ang = (float)pos * inv;
        float sn, cs; sincosf(ang, &sn, &cs); rope[2 * t] = cs; rope[2 * t + 1] = sn;
    }
}

template <bool P2> __device__ __forceinline__ void ret_unit(Frame& F, int u, int layer) {
    LAS unsigned char* lds = F.lds + RING_OFF;
    const int w = F.wave, lane_u = F.lane;
    int lane = lane_u, g = lane >> 4, c16 = lane & 15;
    const int bh = u >> 4, seg = u & 15, b = bh >> 3, h = bh & 7;
    const size_t tb = (size_t)b * T + (size_t)seg * 512;
    const float l2g = l2gamma(h);
    const float cdec = ex2(l2g * 64.0f);
    const bf16* Qg = (const bf16*)(F.ws + WS_Q); const bf16* Kg = (const bf16*)(F.ws + WS_K); const bf16* Vg = (const bf16*)(F.ws + WS_V); const bf16* SGg = (const bf16*)(F.ws + WS_SG);
    bf16* RA = (bf16*)(F.ws + WS_RA);
    float* sp = (float*)(F.ws + WS_SLOC) + (size_t)(bh * 16 + seg) * (128 * 256);
    const float* gnw = F.ret_gn_w + (size_t)layer * 2048 + h * 256;
    f32x4 st[8][2];
    { int so = (32 * w + c16) * 128 + 4 * g;
#pragma unroll
      for (int dt = 0; dt < 8; ++dt) {
        asm volatile("" : "+v"(so));
        const GAS float* spl = (const GAS float*)sp + so;
#pragma unroll
        for (int et = 0; et < 2; ++et) {
            if (P2) st[dt][et] = *(const GAS f32x4*)(spl + et * 2048);
            else st[dt][et] = (f32x4){0.f, 0.f, 0.f, 0.f}; }
        so += 16; } }
    const float l2g_u = l2g;
    v4u qr[2], kr[2], vr[4];
    { const int tid = (w << 6) | lane_u;
#pragma unroll
    for (int i = 0; i < 2; ++i) { const int ch = tid + 512 * i, row = ch >> 4, c8 = ch & 15;
        if (P2) qr[i] = *(const GAS v4u*)(Qg + (tb + row) * 1024 + h * 128 + c8 * 8);
        kr[i] = *(const GAS v4u*)(Kg + (tb + row) * 1024 + h * 128 + c8 * 8); }
#pragma unroll
    for (int i = 0; i < 4; ++i) { const int ch = tid + 512 * i, row = ch >> 5, c8 = ch & 31; vr[i] = *(const GAS v4u*)(Vg + (tb + row) * 2048 + h * 256 + c8 * 8); } }
    for (int cc = 0; cc < 8; ++cc) {
        const size_t r0 = tb + (size_t)cc * 64;
        float l2g = l2g_u; asm volatile("" : "+v"(l2g));
        lane = lane_u; asm volatile("" : "+v"(lane)); g = lane >> 4; c16 = lane & 15;
        const int tid = (w << 6) | lane;
        LAS unsigned char* img = P2 ? lds : lds + (cc & 1) * R1_BUF;
#pragma unroll
        for (int i = 0; i < 2; ++i) { const int ch = tid + 512 * i, row = ch >> 4, c8 = ch & 15;
            if (P2) { *(LAS v4u*)(img + R_Q + row * PQ + c8 * 16) = qr[i]; *(LAS v4u*)(img + R_K + row * PQ + c8 * 16) = kr[i]; }
            const v4u kv = kr[i]; const float kd = ex2(l2g * (float)(63 - row));
            v4u ks; ks.x = pk2(blo(kv.x) * kd, bhi(kv.x) * kd); ks.y = pk2(blo(kv.y) * kd, bhi(kv.y) * kd); ks.z = pk2(blo(kv.z) * kd, bhi(kv.z) * kd); ks.w = pk2(blo(kv.w) * kd, bhi(kv.w) * kd);
            *(LAS v4u*)(img + (P2 ? R_KS : R1_KS) + row * PQ + c8 * 16) = ks; }
#pragma unroll
        for (int i = 0; i < 4; ++i) { const int ch = tid + 512 * i, row = ch >> 5, c8 = ch & 31; { LAS unsigned char* vp = img + (P2 ? R_V : R1_V) + row * PV + ((c8 >> 2) * 32 + (c8 & 3) * 4) * 2;
            v2u lo_, hi_; lo_.x = vr[i].x; lo_.y = vr[i].y; hi_.x = vr[i].z; hi_.y = vr[i].w; *(LAS v2u*)vp = lo_; *(LAS v2u*)(vp + 32) = hi_; } }
        __syncthreads();
        if (cc < 7) { const size_t rn = r0 + 64;
#pragma unroll
            for (int i = 0; i < 2; ++i) { const int ch = tid + 512 * i, row = ch >> 4, c8 = ch & 15;
                if (P2) qr[i] = *(const GAS v4u*)(Qg + (rn + row) * 1024 + h * 128 + c8 * 8);
                kr[i] = *(const GAS v4u*)(Kg + (rn + row) * 1024 + h * 128 + c8 * 8); }
#pragma unroll
            for (int i = 0; i < 4; ++i) { const int ch = tid + 512 * i, row = ch >> 5, c8 = ch & 31; vr[i] = *(const GAS v4u*)(Vg + (rn + row) * 2048 + h * 256 + c8 * 8); } }
        f32x4 o[2][4];
        if (P2) {
#pragma unroll
            for (int tt = 0; tt < 2; ++tt) { const int t16 = 2 * w + tt, jt = t16 >> 2, it = t16 & 3; f32x4 a = (f32x4){0.f, 0.f, 0.f, 0.f};
#pragma unroll
                for (int ks = 0; ks < 4; ++ks) { const bf16x8 A = *(const LAS bf16x8*)(lds + R_K + (16 * jt + c16) * PQ + (32 * ks + 8 * g) * 2); const bf16x8 B = *(const LAS bf16x8*)(lds + R_Q + (16 * it + c16) * PQ + (32 * ks + 8 * g) * 2);
                    a = MFMA16(A, B, a); }
                const int ii = 16 * it + c16;
#pragma unroll
                for (int r = 0; r < 4; ++r) { const int jj = 16 * jt + 4 * g + r; a[r] *= ex2(l2g * fabsf((float)(ii - jj))); }
                v2u pw; pw.x = pg8::cvt_pk_bf16(a[0], a[1]); pw.y = pg8::cvt_pk_bf16(a[2], a[3]);
                *(LAS v2u*)(lds + R_P + ii * PP + (16 * jt + 4 * g) * 2) = pw; }
            __syncthreads();
#pragma unroll
            for (int et = 0; et < 2; ++et)
#pragma unroll
                for (int it = 0; it < 4; ++it) o[et][it] = (f32x4){0.f, 0.f, 0.f, 0.f};
#pragma unroll
            for (int ks = 0; ks < 4; ++ks) { bf16x8 A[2];
#pragma unroll
                for (int et = 0; et < 2; ++et) A[et] = pack_f8(st[2 * ks][et], st[2 * ks + 1][et]);
#pragma unroll
                for (int it = 0; it < 4; ++it) { LAS const unsigned char* qp = lds + R_Q + (16 * it + c16) * PQ + (32 * ks + 4 * g) * 2;
                    const s16x4 lo = *(const LAS s16x4*)qp, hi = *(const LAS s16x4*)(qp + 32); const bf16x8 B = __builtin_shufflevector(lo, hi, 0, 1, 2, 3, 4, 5, 6, 7);
#pragma unroll
                    for (int et = 0; et < 2; ++et) o[et][it] = MFMA16(A[et], B, o[et][it]); }
                __builtin_amdgcn_sched_barrier(0); }
#pragma unroll
            for (int it = 0; it < 4; ++it) { const float qd = ex2(l2g * (float)(16 * it + c16 + 1));
#pragma unroll
                for (int et = 0; et < 2; ++et) o[et][it] *= qd; }
        }
        if (P2) {
#pragma unroll
            for (int ks2 = 0; ks2 < 2; ++ks2) { bf16x8 vf[2];
#pragma unroll
                for (int et = 0; et < 2; ++et) vf[et] = tr_frag(img + (P2 ? R_V : R1_V), PV, 32 * ks2, 32 * w + 16 * et, lane);
#pragma unroll
                for (int it = 0; it < 4; ++it) { const bf16x8 B = *(const LAS bf16x8*)(lds + R_P + (16 * it + c16) * PP + (32 * ks2 + 8 * g) * 2);
#pragma unroll
                    for (int et = 0; et < 2; ++et) o[et][it] = MFMA16(vf[et], B, o[et][it]); __builtin_amdgcn_sched_barrier(0); } }
        }
#pragma unroll
        for (int dt = 0; dt < 8; ++dt)
#pragma unroll
            for (int et = 0; et < 2; ++et) st[dt][et] *= cdec;
#pragma unroll
        for (int ks2 = 0; ks2 < 2; ++ks2) { bf16x8 vf[2];
#pragma unroll
            for (int et = 0; et < 2; ++et) vf[et] = tr_frag(img + (P2 ? R_V : R1_V), PV, 32 * ks2, 32 * w + 16 * et, lane);
#pragma unroll
            for (int dt = 0; dt < 8; ++dt) { const bf16x8 A = tr_frag(img + (P2 ? R_KS : R1_KS), PQ, 32 * ks2, 16 * dt, lane);
#pragma unroll
                for (int et = 0; et < 2; ++et) st[dt][et] = MFMA16(A, vf[et], st[dt][et]); __builtin_amdgcn_sched_barrier(0); } }
        if (P2) {
            LAS f32x2* red = (LAS f32x2*)(lds + R_RED);
            v4u sgr[4];
#pragma unroll
            for (int it = 0; it < 4; ++it) sgr[it] = *(const GAS v4u*)(SGg + (r0 + 16 * it + c16) * 2048 + h * 256 + 32 * w + 8 * g);
#pragma unroll
            for (int it = 0; it < 4; ++it) { float s1 = 0.f, s2 = 0.f;
#pragma unroll
                for (int et = 0; et < 2; ++et)
#pragma unroll
                    for (int r = 0; r < 4; ++r) { const float v = o[et][it][r]; s1 += v; s2 += v * v; }
                s1 += pg8::shx(s1, 16, lane); s1 += pg8::shx(s1, 32, lane); s2 += pg8::shx(s2, 16, lane); s2 += pg8::shx(s2, 32, lane);
                if (g == 0) red[w * 64 + 16 * it + c16] = (f32x2){s1, s2}; }
            __syncthreads();
#pragma unroll
            for (int it = 0; it < 4; ++it) { const int ii = 16 * it + c16; float S1 = 0.f, S2 = 0.f;
#pragma unroll
                for (int w8 = 0; w8 < 8; ++w8) { const f32x2 t = red[w8 * 64 + ii]; S1 += t.x; S2 += t.y; }
                const float mu = S1 * (1.0f / 256.0f), var = fmaxf(S2 * (1.0f / 256.0f) - mu * mu, 0.f), rstd = 1.0f / sqrtf(var + EPS);
                { const int col = h * 256 + 32 * w + 8 * g; const size_t off = (r0 + ii) * 2048 + col; const v4u sg = sgr[it]; v4u ow;
                  { const f32x4 gw4 = *(const f32x4*)(gnw + 32 * w + 8 * g);
                    const float y0 = (o[0][it][0] - mu) * rstd * gw4[0] * blo(sg.x), y1 = (o[0][it][1] - mu) * rstd * gw4[1] * bhi(sg.x), y2 = (o[0][it][2] - mu) * rstd * gw4[2] * blo(sg.y), y3 = (o[0][it][3] - mu) * rstd * gw4[3] * bhi(sg.y);
                    ow.x = pg8::cvt_pk_bf16(y0, y1); ow.y = pg8::cvt_pk_bf16(y2, y3); }
                  { const f32x4 gw4 = *(const f32x4*)(gnw + 32 * w + 8 * g + 4);
                    const float y0 = (o[1][it][0] - mu) * rstd * gw4[0] * blo(sg.z), y1 = (o[1][it][1] - mu) * rstd * gw4[1] * bhi(sg.z), y2 = (o[1][it][2] - mu) * rstd * gw4[2] * blo(sg.w), y3 = (o[1][it][3] - mu) * rstd * gw4[3] * bhi(sg.w);
                    ow.z = pg8::cvt_pk_bf16(y0, y1); ow.w = pg8::cvt_pk_bf16(y2, y3); }
                  *(GAS v4u*)(RA + off) = ow; } }
        }
    }
    __syncthreads();
#if !defined(SKIP_R1_STORE)
    if (!P2) {
        int so = (32 * w + c16) * 128 + 4 * g;
#pragma unroll
        for (int dt = 0; dt < 8; ++dt) {
            asm volatile("" : "+v"(so));
            GAS float* spl = (GAS float*)sp + so;
#pragma unroll
            for (int et = 0; et < 2; ++et) *(GAS f32x4*)(spl + et * 2048) = st[dt][et];
            so += 16; }
    }
#else
    if (!P2) { float acc_ = 0.f;
#pragma unroll
        for (int dt = 0; dt < 8; ++dt)
#pragma unroll
            for (int et = 0; et < 2; ++et)
#pragma unroll
                for (int r = 0; r < 4; ++r) acc_ += st[dt][et][r];
        if (acc_ == 123.456f) sp[0] = acc_; }
#endif
}
__device__ __forceinline__ void ret_scan(Frame& F) {
    float* sl = (float*)(F.ws + WS_SLOC);
    for (int idx = blockIdx.x * (NWAVES * 64) + F.tid; idx < 16 * 8192; idx += NWG * NWAVES * 64) {
        const int bh = idx >> 13, e4 = idx & 8191, h = bh & 7;
        const float l2g = l2gamma(h); const float cd8 = ex2(l2g * 512.0f);
        f32x4 carry = (f32x4){0.f, 0.f, 0.f, 0.f}; asm volatile("" : "+v"(carry));
        for (int seg = 0; seg < 16; ++seg) { GAS f32x4* p = (GAS f32x4*)(sl + (size_t)(bh * 16 + seg) * 32768) + e4; const f32x4 t = *p; *p = carry; carry = carry * cd8 + t; }
    }
}

__device__ __forceinline__ void sgu_stats(const float* LS, size_t r0, LAS f32x2* stt, int tid) {
    if (tid < 128) { const GAS f32x4* p = (const GAS f32x4*)(LS + (r0 + tid) * 64); float S1 = 0.f, S2 = 0.f;
#pragma unroll
        for (int i = 0; i < 16; ++i) { const f32x4 t = p[i]; S1 += t[0] + t[2]; S2 += t[1] + t[3]; }
        const float mu = S1 * (1.0f / 2048.0f), var = fmaxf(S2 * (1.0f / 2048.0f) - mu * mu, 0.f); stt[tid] = (f32x2){mu, 1.0f / sqrtf(var + EPS)}; }
}
__device__ __forceinline__ void sgu_phase(Frame& F, int layer) {
    LAS unsigned char* lds = F.lds + RING_OFF;
    const int w = F.wave, lane_u = F.lane;
    int lane = lane_u, tid = (w << 6) | lane, g = lane >> 4, c16 = lane & 15;
    const bf16* ZU = (const bf16*)(F.ws + WS_ZU); const bf16* ZV = (const bf16*)(F.ws + WS_ZV); bf16* SB = (bf16*)(F.ws + WS_SB);
    const float* LS = (const float*)(F.ws + WS_LS);
    int cg_loaded = -1;
    v4u zvr[8];
    int u = blockIdx.x;
    if (u < 1024) { const int cg = u & 7; const size_t r0 = (size_t)(u >> 3) * 128;
#pragma unroll
        for (int i = 0; i < 8; ++i) { const int ch = tid + 512 * i, j = ch >> 5, c8 = ch & 31; zvr[i] = *(const GAS v4u*)(ZV + (r0 + j) * 2048 + 256 * cg + 8 * c8); }
        sgu_stats(LS, r0, (LAS f32x2*)(lds + S_ST), tid); }
    for (int it_u = 0; u < 1024; u += NWG, ++it_u) {
        lane = lane_u; asm volatile("" : "+v"(lane)); tid = (w << 6) | lane; g = lane >> 4; c16 = lane & 15;
        const int cg = u & 7, rg = u >> 3; const size_t r0 = (size_t)rg * 128; const int ch0 = 256 * cg;
        const float* lnw = F.sgu_ln_w + (size_t)layer * 2048 + ch0; const float* lnb = F.sgu_ln_b + (size_t)layer * 2048 + ch0;
        const float* bs = F.sgu_b_s + ((size_t)layer * 8 + cg) * 128;
        LAS f32x2* stt = (LAS f32x2*)(lds + S_ST + (it_u & 1) * 1024);
        if (cg != cg_loaded) { const float* wsrc = F.sgu_w_s + ((size_t)layer * 8 + cg) * (128 * 128); cg_loaded = cg;
#pragma unroll
            for (int i = 0; i < 8; ++i) { const int idx4 = tid + 512 * i, ir = idx4 >> 5, j4 = (idx4 & 31) * 4; f32x4 wv = *(const GAS f32x4*)(wsrc + ir * 128 + j4);
                if ((j4 >> 6) > (ir >> 6)) wv = (f32x4){0.f, 0.f, 0.f, 0.f};
                v2u pw; pw.x = pk2(wv[0], wv[1]); pw.y = pk2(wv[2], wv[3]); *(LAS v2u*)(lds + S_W + ir * PQ + j4 * 2) = pw; } }
        if (it_u == 0) __syncthreads();
#pragma unroll
        for (int i = 0; i < 8; ++i) { const int ch = tid + 512 * i, j = ch >> 5, c8 = ch & 31; const v4u zv = zvr[i];
            const f32x4 w0 = *(const f32x4*)(lnw + 8 * c8), w1 = *(const f32x4*)(lnw + 8 * c8 + 4), b0 = *(const f32x4*)(lnb + 8 * c8), b1 = *(const f32x4*)(lnb + 8 * c8 + 4);
            const f32x2 ms = stt[j]; const float mu = ms.x, rs = ms.y;
            v4u o; o.x = pk2((blo(zv.x) - mu) * rs * w0[0] + b0[0], (bhi(zv.x) - mu) * rs * w0[1] + b0[1]); o.y = pk2((blo(zv.y) - mu) * rs * w0[2] + b0[2], (bhi(zv.y) - mu) * rs * w0[3] + b0[3]);
            o.z = pk2((blo(zv.z) - mu) * rs * w1[0] + b1[0], (bhi(zv.z) - mu) * rs * w1[1] + b1[1]); o.w = pk2((blo(zv.w) - mu) * rs * w1[2] + b1[2], (bhi(zv.w) - mu) * rs * w1[3] + b1[3]);
            { LAS unsigned char* vp = lds + S_VN + j * PV + ((c8 >> 2) * 32 + (c8 & 3) * 4) * 2;
              v2u lo_, hi_; lo_.x = o.x; lo_.y = o.y; hi_.x = o.z; hi_.y = o.w; *(LAS v2u*)vp = lo_; *(LAS v2u*)(vp + 32) = hi_; } }
        __syncthreads();
        const int un = u + NWG;
        if (un < 1024) { const size_t rn = (size_t)(un >> 3) * 128; const int cgn = un & 7;
#pragma unroll
            for (int i = 0; i < 8; ++i) { const int ch = tid + 512 * i, j = ch >> 5, c8 = ch & 31; zvr[i] = *(const GAS v4u*)(ZV + (rn + j) * 2048 + 256 * cgn + 8 * c8); }
            sgu_stats(LS, rn, (LAS f32x2*)(lds + S_ST + ((it_u + 1) & 1) * 1024), tid); }
        v4u zur[8];
#pragma unroll
        for (int it = 0; it < 8; ++it) zur[it] = *(const GAS v4u*)(ZU + (r0 + 16 * it + c16) * 2048 + ch0 + 32 * w + 8 * g);
        f32x4 acc[2][8];
#pragma unroll
        for (int ct = 0; ct < 2; ++ct)
#pragma unroll
            for (int it = 0; it < 8; ++it) acc[ct][it] = (f32x4){0.f, 0.f, 0.f, 0.f};
#pragma unroll
        for (int ks = 0; ks < 4; ++ks) { bf16x8 A[2];
#pragma unroll
            for (int ct = 0; ct < 2; ++ct) A[ct] = tr_frag(lds + S_VN, PV, 32 * ks, 32 * w + 16 * ct, lane);
#pragma unroll
            for (int it = 0; it < 8; ++it) { if (it < 4 && ks >= 2) continue;
                const bf16x8 B = *(const LAS bf16x8*)(lds + S_W + (16 * it + c16) * PQ + (32 * ks + 8 * g) * 2);
#pragma unroll
                for (int ct = 0; ct < 2; ++ct) acc[ct][it] = MFMA16(A[ct], B, acc[ct][it]); __builtin_amdgcn_sched_barrier(0); } }
#pragma unroll
        for (int it = 0; it < 8; ++it) { const int ii = 16 * it + c16; const float bsv = bs[ii];
            { const size_t off = (r0 + ii) * 2048 + ch0 + 32 * w + 8 * g; const v4u zu = zur[it];
                v4u ow; ow.x = pg8::cvt_pk_bf16(blo(zu.x) * (acc[0][it][0] + bsv), bhi(zu.x) * (acc[0][it][1] + bsv)); ow.y = pg8::cvt_pk_bf16(blo(zu.y) * (acc[0][it][2] + bsv), bhi(zu.y) * (acc[0][it][3] + bsv));
                ow.z = pg8::cvt_pk_bf16(blo(zu.z) * (acc[1][it][0] + bsv), bhi(zu.z) * (acc[1][it][1] + bsv)); ow.w = pg8::cvt_pk_bf16(blo(zu.w) * (acc[1][it][2] + bsv), bhi(zu.w) * (acc[1][it][3] + bsv));
                *(GAS v4u*)(SB + off) = ow; } }
        __syncthreads();
    }
}

__device__ __forceinline__ void final_norm(Frame& F) {
    const int gw = blockIdx.x * NWAVES + F.wave, NGW = NWG * NWAVES;
    const bf16* XB = (const bf16*)(F.ws + WS_XB); const float* SS = (const float*)(F.ws + WS_SS);
    for (int m = gw; m < M; m += NGW) {
        const float s = wave_sum(F.lane < 32 ? SS[(size_t)m * 32 + F.lane] : 0.f, F.lane); const float rstd = 1.0f / sqrtf(s * (1.0f / 2048.0f) + EPS);
        const GAS v2u* xr = (const GAS v2u*)(XB + (size_t)m * D) + F.lane; const GAS f32x4* fw = (const GAS f32x4*)F.final_norm_w + F.lane; GAS f32x4* o = (GAS f32x4*)(F.out + (size_t)m * D) + F.lane;
#pragma unroll
        for (int j = 0; j < 8; ++j) { const v2u w = xr[64 * j]; const f32x4 g = fw[64 * j]; o[64 * j] = (f32x4){blo(w.x) * rstd * g[0], bhi(w.x) * rstd * g[1], blo(w.y) * rstd * g[2], bhi(w.y) * rstd * g[3]}; }
    }
}

#if defined(PROBE_STOP)
__device__ __forceinline__ void probe_dump(Frame& F) {
    const size_t offs[12] = {WS_V, WS_SG, WS_ZU, WS_ZV, WS_GA, WS_GB, WS_RA, WS_SB, WS_MG, WS_XB, WS_P, 0};
    for (size_t i = (size_t)blockIdx.x * 512 + F.tid; i < (size_t)M * D; i += (size_t)NWG * 512) {
        float a = 0.f; const size_t m = i >> 11, c = i & 2047;
#pragma unroll
        for (int b = 0; b < 11; ++b) if (PROBE_MASK & (1 << b)) a += blo((unsigned)((const bf16*)(F.ws + offs[b]))[i]);
        if (PROBE_MASK & (1 << 11)) { if (c < 1024) a += blo((unsigned)((const bf16*)(F.ws + WS_Q))[m * 1024 + c]) + blo((unsigned)((const bf16*)(F.ws + WS_K))[m * 1024 + c]); }
        if (PROBE_MASK & (1 << 12)) a += blo((unsigned)((const bf16*)(F.ws + WS_H))[m * 5632 + c]) + blo((unsigned)((const bf16*)(F.ws + WS_H))[m * 5632 + 2048 + c]) + ((c < 1536) ? blo((unsigned)((const bf16*)(F.ws + WS_H))[m * 5632 + 4096 + c]) : 0.f);
        if (PROBE_MASK & (1 << 13)) { if (i < (size_t)D * D) a += blo((unsigned)((const bf16*)(F.ws + WS_W + W_R))[i]); }
        if (PROBE_MASK & (1 << 14)) { if (i < (size_t)D * D) a += blo((unsigned)((const bf16*)(F.ws + WS_W + W_S))[i]) + blo((unsigned)((const bf16*)(F.ws + WS_W + W_O))[i]); }
        F.out[i] = a;
    }
}
#endif
constexpr int PH_PER_LAYER = 8, NPHASES = 2 + DEPTH * PH_PER_LAYER;
struct Args { const float* in[15]; float* out; unsigned char* ws; int ph_lo, ph_hi; };
static_assert(sizeof(Args) == 15 * 8 + 8 + 8 + 8, "Args has no padding");
__global__ void __launch_bounds__(NWAVES * 64, 2) mk_fwd(Args args) {
    extern __shared__ __attribute__((aligned(16))) unsigned char lds_raw[];
    Frame F;
    F.lds = (LAS unsigned char*)lds_raw;
    F.tid = threadIdx.x; F.lane = F.tid & 63; F.wave = __builtin_amdgcn_readfirstlane(F.tid >> 6);
    F.x = args.in[0]; F.norm_mix_w = args.in[1]; F.w_in = args.in[2]; F.ret_gn_w = args.in[3]; F.ret_proj = args.in[4]; F.sgu_ln_w = args.in[5]; F.sgu_ln_b = args.in[6]; F.sgu_w_s = args.in[7];
    F.sgu_b_s = args.in[8]; F.sgu_proj = args.in[9]; F.w_out = args.in[10]; F.norm_ffn_w = args.in[11]; F.w_ffn_in = args.in[12]; F.w_ffn_out = args.in[13]; F.final_norm_w = args.in[14];
    F.out = args.out; F.ws = args.ws;
#if defined(ZERO_LDS)
    for (int u = F.tid; u < LDS_BYTES / 4; u += NWAVES * 64) ((LAS unsigned*)(F.lds))[u] = 0u;
#else
    for (int u = F.tid; u < (LDS_BYTES - LDSCTL_OFF) / 4; u += NWAVES * 64) ((LAS unsigned*)(F.lds + LDSCTL_OFF))[u] = 0u;
#endif
    __syncthreads();
#if MK_PER_PHASE || defined(PROBE_STOP)
    const int lo = args.ph_lo, hi = args.ph_hi;
#else
    constexpr int lo = 0, hi = NPHASES;
#endif
    unsigned* ctl = (unsigned*)(F.ws + WS_CTL);
#if defined(TAIL_MIN)
    if (blockIdx.x == 0 && threadIdx.x == 0) ((unsigned long long*)(ctl + 2048))[1] = ~0ull;
#endif
    XcdBarrier bar; bar.bar = ctl + CW_BAR; bar.x = 0; bar.st = nullptr;
    if (hi - lo > 1) bar = xcd_barrier_post(ctl + CW_BAR, (volatile LAS unsigned*)(F.lds + MISC_OFF) + 8);
#ifndef MK_ONLY
#define MK_ONLY -1
#endif
#if defined(PROBE_STOP)
#define IN(k) (lo <= (k) && (k) < hi && ((k) <= PROBE_STOP || (k) == NPHASES - 1))
#elif MK_PER_PHASE
#define IN(k) (lo <= (k) && (k) < hi)
#else
#define IN(k) true
#endif
#define INP(slot, k) ((MK_ONLY < 0 || MK_ONLY == (slot)) && IN(k))
#ifndef DUP_SLOT
#define DUP_SLOT -1
#endif
#define REP(slot) for (int rep_ = 0; rep_ < ((DUP_SLOT == (slot)) ? 2 : 1); ++rep_)
#if defined(TAIL_PROBE)
    unsigned long long wait_sum = 0ull;
#ifndef TAIL_MASK
#define TAIL_MASK 0x1ff
#endif
#define SEAM(k) do { if (IN(k) && IN((k) + 1)) { const unsigned long long t0_ = wall_clock64(); xcd_barrier(bar); const int st_ = ((k) == 0) ? 8 : (((k) - 1) & 7); if ((TAIL_MASK >> st_) & 1) wait_sum += wall_clock64() - t0_; } } while (0)
#elif defined(DUP_BARRIER)
#define SEAM(k) do { if (IN(k) && IN((k) + 1)) { xcd_barrier(bar); xcd_barrier(bar); } } while (0)
#else
#define SEAM(k) do { if (IN(k) && IN((k) + 1)) { FRESH(); XcdBarrier b2_ = bar; b2_.bar = (unsigned*)(F.ws + WS_CTL) + CW_BAR; { unsigned so_ = MISC_OFF + 32; asm volatile("" : "+s"(so_)); b2_.st = (volatile LAS unsigned*)(F.lds + so_); } xcd_barrier_idle(b2_, F, F.tid); } } while (0)
#endif
    size_t zero_o = 0; const int wave_s = __builtin_amdgcn_readfirstlane(threadIdx.x >> 6);
#define FRESH() do { asm volatile("" : "+s"(zero_o)); int l_; asm volatile("v_mbcnt_lo_u32_b32 %0, -1, 0\n\tv_mbcnt_hi_u32_b32 %0, -1, %0" : "=v"(l_)); F.ws = args.ws + zero_o; F.lane = l_; F.wave = wave_s; F.tid = (wave_s << 6) | l_; } while (0)
#if defined(START_DELAY)
    if (IN(0)) { const unsigned long long t0 = wall_clock64(); while (wall_clock64() - t0 < 100ull * START_DELAY) __builtin_amdgcn_s_sleep(32); }
#endif
    if (INP(0, 0)) REP(0) { FRESH(); p0_prologue(F); }
    SEAM(0);
    for (int l = 0; l < DEPTH; ++l) {
        const int pb = 1 + PH_PER_LAYER * l;
        if (INP(1, pb + 0)) REP(1) { FRESH(); unsigned char* wl = F.ws + WS_W + (size_t)l * W_LAYER;
            pg8::Gemm gm{(const pg8::bf16_t*)(F.ws + WS_XB), (const pg8::bf16_t*)(wl + W_IN), M, NIN, D}; pg8::StaticOrder S; S.init(M, NIN, NWG, (int)blockIdx.x);
#if defined(G1_REV)
            pg8::RevOrder SR; SR.base = S;
#endif
            pg8::Unit u0; S.next(0, u0); const LAS float* rstab = (const LAS float*)(F.lds + RSTAB_OFF); pg8::rstd_table((const float*)(F.ws + WS_SS), u0.pm, (LAS float*)(F.lds + RSTAB_OFF), F.tid);
            pg8::EpiIn E{(const float*)(F.ws + WS_SS), (const float*)(F.ws + WS_ROPE), (pg8::bf16_t*)(F.ws + WS_Q), (pg8::bf16_t*)(F.ws + WS_K), (pg8::bf16_t*)(F.ws + WS_O2048), (float*)(F.ws + WS_LS), rstab, u0.pm};
#if defined(TIMING_NULL_G1)
#if defined(TIMING_SAME_TILE)
            if (rep_ == 1) { pg8::EpiNull EN{(float*)(F.ws + WS_SLOC)}; pg8::SameTileOrder ST{14}; pg8::gemm_phase<pg8::EpiNull, pg8::SameTileOrder, true, true>(F.lds + RING_OFF, gm, ST, EN, F.tid); } else
#else
#if defined(TIMING_NOSP2)
            if (rep_ == 1) { pg8::EpiNull EN{(float*)(F.ws + WS_SLOC)}; pg8::gemm_phase<pg8::EpiNull, pg8::StaticOrder, true, false>(F.lds + RING_OFF, gm, S, EN, F.tid); } else
#elif defined(TIMING_MM32)
            if (rep_ == 1) { pg8::EpiNull EN{(float*)(F.ws + WS_SLOC)}; pg8::gemm_phase<pg8::EpiNull, pg8::StaticOrder, true, true, true>(F.lds + RING_OFF, gm, S, EN, F.tid); } else
#else
            if (rep_ == 1) { pg8::EpiNull EN{(float*)(F.ws + WS_SLOC)}; pg8::gemm_phase<pg8::EpiNull, pg8::StaticOrder, true, true>(F.lds + RING_OFF, gm, S, EN, F.tid); } else
#endif
#endif
#endif
#if defined(G1_REV)
            pg8::gemm_phase<pg8::EpiIn, pg8::RevOrder, true, true>(F.lds + RING_OFF, gm, SR, E, F.tid);
#else
            pg8::gemm_phase<pg8::EpiIn, pg8::StaticOrder, true, true>(F.lds + RING_OFF, gm, S, E, F.tid);
#endif
        }
        SEAM(pb + 0);
        if (INP(2, pb + 1)) REP(2) { FRESH();
#if !defined(SKIP_R1)
#if defined(DUPSKIP_R1)
            if (rep_ == 0)
#endif
            for (int u = blockIdx.x; u < 256; u += NWG) ret_unit<false>(F, u, l);
#endif
#if defined(SLEEP_R1)
            { const unsigned long long t0 = wall_clock64(); while (wall_clock64() - t0 < 100ull * SLEEP_R1) __builtin_amdgcn_s_sleep(32); }
#endif
#if defined(DUMMY_R1)
            { const GAS v4u* src = (const GAS v4u*)(F.ws + WS_K); unsigned a_ = 0;
              for (size_t i = (size_t)blockIdx.x * 512 + F.tid; i < (size_t)96 * MiB / 16; i += (size_t)NWG * 512) { const v4u t = src[i]; a_ += t.x ^ t.y ^ t.z ^ t.w; }
              if (a_ == 0x12345678u) ((float*)(F.ws + WS_SLOC))[0] = 1.f; }
#endif
#if !defined(SGU_AFTER_R3)
            FRESH();
#if !defined(SKIP_SGU)
#if defined(DUPSKIP_SGU)
            if (rep_ == 0)
#endif
            sgu_phase(F, l);
#endif
#endif
        }
        SEAM(pb + 1);
        if (INP(3, pb + 2)) { FRESH(); ret_scan(F); }
        SEAM(pb + 2);
#if defined(SGU_AFTER_R3)
        if (INP(4, pb + 3)) REP(4) { FRESH(); for (int u = blockIdx.x; u < 256; u += NWG) ret_unit<true>(F, u, l); FRESH(); sgu_phase(F, l); }
#else
        if (INP(4, pb + 3)) REP(4) { FRESH(); for (int u = blockIdx.x; u < 256; u += NWG) ret_unit<true>(F, u, l); }
#endif
        SEAM(pb + 3);
        if (INP(5, pb + 4)) REP(5) { FRESH(); unsigned char* wl = F.ws + WS_W + (size_t)l * W_LAYER;
            pg8::Gemm gm{(const pg8::bf16_t*)(F.ws + WS_RA), (const pg8::bf16_t*)(wl + W_R), M, D, D}; pg8::PairOrder S; S.base.init(M, D, NWG, (int)blockIdx.x);
            pg8::EpiMerge E{(const pg8::bf16_t*)(F.ws + WS_GA), (const pg8::bf16_t*)(F.ws + WS_GB), (pg8::bf16_t*)(F.ws + WS_MG)};
            pg8::gemm_phase<pg8::EpiMerge, pg8::PairOrder, true, true>(F.lds + RING_OFF, gm, S, E, F.tid);
        }
        SEAM(pb + 4);
        if (INP(6, pb + 5)) REP(6) { FRESH(); unsigned char* wl = F.ws + WS_W + (size_t)l * W_LAYER;
            pg8::Gemm gm{(const pg8::bf16_t*)(F.ws + WS_MG), (const pg8::bf16_t*)(wl + W_O), M, D, D}; pg8::StaticOrder S; S.init(M, D, NWG, (int)blockIdx.x);
            pg8::EpiResid E{(pg8::bf16_t*)(F.ws + WS_XB), (float*)(F.ws + WS_SS2), (rep_ == 1) ? 0.f : 1.f};
#if defined(TIMING_NULL_G35)
            if (rep_ == 1) { pg8::EpiNull EN{(float*)(F.ws + WS_SLOC)}; pg8::gemm_phase<pg8::EpiNull, pg8::StaticOrder, true, true>(F.lds + RING_OFF, gm, S, EN, F.tid); } else
#endif
            pg8::gemm_phase<pg8::EpiResid, pg8::StaticOrder, true, true>(F.lds + RING_OFF, gm, S, E, F.tid);
        }
        SEAM(pb + 5);
        if (INP(7, pb + 6)) REP(7) { FRESH(); unsigned char* wl = F.ws + WS_W + (size_t)l * W_LAYER;
            pg8::Gemm gm{(const pg8::bf16_t*)(F.ws + WS_XB), (const pg8::bf16_t*)(wl + W_F1), M, NFF, D}; pg8::StaticOrder S; S.init(M, NFF, NWG, (int)blockIdx.x);
            pg8::Unit u0; S.next(0, u0); const LAS float* rstab = (const LAS float*)(F.lds + RSTAB_OFF); pg8::rstd_table((const float*)(F.ws + WS_SS2), u0.pm, (LAS float*)(F.lds + RSTAB_OFF), F.tid);
            pg8::EpiSwiglu E{(const float*)(F.ws + WS_SS2), (pg8::bf16_t*)(F.ws + WS_H), rstab, u0.pm};
#if defined(G4_REV)
            if (l >= FP8_L0) { pg8::EpiSwiglu8 E8{(const float*)(F.ws + WS_SS2), F.ws + WS_H, rstab, u0.pm}; pg8::RevOrder SR; SR.base = S; pg8::gemm_phase<pg8::EpiSwiglu8, pg8::RevOrder, true, true>(F.lds + RING_OFF, gm, SR, E8, F.tid); }
            else { pg8::RevOrder SR; SR.base = S; pg8::gemm_phase<pg8::EpiSwiglu, pg8::RevOrder, true, true>(F.lds + RING_OFF, gm, SR, E, F.tid); }
#else
            pg8::gemm_phase<pg8::EpiSwiglu, pg8::StaticOrder, true, true>(F.lds + RING_OFF, gm, S, E, F.tid);
#endif
        }
        SEAM(pb + 6);
        if (INP(8, pb + 7)) REP(8) { FRESH(); unsigned char* wl = F.ws + WS_W + (size_t)l * W_LAYER;
            pg8::Gemm gm{(const pg8::bf16_t*)(F.ws + WS_H), (const pg8::bf16_t*)(wl + W_F2), M, D, DFF}; pg8::StaticOrder S; S.init(M, D, NWG, (int)blockIdx.x);
            pg8::EpiResid E{(pg8::bf16_t*)(F.ws + WS_XB), (float*)(F.ws + WS_SS), (rep_ == 1) ? 0.f : 1.f};
#if defined(TIMING_NULL_G35)
            if (rep_ == 1) { pg8::EpiNull EN{(float*)(F.ws + WS_SLOC)}; pg8::gemm_phase<pg8::EpiNull, pg8::StaticOrder, true, true>(F.lds + RING_OFF, gm, S, EN, F.tid); } else
#endif
            if (l >= FP8_L0) { FRESH();
                pg8::Gemm gm8{(const pg8::bf16_t*)(F.ws + WS_H), (const pg8::bf16_t*)(wl + W_F2), M, D, DFF / 2};
                pg8::EpiResid E8{(pg8::bf16_t*)(F.ws + WS_XB), (float*)(F.ws + WS_SS), (rep_ == 1) ? 0.f : (1.0f / 2048.0f)};
                pg8::gemm_phase<pg8::EpiResid, pg8::StaticOrder, true, false, false, true>(F.lds + RING_OFF, gm8, S, E8, F.tid);
            } else { FRESH();
            pg8::gemm_phase<pg8::EpiResid, pg8::StaticOrder, true, true>(F.lds + RING_OFF, gm, S, E, F.tid); }
        }
        if (IN(pb + 7) && l + 1 < DEPTH) { FRESH(); conv_finish(F, l + 1); }
        SEAM(pb + 7);
    }
#if defined(TAIL_PROBE)
    if (hi - lo > 1) { unsigned long long* accp = (unsigned long long*)(ctl + 2048);
#if defined(TAIL_MIN)
        if (F.tid == 0) atomicMin(accp + 1, wait_sum);
#else
        if (F.tid == 0) atomicAdd(accp, wait_sum);
#endif
        xcd_barrier(bar);
        if (blockIdx.x == 0 && F.tid == 0) {
#if defined(TAIL_MIN)
            const unsigned long long avg = __hip_atomic_load(accp + 1, __ATOMIC_RELAXED, __HIP_MEMORY_SCOPE_AGENT);
#else
            const unsigned long long tot = __hip_atomic_load(accp, __ATOMIC_RELAXED, __HIP_MEMORY_SCOPE_AGENT); const unsigned long long avg = tot / gridDim.x;
#endif
            const unsigned long long t0_ = wall_clock64(); while (wall_clock64() - t0_ < avg * TAIL_PROBE) __builtin_amdgcn_s_sleep(32); } }
#endif
#if defined(END_WB)
    asm volatile("s_waitcnt vmcnt(0)" ::: "memory"); __builtin_amdgcn_fence(__ATOMIC_RELEASE, "agent"); asm volatile("s_waitcnt vmcnt(0)" ::: "memory");
#endif
#if defined(PROBE_STOP)
    if (hi - lo > 1) xcd_barrier(bar);
    if (IN(NPHASES - 1)) { FRESH(); probe_dump(F); }
#else
    if (INP(9, NPHASES - 1)) { FRESH(); final_norm(F); }
#endif
#undef IN
#undef INP
#undef FRESH
#undef SEAM
}

extern "C" void kernel_launch(void* const* d_in, const int* in_sizes, int n_in, void* d_out, int out_size, void* d_ws, size_t ws_size, hipStream_t stream) {
    static int grid = 0;
    if (grid == 0) {
        if (n_in != 15 || in_sizes[0] != M * D || out_size != M * D || ws_size < WS_END) { fprintf(stderr, "kernel_launch: unexpected sizes (n_in %d, in0 %d, out %d, ws %zu < %zu?)\n", n_in, n_in > 0 ? in_sizes[0] : -1, out_size, ws_size, (size_t)WS_END); grid = -1; return; }
        int dev = 0, cus = 0, per_cu = 0;
        if (hipGetDevice(&dev) != hipSuccess || hipDeviceGetAttribute(&cus, hipDeviceAttributeMultiprocessorCount, dev) != hipSuccess) { grid = -1; return; }
        if (hipFuncSetAttribute((const void*)mk_fwd, hipFuncAttributeMaxDynamicSharedMemorySize, LDS_BYTES) != hipSuccess) { fprintf(stderr, "kernel_launch: hipFuncSetAttribute failed\n"); grid = -1; return; }
        if (hipOccupancyMaxActiveBlocksPerMultiprocessor(&per_cu, (const void*)mk_fwd, NWAVES * 64, LDS_BYTES) != hipSuccess || per_cu < 1) fprintf(stderr, "kernel_launch: occupancy query reports %d\n", per_cu);
        (void)hipGetLastError();
        if (cus < NWG) { fprintf(stderr, "kernel_launch: built for a %d-CU device (one resident workgroup per CU), this one has %d; nothing launched\n", NWG, cus); grid = -1; return; }
        grid = NWG;
    }
    if (grid < 0) return;
    if (hipMemsetAsync((char*)d_ws + WS_CTL, 0, CTL_ZERO_BYTES, stream) != hipSuccess) return;
    Args a{};
    for (int i = 0; i < 15; ++i) a.in[i] = (const float*)d_in[i];
    a.out = (float*)d_out; a.ws = (unsigned char*)d_ws;
#if MK_PER_PHASE
    for (int p = 0; p < NPHASES; ++p) { a.ph_lo = p; a.ph_hi = p + 1; hipLaunchKernelGGL(mk_fwd, dim3(grid), dim3(NWAVES * 64), LDS_BYTES, stream, a); }
#else
    a.ph_lo = 0; a.ph_hi = NPHASES; hipLaunchKernelGGL(mk_fwd, dim3(grid), dim3(NWAVES * 64), LDS_BYTES, stream, a);
#endif
}
```

```cpp
#define G1_REV 1
#define G4_REV 1
#define FP8_L0 2
#include <hip/hip_runtime.h>
#include <cstdio>
#include <cstdint>
namespace pg8 {
#define PG8_LAS __attribute__((address_space(3)))
typedef unsigned short bf16_t;
typedef short bf16x8 __attribute__((ext_vector_type(8)));
typedef float f32x4 __attribute__((ext_vector_type(4)));
typedef float f32x16 __attribute__((ext_vector_type(16)));
typedef unsigned u32x4 __attribute__((ext_vector_type(4)));
constexpr int BM = 256, BK = 64, HALF = 128, HTB = HALF * BK * 2  , STAGE_BYTES = 8 * HTB, NXCD = 8, WGM = 8;

__host__ __device__ __forceinline__ int lds_byte(int r, int c) { const int st = (r >> 4) * 2 + (c >> 5), rr = r & 15, cc = c & 31, ob = rr * 64 + cc * 2; return st * 1024 + (ob ^ (((ob >> 9) & 1) << 5)); }
__host__ __device__ __forceinline__ void stage_rc(int b, int& R, int& C) { const int st = b / 1024, sb = b % 1024, swz = sb ^ (((sb >> 9) & 1) << 5); R = (st >> 1) * 16 + swz / 64; C = (st & 1) * 32 + (swz % 64) / 2; }
__host__ __device__ __forceinline__ int perm32(int rho) { const int n = rho >> 4, i = rho & 15; return 8 * (i >> 2) + 4 * n + (i & 3); }

struct Unit { int pm, pn; };
struct Gemm { const bf16_t* A; const bf16_t* Bt; int M, N, K; };

struct StaticOrder {
    int nM, nN, nwg, G, c;
    __host__ __device__ __forceinline__ void init(int M, int N, int G_, int c_) { nM = M / BM; nN = N / BM; nwg = nM * nN; G = G_; c = c_; }
    __host__ __device__ __forceinline__ bool next(int i, Unit& u) const {
        const long L = (long)i * G + c; if (L >= nwg) return false;
        int wgid = (int)L; { const int q = nwg / NXCD, r = nwg % NXCD, xcd = wgid % NXCD, off = wgid / NXCD; wgid = (xcd < r ? xcd * (q + 1) : r * (q + 1) + (xcd - r) * q) + off; }
        const int nig = WGM * nN, gid = wgid / nig, fm = gid * WGM, gsz = (nM - fm) < WGM ? (nM - fm) : WGM;
        u.pm = fm + ((wgid % nig) % gsz); u.pn = (wgid % nig) / gsz; return true;
    }
    __device__ __forceinline__ void a_ready(const Unit&) const {}
    __device__ __forceinline__ void done(const Unit&) const {}
};

typedef float f32x2c_t __attribute__((ext_vector_type(2))); typedef __bf16 bf16x2c_t __attribute__((ext_vector_type(2)));
__device__ __forceinline__ unsigned cvt_pk_bf16(float lo, float hi) { const f32x2c_t v = {lo, hi}; const bf16x2c_t b = __builtin_convertvector(v, bf16x2c_t); return __builtin_bit_cast(unsigned, b); }
typedef float f32x2 __attribute__((ext_vector_type(2)));
__device__ __forceinline__ f32x2 gelu_pk(f32x2 v) {
    const f32x2 av = __builtin_elementwise_abs(v), d = av * 0.2316418882f + 1.0f;
    f32x2 t; t.x = __builtin_amdgcn_rcpf(d.x); t.y = __builtin_amdgcn_rcpf(d.y);
    f32x2 q = t * 0.5307027145f + (-0.7265760135f); q = q * t + 0.7107068705f; q = q * t + (-0.142248368f); q = q * t + 0.127414796f; q = q * t;
    const f32x2 s = (v * v) * (-0.72134752044f);
    f32x2 e; e.x = __builtin_amdgcn_exp2f(s.x); e.y = __builtin_amdgcn_exp2f(s.y);
    const f32x2 m = v * (q * e), r = v - m;
    f32x2 o; o.x = v.x < 0.f ? m.x : r.x; o.y = v.y < 0.f ? m.y : r.y; return o;
}

constexpr int MROWS = 16384, DM = 2048;
constexpr float RMS_EPS = 1e-6f;
__device__ __forceinline__ float shx(float v, int o, int lane) { return __builtin_bit_cast(float, __builtin_amdgcn_ds_bpermute((lane ^ o) << 2, __builtin_bit_cast(int, v))); }
__device__ __forceinline__ float sigm_f(float x) { return __builtin_amdgcn_rcpf(1.0f + __builtin_amdgcn_exp2f(x * -1.44269504089f)); }
__device__ __forceinline__ float silu_f(float x) { return x * sigm_f(x); }
__device__ __forceinline__ float bf_lo(unsigned w) { return __uint_as_float(w << 16); }
__device__ __forceinline__ float bf_hi(unsigned w) { return __uint_as_float(w & 0xffff0000u); }
__device__ __forceinline__ u32x4 pack8(const f32x4& a, const f32x4& b) { u32x4 w; w.x = cvt_pk_bf16(a[0], a[1]); w.y = cvt_pk_bf16(a[2], a[3]); w.z = cvt_pk_bf16(b[0], b[1]); w.w = cvt_pk_bf16(b[2], b[3]); return w; }
__device__ __forceinline__ float row_rstd1(const float* ss, int row, int fq) {
    const float* p = ss + (size_t)row * 32 + 8 * fq; const f32x4 a = *(const f32x4*)p, b = *(const f32x4*)(p + 4);
    float s = ((a[0] + a[1]) + (a[2] + a[3])) + ((b[0] + b[1]) + (b[2] + b[3])); { int ln; asm volatile("v_mbcnt_lo_u32_b32 %0, -1, 0\n\tv_mbcnt_hi_u32_b32 %0, -1, %0" : "=v"(ln)); s += shx(s, 16, ln); s += shx(s, 32, ln); }
    return 1.0f / sqrtf(s * (1.0f / 2048.0f) + RMS_EPS);
}

__device__ __forceinline__ void rstd_table(const float* ss, int pm0, PG8_LAS float* tab, int tid) {
    if (tid < 256) { const f32x4* p = (const f32x4*)(ss + (size_t)(pm0 * BM + tid) * 32); float s = 0.f;
#pragma unroll
        for (int i = 0; i < 8; ++i) { const f32x4 a = p[i]; s += (a[0] + a[1]) + (a[2] + a[3]); }
        tab[tid] = 1.0f / sqrtf(s * (1.0f / 2048.0f) + RMS_EPS); }
    __syncthreads();
}
#define ROW_RSTD(ss_, tab_, pm0_, u_, rl_, row_, fq_) (((u_).pm == (pm0_)) ? (tab_)[(rl_)] : row_rstd1((ss_), (row_), (fq_)))

struct EpiIn {
    static constexpr bool PERM = true, AFTER_DRAIN = false, CARRY = false;
    const float* ss;
    const float* rope;
    bf16_t* q; bf16_t* k;
    bf16_t* o2048;
    float* ls;
    const PG8_LAS float* rstab; int pm0;
    template <int ACT> __device__ __forceinline__ void emit(const f32x4 (&acc)[2][2][4][2], const Unit& u, bf16_t* base, int row0, int rl0, int col0, int slot0, int fq) const {
#pragma unroll
        for (int ai = 0; ai < 2; ++ai)
#pragma unroll
            for (int m = 0; m < 4; ++m) { const int row = row0 + ai * HALF + m * 16; const float r = ROW_RSTD(ss, rstab, pm0, u, rl0 + ai * HALF + m * 16, row, fq); bf16_t* rowp = base + (size_t)row * DM + col0; float s1 = 0.f, s2 = 0.f;
#pragma unroll
                for (int bj = 0; bj < 2; ++bj) { f32x4 v0 = acc[ai][bj][m][0] * r, v1 = acc[ai][bj][m][1] * r;
                    if (ACT == 1) {
#pragma unroll
                        for (int j = 0; j < 4; ++j) { v0[j] = silu_f(v0[j]); v1[j] = silu_f(v1[j]); } }
                    if (ACT == 2 || ACT == 3) { const f32x2 a = gelu_pk((f32x2){v0[0], v0[1]}), b = gelu_pk((f32x2){v0[2], v0[3]}), c = gelu_pk((f32x2){v1[0], v1[1]}), d = gelu_pk((f32x2){v1[2], v1[3]});
                        v0 = (f32x4){a.x, a.y, b.x, b.y}; v1 = (f32x4){c.x, c.y, d.x, d.y}; }
                    if (ACT == 4) {
#pragma unroll
                        for (int j = 0; j < 4; ++j) { v0[j] = sigm_f(v0[j]); v1[j] = sigm_f(v1[j]); } }
                    if (ACT == 3) { s1 += ((v0[0] + v0[1]) + (v0[2] + v0[3])) + ((v1[0] + v1[1]) + (v1[2] + v1[3]));
                        s2 += ((v0[0] * v0[0] + v0[1] * v0[1]) + (v0[2] * v0[2] + v0[3] * v0[3])) + ((v1[0] * v1[0] + v1[1] * v1[1]) + (v1[2] * v1[2] + v1[3] * v1[3])); }
                    *(u32x4*)(rowp + bj * HALF) = pack8(v0, v1); }
                if (ACT == 3) { const int ln = (row0 & 15) | (fq << 4); s1 += shx(s1, 16, ln); s1 += shx(s1, 32, ln); s2 += shx(s2, 16, ln); s2 += shx(s2, 32, ln);
                    if (fq == 0) *(f32x2*)(ls + ((size_t)row * 32 + slot0) * 2) = (f32x2){s1, s2}; } }
    }
    __device__ __forceinline__ void operator()(const f32x4 (&acc)[2][2][4][2], const Unit& u, int wr, int wc, int fr, int fq) const {
        const int rl0 = wr * 64 + fr, row0 = u.pm * BM + rl0, pn = u.pn;
        if (pn < 8) {
            bf16_t* base = (pn < 4) ? q : k; const int col0 = (pn & 3) * BM + wc * 32 + 8 * fq;
#pragma unroll
            for (int ai = 0; ai < 2; ++ai) { f32x4 tt[4][2];
#pragma unroll
                for (int m = 0; m < 4; ++m) { const int pos = (row0 + ai * HALF + m * 16) & 8191; const f32x4* tp = (const f32x4*)(rope + ((size_t)pos * 64 + 16 * wc + 4 * fq) * 2); tt[m][0] = tp[0]; tt[m][1] = tp[1]; }
#pragma unroll
                for (int m = 0; m < 4; ++m) { const int row = row0 + ai * HALF + m * 16; const float r = ROW_RSTD(ss, rstab, pm0, u, rl0 + ai * HALF + m * 16, row, fq);
                    const f32x4 t0 = tt[m][0], t1 = tt[m][1];
                    bf16_t* rowp = base + (size_t)row * 1024 + col0;
#pragma unroll
                    for (int bj = 0; bj < 2; ++bj) { const f32x4 v0 = acc[ai][bj][m][0] * r, v1 = acc[ai][bj][m][1] * r; f32x4 y0, y1;
                        y0[0] = v0[0] * t0[0] - v0[1] * t0[1]; y0[1] = v0[1] * t0[0] + v0[0] * t0[1]; y0[2] = v0[2] * t0[2] - v0[3] * t0[3]; y0[3] = v0[3] * t0[2] + v0[2] * t0[3];
                        y1[0] = v1[0] * t1[0] - v1[1] * t1[1]; y1[1] = v1[1] * t1[0] + v1[0] * t1[1]; y1[2] = v1[2] * t1[2] - v1[3] * t1[3]; y1[3] = v1[3] * t1[2] + v1[2] * t1[3];
                        *(u32x4*)(rowp + bj * HALF) = pack8(y0, y1); } }
                asm volatile("" ::: "memory"); }
        } else {
            const int s = (pn - 8) >> 3, tile = (pn - 8) & 7; bf16_t* base = o2048 + (size_t)s * ((size_t)MROWS * DM); const int col0 = tile * BM + wc * 32 + 8 * fq, slot0 = tile * 4 + wc;
            if (s == 0) emit<0>(acc, u, base, row0, rl0, col0, slot0, fq);
            else if (s == 1) emit<1>(acc, u, base, row0, rl0, col0, slot0, fq);
            else if (s == 2) emit<2>(acc, u, base, row0, rl0, col0, slot0, fq);
            else if (s == 3) emit<3>(acc, u, base, row0, rl0, col0, slot0, fq);
            else emit<4>(acc, u, base, row0, rl0, col0, slot0, fq);
        }
    }
};

struct EpiMerge {
    static constexpr bool PERM = true, AFTER_DRAIN = false, CARRY = true;
    const bf16_t* ga; const bf16_t* gb; bf16_t* mg;
    __device__ __forceinline__ bool carry(f32x4 (&acc)[2][2][4][2], const Unit& u, int wr, int wc, int fr, int fq) const {
        if (u.pn >= 8) return false;
        const int row0 = u.pm * BM + wr * 64 + fr, col0 = u.pn * BM + wc * 32 + 8 * fq;
        u32x4 a[2][2][2], b[2][2][2];
#define EM_LOAD(q) do { _Pragma("unroll") for (int mm = 0; mm < 2; ++mm) _Pragma("unroll") for (int bj = 0; bj < 2; ++bj) { \
            const size_t off = (size_t)(row0 + ((q) >> 1) * HALF + (2 * ((q) & 1) + mm) * 16) * DM + col0 + bj * HALF; a[(q) & 1][mm][bj] = *(const u32x4*)(ga + off); b[(q) & 1][mm][bj] = *(const u32x4*)(gb + off); } } while (0)
        EM_LOAD(0);
#pragma unroll
        for (int q = 0; q < 4; ++q) { const int ai = q >> 1, mp = q & 1;
            if (q < 3) EM_LOAD(q + 1);
            __builtin_amdgcn_sched_barrier(0);
#pragma unroll
            for (int mm = 0; mm < 2; ++mm)
#pragma unroll
                for (int bj = 0; bj < 2; ++bj) { const int m = 2 * mp + mm; const u32x4 x = a[q & 1][mm][bj], y = b[q & 1][mm][bj]; f32x4& v0 = acc[ai][bj][m][0]; f32x4& v1 = acc[ai][bj][m][1];
                    v0[0] *= bf_lo(x.x) * __builtin_amdgcn_rcpf(fmaxf(bf_lo(y.x), 1e-20f)); v0[1] *= bf_hi(x.x) * __builtin_amdgcn_rcpf(fmaxf(bf_hi(y.x), 1e-20f));
                    v0[2] *= bf_lo(x.y) * __builtin_amdgcn_rcpf(fmaxf(bf_lo(y.y), 1e-20f)); v0[3] *= bf_hi(x.y) * __builtin_amdgcn_rcpf(fmaxf(bf_hi(y.y), 1e-20f));
                    v1[0] *= bf_lo(x.z) * __builtin_amdgcn_rcpf(fmaxf(bf_lo(y.z), 1e-20f)); v1[1] *= bf_hi(x.z) * __builtin_amdgcn_rcpf(fmaxf(bf_hi(y.z), 1e-20f));
                    v1[2] *= bf_lo(x.w) * __builtin_amdgcn_rcpf(fmaxf(bf_lo(y.w), 1e-20f)); v1[3] *= bf_hi(x.w) * __builtin_amdgcn_rcpf(fmaxf(bf_hi(y.w), 1e-20f)); }
            __builtin_amdgcn_sched_barrier(0); }
#undef EM_LOAD
        return true;
    }
    __device__ __forceinline__ void operator()(const f32x4 (&acc)[2][2][4][2], const Unit& u, int wr, int wc, int fr, int fq) const {
        const int pm = u.pm & 63, pn = u.pn & 7;
        typedef __attribute__((address_space(1))) unsigned char gchar;
        const size_t tile = ((size_t)(pm * BM + wr * 64) * DM + (size_t)(pn * BM + wc * 32)) * 2;
        const gchar* gbase = (const gchar*)gb + tile; gchar* mbase = (gchar*)mg + tile;
        const unsigned voff = (unsigned)((fr * DM + 8 * fq) * 2);
        u32x4 g8[2][4][2];
#pragma unroll
        for (int ai = 0; ai < 2; ++ai)
#pragma unroll
            for (int m = 0; m < 4; ++m)
#pragma unroll
                for (int bj = 0; bj < 2; ++bj) g8[ai][m][bj] = *(const __attribute__((address_space(1))) u32x4*)(gbase + (size_t)(((ai * HALF + m * 16) * DM + bj * HALF) * 2) + voff);
        __builtin_amdgcn_sched_barrier(0);
#pragma unroll
        for (int ai = 0; ai < 2; ++ai) {
#pragma unroll
            for (int m = 0; m < 4; ++m) {
#pragma unroll
                for (int bj = 0; bj < 2; ++bj) { const u32x4 g = g8[ai][m][bj]; f32x4 v0 = acc[ai][bj][m][0], v1 = acc[ai][bj][m][1];
                    v0[0] *= fmaxf(bf_lo(g.x), 1e-20f); v0[1] *= fmaxf(bf_hi(g.x), 1e-20f); v0[2] *= fmaxf(bf_lo(g.y), 1e-20f); v0[3] *= fmaxf(bf_hi(g.y), 1e-20f);
                    v1[0] *= fmaxf(bf_lo(g.z), 1e-20f); v1[1] *= fmaxf(bf_hi(g.z), 1e-20f); v1[2] *= fmaxf(bf_lo(g.w), 1e-20f); v1[3] *= fmaxf(bf_hi(g.w), 1e-20f);
                    *(__attribute__((address_space(1))) u32x4*)(mbase + (size_t)(((ai * HALF + m * 16) * DM + bj * HALF) * 2) + voff) = pack8(v0, v1); } }
            asm volatile("" ::: "memory"); }
    }
};
struct RevOrder {
    StaticOrder base;
    __device__ __forceinline__ bool next(int i, Unit& u) const { if (!base.next(i, u)) return false; u.pn = base.nN - 1 - u.pn; return true; }
    __device__ __forceinline__ void a_ready(const Unit&) const {}
    __device__ __forceinline__ void done(const Unit&) const {}
};
struct PairOrder {
    StaticOrder base;
    __device__ __forceinline__ bool next(int i, Unit& u) const { if (!base.next(i >> 1, u)) return false; if (i & 1) { u.pm += 64; u.pn += 8; } return true; }
    __device__ __forceinline__ void a_ready(const Unit&) const {}
    __device__ __forceinline__ void done(const Unit&) const {}
};

struct EpiResid {
    static constexpr bool PERM = true, AFTER_DRAIN = false, CARRY = false;
    bf16_t* xb; float* ssout; float scale;
    __device__ __forceinline__ void operator()(const f32x4 (&acc)[2][2][4][2], const Unit& u, int wr, int wc, int fr, int fq) const {
        const int row0 = u.pm * BM + wr * 64 + fr;
        typedef __attribute__((address_space(1))) unsigned char gchar;
        gchar* base = (gchar*)xb + ((size_t)(u.pm * BM + wr * 64) * DM + (size_t)(u.pn * BM + wc * 32)) * 2;
        const unsigned voff = (unsigned)((fr * DM + 8 * fq) * 2);
        u32x4 xo[2][4][2];
#pragma unroll
        for (int ai = 0; ai < 2; ++ai)
#pragma unroll
            for (int m = 0; m < 4; ++m)
#pragma unroll
                for (int bj = 0; bj < 2; ++bj) xo[ai][m][bj] = *(const __attribute__((address_space(1))) u32x4*)(base + (size_t)(((ai * HALF + m * 16) * DM + bj * HALF) * 2) + voff);
        __builtin_amdgcn_sched_barrier(0);
#pragma unroll
        for (int ai = 0; ai < 2; ++ai) {
#pragma unroll
            for (int m = 0; m < 4; ++m) { const int row = row0 + ai * HALF + m * 16; float s2 = 0.f;
#pragma unroll
                for (int bj = 0; bj < 2; ++bj) { const u32x4 g = xo[ai][m][bj]; f32x4 a0 = acc[ai][bj][m][0] * scale, a1 = acc[ai][bj][m][1] * scale;
                    a0[0] += bf_lo(g.x); a0[1] += bf_hi(g.x); a0[2] += bf_lo(g.y); a0[3] += bf_hi(g.y); a1[0] += bf_lo(g.z); a1[1] += bf_hi(g.z); a1[2] += bf_lo(g.w); a1[3] += bf_hi(g.w);
                    s2 += ((a0[0] * a0[0] + a0[1] * a0[1]) + (a0[2] * a0[2] + a0[3] * a0[3])) + ((a1[0] * a1[0] + a1[1] * a1[1]) + (a1[2] * a1[2] + a1[3] * a1[3]));
                    *(__attribute__((address_space(1))) u32x4*)(base + (size_t)(((ai * HALF + m * 16) * DM + bj * HALF) * 2) + voff) = pack8(a0, a1); }
                { const int ln = fr | (fq << 4); s2 += shx(s2, 16, ln); s2 += shx(s2, 32, ln); }
                if (fq == 0) ssout[(size_t)row * 32 + u.pn * 4 + wc] = s2; }
            asm volatile("" ::: "memory"); }
    }
};

struct EpiSwiglu {
    static constexpr bool PERM = true, AFTER_DRAIN = false, CARRY = false;
    const float* ss; bf16_t* h; const PG8_LAS float* rstab; int pm0;
    __device__ __forceinline__ void operator()(const f32x4 (&acc)[2][2][4][2], const Unit& u, int wr, int wc, int fr, int fq) const {
        const int rl0 = wr * 64 + fr, row0 = u.pm * BM + rl0, col0 = u.pn * HALF + wc * 32 + 8 * fq;
#pragma unroll
        for (int ai = 0; ai < 2; ++ai)
#pragma unroll
            for (int m = 0; m < 4; ++m) { const float r = ROW_RSTD(ss, rstab, pm0, u, rl0 + ai * HALF + m * 16, row0 + ai * HALF + m * 16, fq); f32x4 a0 = acc[ai][0][m][0] * r, a1 = acc[ai][0][m][1] * r; const f32x4 c0 = acc[ai][1][m][0] * r, c1 = acc[ai][1][m][1] * r;
#pragma unroll
                for (int j = 0; j < 4; ++j) { a0[j] = silu_f(a0[j]) * c0[j]; a1[j] = silu_f(a1[j]) * c1[j]; }
                *(u32x4*)(h + (size_t)(row0 + ai * HALF + m * 16) * 5632 + col0) = pack8(a0, a1); }
    }
};

struct EpiSwiglu8 {
    static constexpr bool PERM = true, AFTER_DRAIN = false, CARRY = false;
    const float* ss; unsigned char* h8; const PG8_LAS float* rstab; int pm0;
    __device__ __forceinline__ void operator()(const f32x4 (&acc)[2][2][4][2], const Unit& u, int wr, int wc, int fr, int fq) const {
        const int rl0 = wr * 64 + fr, row0 = u.pm * BM + rl0, col0 = u.pn * HALF + wc * 32 + 8 * fq;
#pragma unroll
        for (int ai = 0; ai < 2; ++ai)
#pragma unroll
            for (int m = 0; m < 4; ++m) { const float r = ROW_RSTD(ss, rstab, pm0, u, rl0 + ai * HALF + m * 16, row0 + ai * HALF + m * 16, fq); f32x4 a0 = acc[ai][0][m][0] * r, a1 = acc[ai][0][m][1] * r; const f32x4 c0 = acc[ai][1][m][0] * (r * 8.0f), c1 = acc[ai][1][m][1] * (r * 8.0f);
#pragma unroll
                for (int j = 0; j < 4; ++j) { a0[j] = silu_f(a0[j]) * c0[j]; a1[j] = silu_f(a1[j]) * c1[j]; }
                int w0 = __builtin_amdgcn_cvt_pk_fp8_f32(a0[0], a0[1], 0, false); w0 = __builtin_amdgcn_cvt_pk_fp8_f32(a0[2], a0[3], w0, true);
                int w1 = __builtin_amdgcn_cvt_pk_fp8_f32(a1[0], a1[1], 0, false); w1 = __builtin_amdgcn_cvt_pk_fp8_f32(a1[2], a1[3], w1, true);
                typedef unsigned u32x2_ __attribute__((ext_vector_type(2))); u32x2_ o; o.x = (unsigned)w0; o.y = (unsigned)w1;
                *(u32x2_*)(h8 + (size_t)(row0 + ai * HALF + m * 16) * 5632 + col0) = o; }
    }
};

struct EpiNull {
    static constexpr bool PERM = true, AFTER_DRAIN = false, CARRY = false;
    float* sink;
    __device__ __forceinline__ void operator()(const f32x4 (&acc)[2][2][4][2], const Unit& u, int wr, int wc, int fr, int fq) const {
        float s = 0.f;
#pragma unroll
        for (int ai = 0; ai < 2; ++ai)
#pragma unroll
            for (int bj = 0; bj < 2; ++bj)
#pragma unroll
                for (int m = 0; m < 4; ++m)
#pragma unroll
                    for (int n = 0; n < 2; ++n) s += (acc[ai][bj][m][n][0] + acc[ai][bj][m][n][1]) + (acc[ai][bj][m][n][2] + acc[ai][bj][m][n][3]);
        if (s == 123456.789f) sink[u.pm * 64 + u.pn] = s;
    }
};

struct SameTileOrder {
    int nunits;
    __device__ __forceinline__ bool next(int i, Unit& u) const { if (i >= nunits) return false; u.pm = 0; u.pn = 0; return true; }
    __device__ __forceinline__ void a_ready(const Unit&) const {}
    __device__ __forceinline__ void done(const Unit&) const {}
};
typedef int pg8_v4i __attribute__((ext_vector_type(4))); typedef int pg8_v8i __attribute__((ext_vector_type(8)));
__device__ __forceinline__ pg8_v8i pg8_cat8(const bf16x8& lo, const bf16x8& hi) { return __builtin_shufflevector(__builtin_bit_cast(pg8_v4i, lo), __builtin_bit_cast(pg8_v4i, hi), 0, 1, 2, 3, 4, 5, 6, 7); }
template <class Epi, class Sched, bool ALIGN_EPI = false, bool SP2 = false, bool MM32 = false, bool FP8 = false>
__device__ __forceinline__ void gemm_phase(PG8_LAS unsigned char* lds, const Gemm g, const Sched& S, const Epi& E, const int tid_in) {
    const int tid = tid_in, wid = __builtin_amdgcn_readfirstlane(tid >> 6), lane = tid & 63, wr = wid >> 2, wc = wid & 3, fr = lane & 15, fq = lane >> 4;
    const int K = g.K, nt = K / BK;
    unsigned voffA[2], voffB[2];
#pragma unroll
    for (int i = 0; i < 2; ++i) { int R, C; stage_rc(tid * 16 + i * 8192, R, C); const int Rb = Epi::PERM ? ((R & ~31) + perm32(R & 31)) : R;
        voffA[i] = (unsigned)(R * K + C) * 2u; voffB[i] = (unsigned)(Rb * K + C) * 2u; }
    const size_t kstep = (size_t)(BK * 2);
    const size_t hstep = (size_t)HALF * K * 2;
    const size_t tstep = 2 * hstep;
    const unsigned ldsw = (unsigned)wid * 1024u; const unsigned ldsu = (unsigned)(unsigned long)lds + ldsw;
    const int aoff = lds_byte(wr * 64 + fr, fq * 8), boff = lds_byte(wc * 32 + fr, fq * 8);
#ifndef PG8_DMA_AUX
#define PG8_DMA_AUX 0
#endif
#define PG8_SA(b, h) (((b) * 2 + (h)) * HTB)
#define PG8_SB(b, h) ((4 + (b) * 2 + (h)) * HTB)
#define PG8_STAGE(bufoff, gbase, voff) do { _Pragma("unroll") for (int _i = 0; _i < 2; ++_i) \
        asm volatile("s_mov_b32 m0, %0\n\ts_nop 0\n\tglobal_load_lds_dwordx4 %1, %2" :: "s"(ldsu + (unsigned)((bufoff) + _i * 8192)), "v"((voff)[_i]), "s"((unsigned long long)(gbase)) : "m0", "memory"); } while (0)
#define PG8_LDA(dst, b, h) do { _Pragma("unroll") for (int m = 0; m < 4; ++m) _Pragma("unroll") for (int k = 0; k < 2; ++k) dst[m][k] = *(const PG8_LAS bf16x8*)(lds + PG8_SA(b, h) + aoff + m * 2048 + k * 1024); } while (0)
#define PG8_LDB(dst, b, h) do { _Pragma("unroll") for (int n = 0; n < 2; ++n) _Pragma("unroll") for (int k = 0; k < 2; ++k) dst[n][k] = *(const PG8_LAS bf16x8*)(lds + PG8_SB(b, h) + boff + n * 2048 + k * 1024); } while (0)
#define PG8_MMA(ai, bj, At, Bt) do { __builtin_amdgcn_s_setprio(1); if constexpr (MM32) { _Pragma("unroll") for (int j = 0; j < 4; ++j) _Pragma("unroll") for (int p = 0; p < 2; ++p) \
        acc16[ai][bj][p] = __builtin_amdgcn_mfma_f32_32x32x16_bf16(Bt[p][j & 1], At[j][j >> 1], acc16[ai][bj][p], 0, 0, 0); } else if constexpr (FP8) { \
        _Pragma("unroll") for (int m = 0; m < 4; ++m) _Pragma("unroll") for (int n = 0; n < 2; ++n) \
        acc[ai][bj][m][n] = __builtin_amdgcn_mfma_scale_f32_16x16x128_f8f6f4(pg8_cat8(Bt[n][0], Bt[n][1]), pg8_cat8(At[m][0], At[m][1]), acc[ai][bj][m][n], 0, 0, 0, 0x7f7f7f7f, 0, 0x7f7f7f7f); } else { \
        _Pragma("unroll") for (int m = 0; m < 4; ++m) _Pragma("unroll") for (int n = 0; n < 2; ++n) _Pragma("unroll") for (int k = 0; k < 2; ++k) \
        acc[ai][bj][m][n] = __builtin_amdgcn_mfma_f32_16x16x32_bf16(Bt[n][k], At[m][k], acc[ai][bj][m][n], 0, 0, 0); } __builtin_amdgcn_s_setprio(0); } while (0)
#define PG8_WAIT_V(n) asm volatile("s_waitcnt vmcnt(" #n ")" ::: "memory")
#define PG8_WAIT_L(n) asm volatile("s_waitcnt lgkmcnt(" #n ")" ::: "memory")
#define PG8_BAR __builtin_amdgcn_s_barrier()
#define PG8_SCHED __builtin_amdgcn_sched_barrier(0)
    Unit cur, nxt; int ui = 0;
    if (!S.next(0, cur)) return;
    f32x4 acc[2][2][4][2];
#pragma unroll
    for (int a = 0; a < 2; ++a)
#pragma unroll
        for (int b = 0; b < 2; ++b)
#pragma unroll
            for (int m = 0; m < 4; ++m)
#pragma unroll
                for (int n = 0; n < 2; ++n) acc[a][b][m][n] = (f32x4){0.f, 0.f, 0.f, 0.f};
    f32x16 acc16[2][2][2];
    if constexpr (MM32) {
#pragma unroll
        for (int a = 0; a < 2; ++a)
#pragma unroll
            for (int b = 0; b < 2; ++b)
#pragma unroll
                for (int p = 0; p < 2; ++p)
#pragma unroll
                    for (int e = 0; e < 16; ++e) acc16[a][b][p][e] = 0.f;
    }
    bf16x8 At[4][2], B0[2][2], B1[2][2];
    const char* cA = (const char*)g.A + (size_t)cur.pm * tstep; const char* cB = (const char*)g.Bt + (size_t)cur.pn * tstep;
    S.a_ready(cur);
    if constexpr (SP2) {
        PG8_STAGE(PG8_SB(0, 0), cB, voffB); PG8_STAGE(PG8_SB(0, 1), cB + hstep, voffB); PG8_STAGE(PG8_SA(0, 0), cA, voffA); PG8_STAGE(PG8_SA(0, 1), cA + hstep, voffA);
        if (wr == 1) PG8_BAR;
        PG8_WAIT_V(2); PG8_BAR;
        PG8_STAGE(PG8_SB(1, 0), cB + kstep, voffB); PG8_STAGE(PG8_SA(1, 0), cA + kstep, voffA); PG8_STAGE(PG8_SB(1, 1), cB + hstep + kstep, voffB);
        PG8_WAIT_V(6); PG8_BAR;
    } else {
        PG8_STAGE(PG8_SB(0, 0), cB, voffB); PG8_STAGE(PG8_SA(0, 0), cA, voffA); PG8_STAGE(PG8_SB(0, 1), cB + hstep, voffB); PG8_STAGE(PG8_SA(0, 1), cA + hstep, voffA);
        if (wr == 1) PG8_BAR;
        PG8_WAIT_V(4); PG8_BAR;
        PG8_STAGE(PG8_SB(1, 0), cB + kstep, voffB); PG8_STAGE(PG8_SA(1, 0), cA + kstep, voffA); PG8_STAGE(PG8_SB(1, 1), cB + hstep + kstep, voffB);
        PG8_WAIT_V(6); PG8_BAR;
    }
    for (;;) {
        const bool has_next = S.next(ui + 1, nxt);
        const char* nA = has_next ? (const char*)g.A + (size_t)nxt.pm * tstep : cA; const char* nB = has_next ? (const char*)g.Bt + (size_t)nxt.pn * tstep : cB;
        for (int t = 0; t < nt; t += 2) {
            const bool last = (t == nt - 2);
            const char* a1 = cA + (size_t)(t + 1) * kstep;
            const char* a2 = last ? nA : cA + (size_t)(t + 2) * kstep; const char* b2 = last ? nB : cB + (size_t)(t + 2) * kstep;
            const char* a3 = a2 + kstep; const char* b3 = b2 + kstep;
            if (last && has_next) S.a_ready(nxt);
            if constexpr (SP2) {
            PG8_LDB(B0, 0, 0); PG8_LDB(B1, 0, 1); PG8_SCHED; PG8_LDA(At, 0, 0); PG8_STAGE(PG8_SA(1, 1), a1 + hstep, voffA);
            PG8_WAIT_V(8); PG8_WAIT_L(0); PG8_BAR; PG8_MMA(0, 0, At, B0); PG8_MMA(0, 1, At, B1); PG8_BAR; PG8_SCHED;
            PG8_LDA(At, 0, 1); PG8_STAGE(PG8_SB(0, 0), b2, voffB); PG8_STAGE(PG8_SB(0, 1), b2 + hstep, voffB); PG8_STAGE(PG8_SA(0, 0), a2, voffA);
            PG8_WAIT_V(8); PG8_WAIT_L(0); PG8_BAR; PG8_MMA(1, 0, At, B0); PG8_MMA(1, 1, At, B1); PG8_BAR; PG8_SCHED;
            PG8_LDB(B0, 1, 0); PG8_LDB(B1, 1, 1); PG8_SCHED; PG8_LDA(At, 1, 0); PG8_STAGE(PG8_SA(0, 1), a2 + hstep, voffA);
            PG8_WAIT_V(8); PG8_WAIT_L(0); PG8_BAR; PG8_MMA(0, 0, At, B0); PG8_MMA(0, 1, At, B1); PG8_BAR; PG8_SCHED;
            PG8_LDA(At, 1, 1); PG8_STAGE(PG8_SB(1, 0), b3, voffB); PG8_STAGE(PG8_SB(1, 1), b3 + hstep, voffB); PG8_STAGE(PG8_SA(1, 0), a3, voffA);
            PG8_WAIT_V(8); PG8_WAIT_L(0); PG8_BAR; PG8_MMA(1, 0, At, B0); PG8_MMA(1, 1, At, B1); PG8_BAR; PG8_SCHED;
            } else {
            PG8_LDB(B0, 0, 0); PG8_SCHED; PG8_LDA(At, 0, 0); PG8_STAGE(PG8_SA(1, 1), a1 + hstep, voffA);
            PG8_WAIT_L(8); PG8_BAR; PG8_WAIT_L(0); PG8_MMA(0, 0, At, B0); PG8_BAR; PG8_SCHED;
            PG8_LDB(B1, 0, 1); PG8_STAGE(PG8_SB(0, 0), b2, voffB);
            PG8_BAR; PG8_WAIT_L(0); PG8_MMA(0, 1, At, B1); PG8_BAR;
            PG8_LDA(At, 0, 1); PG8_STAGE(PG8_SA(0, 0), a2, voffA);
            PG8_BAR; PG8_WAIT_L(0); PG8_MMA(1, 0, At, B0); PG8_BAR; PG8_SCHED;
            PG8_STAGE(PG8_SB(0, 1), b2 + hstep, voffB);
            PG8_WAIT_V(6); PG8_BAR; PG8_MMA(1, 1, At, B1); PG8_BAR;
            PG8_LDB(B0, 1, 0); PG8_SCHED; PG8_LDA(At, 1, 0); PG8_STAGE(PG8_SA(0, 1), a2 + hstep, voffA);
            PG8_WAIT_L(8); PG8_BAR; PG8_WAIT_L(0); PG8_MMA(0, 0, At, B0); PG8_BAR; PG8_SCHED;
            PG8_LDB(B1, 1, 1); PG8_STAGE(PG8_SB(1, 0), b3, voffB);
            PG8_BAR; PG8_WAIT_L(0); PG8_MMA(0, 1, At, B1); PG8_BAR;
            PG8_LDA(At, 1, 1); PG8_STAGE(PG8_SA(1, 0), a3, voffA);
            PG8_BAR; PG8_WAIT_L(0); PG8_MMA(1, 0, At, B0); PG8_BAR; PG8_SCHED;
            PG8_STAGE(PG8_SB(1, 1), b3 + hstep, voffB);
            PG8_WAIT_V(6); PG8_BAR; PG8_MMA(1, 1, At, B1); PG8_BAR;
            }
        }
        if constexpr (ALIGN_EPI) { if (wr == 0) PG8_BAR; }
        if constexpr (MM32) {
#pragma unroll
            for (int a = 0; a < 2; ++a)
#pragma unroll
                for (int b = 0; b < 2; ++b)
#pragma unroll
                    for (int m = 0; m < 4; ++m)
#pragma unroll
                        for (int n = 0; n < 2; ++n)
#pragma unroll
                            for (int e = 0; e < 4; ++e) acc[a][b][m][n][e] = acc16[a][b][m >> 1][(m & 1) * 8 + n * 4 + e];
        }
        bool keep = false;
        int tl_ = tid; asm volatile("" : "+v"(tl_)); const int fr_e = tl_ & 15, fq_e = (tl_ >> 4) & 3;
        if constexpr (!Epi::AFTER_DRAIN) { if constexpr (Epi::CARRY) keep = E.carry(acc, cur, wr, wc, fr_e, fq_e); if (!keep) E(acc, cur, wr, wc, fr_e, fq_e); S.done(cur); }
        if (!has_next) break;
        if (!keep)
#pragma unroll
        for (int a = 0; a < 2; ++a)
#pragma unroll
            for (int b = 0; b < 2; ++b)
#pragma unroll
                for (int m = 0; m < 4; ++m)
#pragma unroll
                    for (int n = 0; n < 2; ++n) acc[a][b][m][n] = (f32x4){0.f, 0.f, 0.f, 0.f};
        cur = nxt; cA = nA; cB = nB; ++ui;
        if constexpr (ALIGN_EPI) { if (wr == 1) PG8_BAR; }
    }
    PG8_WAIT_V(0);
    if constexpr (!ALIGN_EPI) { if (wr == 0) PG8_BAR; }
    PG8_BAR;
    if constexpr (Epi::AFTER_DRAIN) { E.fused(acc, cur, wr, wc, fr, fq, lds, wid, lane); S.done(cur); }
#undef PG8_SA
#undef PG8_SB
#undef PG8_STAGE
#undef PG8_LDA
#undef PG8_LDB
#undef PG8_MMA
#undef PG8_WAIT_V
#undef PG8_WAIT_L
#undef PG8_BAR
#undef PG8_SCHED
}
}

#ifndef MK_PER_PHASE
#define MK_PER_PHASE 0
#endif
constexpr int NWAVES = 8;
constexpr int NWG = 256;
constexpr int BATCH = 2, T = 8192, D = 2048, M = BATCH * T, DEPTH = 4;
constexpr int NIN = 14336, DFF = 5632, NFF = 2 * DFF;
constexpr float EPS = 1e-6f;
static_assert(M == pg8::MROWS && D == pg8::DM, "shapes");

constexpr size_t MiB = 1u << 20;
constexpr size_t WS_CTL = 0, CTL_ZERO_BYTES = 1 * MiB;
constexpr size_t WS_ROPE = 1 * MiB;
constexpr size_t WS_SS = 5 * MiB, WS_SS2 = 7 * MiB;
constexpr size_t WS_LS = 9 * MiB;
constexpr size_t WS_W = 16 * MiB, W_LAYER = 146 * MiB;
constexpr size_t W_IN = 0, W_R = 56 * MiB, W_S = 64 * MiB, W_O = 72 * MiB, W_F1 = 80 * MiB, W_F2 = 124 * MiB;
static_assert((size_t)NIN * D * 2 == 56 * MiB && (size_t)NFF * D * 2 == 44 * MiB && (size_t)D * DFF * 2 == 22 * MiB, "weight map");
constexpr size_t WS_X = 600 * MiB;
constexpr size_t WS_XB = 728 * MiB;
constexpr size_t WS_Q = 792 * MiB, WS_K = 824 * MiB;
constexpr size_t WS_O2048 = 856 * MiB;
constexpr size_t WS_V = WS_O2048, WS_SG = WS_V + 64 * MiB, WS_ZU = WS_SG + 64 * MiB, WS_ZV = WS_ZU + 64 * MiB, WS_GA = WS_ZV + 64 * MiB, WS_GB = WS_GA + 64 * MiB;
constexpr size_t WS_RA = 1240 * MiB, WS_SB = 1304 * MiB;
constexpr size_t WS_P = 1368 * MiB, WS_MG = 1432 * MiB;
constexpr size_t WS_SLOC = 1496 * MiB;
constexpr size_t WS_END = 1528 * MiB;
constexpr size_t WS_H = WS_Q;
static_assert(WS_W + DEPTH * W_LAYER <= WS_X && WS_GB + 64 * MiB == WS_RA && WS_SB == WS_RA + 64 * MiB && WS_H + (size_t)M * DFF * 2 <= WS_ZU, "d_ws map");
constexpr int CW_TMO = 0, CW_CODE = 1, CW_BAR = 4096;

constexpr int RING_OFF = 0, RING_BYTES = 131072;
constexpr int LDSCTL_OFF = RING_BYTES, MISC_OFF = LDSCTL_OFF + 320, RSTAB_OFF = LDSCTL_OFF + 1024;
constexpr int LDS_BYTES = 147456;
constexpr int R_Q = 0, R_K = 17408, R_KS = 34816, R_V = 52224, R_P = 86016, R_RED = 95232, R_END = 99328;
constexpr int PQ = 272, PV = 528, PP = 144;
constexpr int R1_KS = 0, R1_V = 17408, R1_BUF = 51200;
static_assert(2 * R1_BUF <= RING_BYTES, "LDS map");
constexpr int S_W = 0, S_VN = 34816, S_ST = 102400, S_END = 104448;
static_assert(R_END <= RING_BYTES && S_END <= RING_BYTES, "LDS map");

#define GAS __attribute__((address_space(1)))
#define LAS __attribute__((address_space(3)))
typedef unsigned short bf16;
typedef unsigned v4u __attribute__((ext_vector_type(4)));
typedef unsigned v2u __attribute__((ext_vector_type(2)));
typedef float f32x4 __attribute__((ext_vector_type(4)));
typedef float f32x2 __attribute__((ext_vector_type(2)));
typedef short bf16x8 __attribute__((ext_vector_type(8)));
typedef short s16x4 __attribute__((ext_vector_type(4)));
typedef GAS unsigned gu32;
#define RLX_AGENT __ATOMIC_RELAXED, __HIP_MEMORY_SCOPE_AGENT
#define LDS_WAIT() asm volatile("s_waitcnt lgkmcnt(0)" ::: "memory")
#define VM_WAIT() asm volatile("s_waitcnt vmcnt(0)" ::: "memory")
__device__ __forceinline__ unsigned f2bf(float f) { unsigned u = __builtin_bit_cast(unsigned, f); return (u + 0x7fffu + ((u >> 16) & 1u)) >> 16; }
__device__ __forceinline__ unsigned pk2(float lo, float hi) { typedef float f2_ __attribute__((ext_vector_type(2))); typedef __bf16 b2_ __attribute__((ext_vector_type(2))); const f2_ v = {lo, hi}; return __builtin_bit_cast(unsigned, __builtin_convertvector(v, b2_)); }
__device__ __forceinline__ float blo(unsigned w) { return __uint_as_float(w << 16); }
__device__ __forceinline__ float bhi(unsigned w) { return __uint_as_float(w & 0xffff0000u); }
__device__ __forceinline__ float ex2(float x) { return __builtin_amdgcn_exp2f(x); }
__device__ __forceinline__ float l2gamma(int h) {
    const float t0 = (h & 1) ? -0.02272007650008353f : -0.04580368961312479f, t1 = (h & 1) ? -0.005646563141142063f : -0.011315313227834146f;
    const float t2 = (h & 1) ? -0.0014095702546713536f : -0.0028205190623786626f, t3 = (h & 1) ? -0.0003522634716290214f : -0.0007046129765893727f;
    const float a = (h & 2) ? t1 : t0, b = (h & 2) ? t3 : t2; return (h & 4) ? b : a; }
#define MFMA16(a, b, c) __builtin_amdgcn_mfma_f32_16x16x32_bf16((a), (b), (c), 0, 0, 0)

#define XB_TMO      128
#define XB_XCNT(j)  (256  + 64 * (j))
#define XB_XSUB(j)  (1280 + 64 * (j))
#define XB_XGEN(j)  (2304 + 64 * (j))
#define XB_TOP      3328
#define XB_TOPGEN   3392
#define XCD_BAR_WORDS 3456
#define XB_SPIN_CAP (1u << 18)

__device__ __forceinline__ unsigned xb_ld(unsigned* p)              { return __hip_atomic_load(p, __ATOMIC_RELAXED, __HIP_MEMORY_SCOPE_AGENT); }
__device__ __forceinline__ unsigned xb_add(unsigned* p, unsigned v) { return __hip_atomic_fetch_add(p, v, __ATOMIC_RELAXED, __HIP_MEMORY_SCOPE_AGENT); }
__device__ __forceinline__ unsigned xb_xcc_id() { return (unsigned)__builtin_amdgcn_s_getreg((3 << 11) | 20) & 0xFu; }
#define XB_SPIN(cond, bar) do { unsigned _sp = 0; while (cond) { __builtin_amdgcn_s_sleep(1); \
    if ((++_sp & 255u) == 0u) { if (xb_ld(&(bar)[XB_TMO])) break; if (_sp > XB_SPIN_CAP) { atomicAdd(&(bar)[XB_TMO], 1u); break; } } } } while (0)

struct XcdBarrier {
    unsigned* bar; unsigned x;
    volatile LAS unsigned* st;
};

__device__ __forceinline__ XcdBarrier xcd_barrier_post(unsigned* bar, volatile LAS unsigned* st) {
    XcdBarrier b; b.bar = bar; b.x = xb_xcc_id(); b.st = st;
    if (threadIdx.x == 0) (void)xb_add(&bar[XB_XCNT(b.x)], 1u);
    return b;
}
__device__ __forceinline__ void xcd_barrier_complete(unsigned* bar, unsigned x, unsigned& nloc, unsigned& nx) {
    const unsigned G = gridDim.x * gridDim.y * gridDim.z;
    unsigned sum, cnt, mine, sp = 0u;
    for (;;) {
        sum = 0u; cnt = 0u; mine = 0u;
#pragma unroll
        for (unsigned j = 0; j < 16; ++j) { const unsigned c = xb_ld(&bar[XB_XCNT(j)]); sum += c; cnt += (c > 0u) ? 1u : 0u; mine = (j == x) ? c : mine; }
        if (sum == G) break;
        __builtin_amdgcn_s_sleep(1);
        if ((++sp & 255u) == 0u) { if (xb_ld(&bar[XB_TMO])) break; if (sp > XB_SPIN_CAP) { atomicAdd(&bar[XB_TMO], 1u); break; } }
    }
    nloc = mine > 0u ? mine : 1u; nx = cnt > 0u ? cnt : 1u;
}

__device__ __forceinline__ void xcd_barrier(const XcdBarrier& b) {
    asm volatile("s_waitcnt vmcnt(0)" ::: "memory");
    __syncthreads();
    if (threadIdx.x == 0) {
        unsigned* bar = b.bar;
        __builtin_amdgcn_s_waitcnt(0);
        unsigned nloc = b.st[0], nx = b.st[1];
        if (nloc == 0u) { xcd_barrier_complete(bar, b.x, nloc, nx); b.st[0] = nloc; b.st[1] = nx; }
        const unsigned old = xb_add(&bar[XB_XSUB(b.x)], 1u);
        const unsigned gen = old / nloc;
        if (old + 1u == (gen + 1u) * nloc) {
            __builtin_amdgcn_fence(__ATOMIC_RELEASE, "agent");
            asm volatile("s_waitcnt vmcnt(0)" ::: "memory");
            const unsigned og = xb_add(&bar[XB_TOP], 1u);
            const unsigned tg = og / nx;
            if (og + 1u == (tg + 1u) * nx) xb_add(&bar[XB_TOPGEN], 1u);
            else XB_SPIN(xb_ld(&bar[XB_TOPGEN]) == tg, bar);
            __builtin_amdgcn_fence(__ATOMIC_ACQUIRE, "agent");
            xb_add(&bar[XB_XGEN(b.x)], 1u);
            asm volatile("s_waitcnt vmcnt(0)" ::: "memory");
        } else {
            XB_SPIN(xb_ld(&bar[XB_XGEN(b.x)]) == gen, bar);
            __builtin_amdgcn_fence(__ATOMIC_ACQUIRE, "agent");
            asm volatile("s_waitcnt vmcnt(0)" ::: "memory");
        }
    }
    __syncthreads();
}

struct Frame;
__device__ __forceinline__ bool conv_work_one(Frame& F, int max_layer);
__device__ __forceinline__ void xcd_barrier_idle(const XcdBarrier& b, Frame& F, const int tid_) {
    asm volatile("s_waitcnt vmcnt(0)" ::: "memory");
    __syncthreads();
    if (tid_ == 0) {
        unsigned* bar = b.bar;
        __builtin_amdgcn_s_waitcnt(0);
        unsigned nloc = b.st[0], nx = b.st[1];
        if (nloc == 0u) { xcd_barrier_complete(bar, b.x, nloc, nx); b.st[0] = nloc; b.st[1] = nx; }
        const unsigned old = xb_add(&bar[XB_XSUB(b.x)], 1u);
        const unsigned gen = old / nloc;
        if (old + 1u == (gen + 1u) * nloc) {
            __builtin_amdgcn_fence(__ATOMIC_RELEASE, "agent");
            asm volatile("s_waitcnt vmcnt(0)" ::: "memory");
            const unsigned og = xb_add(&bar[XB_TOP], 1u);
            const unsigned tg = og / nx;
            if (og + 1u == (tg + 1u) * nx) xb_add(&bar[XB_TOPGEN], 1u);
            else XB_SPIN(xb_ld(&bar[XB_TOPGEN]) == tg, bar);
            __builtin_amdgcn_fence(__ATOMIC_ACQUIRE, "agent");
            xb_add(&bar[XB_XGEN(b.x)], 1u);
            asm volatile("s_waitcnt vmcnt(0)" ::: "memory");
            b.st[2] = 0u;
        } else { b.st[2] = 1u; b.st[3] = gen;
#if defined(PRE_WB)
            { const unsigned pos = old - gen * nloc;
              if (pos + 1u == nloc / 2u || pos + 4u == nloc || pos + 2u == nloc) asm volatile("buffer_wbl2 sc1" ::: "memory"); }
#endif
        }
    }
    __syncthreads();
    if (b.st[2] != 0u) {
        unsigned* bar = b.bar; const unsigned gen = b.st[3]; bool more = true;
        for (unsigned it = 0; it < (1u << 20); ++it) {
            if (tid_ == 0) b.st[4] = (xb_ld(&bar[XB_XGEN(b.x)]) != gen || xb_ld(&bar[XB_TMO]) != 0u) ? 1u : 0u;
            __syncthreads();
            const unsigned rel = b.st[4];
            if (rel) break;
            if (more) { const unsigned w_ = conv_work_one(F, DEPTH - 1) ? 1u : 0u; volatile LAS unsigned* wf = b.st + 16;
                if ((tid_ & 63) == 0) wf[tid_ >> 6] = w_;
                __syncthreads();
                more = (wf[0] | wf[1] | wf[2] | wf[3] | wf[4] | wf[5] | wf[6] | wf[7]) != 0u; }
            else { if (tid_ == 0) XB_SPIN(xb_ld(&bar[XB_XGEN(b.x)]) == gen, bar); __syncthreads(); break; }
        }
        if (tid_ == 0) { __builtin_amdgcn_fence(__ATOMIC_ACQUIRE, "agent"); asm volatile("s_waitcnt vmcnt(0)" ::: "memory"); }
    }
    __syncthreads();
}

__device__ __forceinline__ bf16x8 tr_frag(LAS const unsigned char* img, int pitch, int k0, int n0, int lane) {
    const int g = lane >> 4, q = (lane & 15) >> 2, p = lane & 3;
    LAS const unsigned char* a = img + (k0 + 8 * g + q) * pitch + (n0 + 4 * p) * 2;
    const s16x4 lo = __builtin_bit_cast(s16x4, __builtin_amdgcn_ds_read_tr16_b64_v4i16((LAS s16x4*)a));
    const s16x4 hi = __builtin_bit_cast(s16x4, __builtin_amdgcn_ds_read_tr16_b64_v4i16((LAS s16x4*)(a + 4 * pitch)));
    return __builtin_shufflevector(lo, hi, 0, 1, 2, 3, 4, 5, 6, 7);
}
__device__ __forceinline__ bf16x8 pack_f8(const f32x4& a, const f32x4& b) { v4u w; w.x = pg8::cvt_pk_bf16(a[0], a[1]); w.y = pg8::cvt_pk_bf16(a[2], a[3]); w.z = pg8::cvt_pk_bf16(b[0], b[1]); w.w = pg8::cvt_pk_bf16(b[2], b[3]); return __builtin_bit_cast(bf16x8, w); }
__device__ __forceinline__ float wave_sum(float v, int lane) {
#pragma unroll
    for (int o = 1; o < 64; o <<= 1) v += pg8::shx(v, o, lane);
    return v;
}

struct Frame {
    LAS unsigned char* lds;
    int tid, lane, wave;
    const float *x, *norm_mix_w, *w_in, *ret_gn_w, *ret_proj, *sgu_ln_w, *sgu_ln_b, *sgu_w_s, *sgu_b_s, *sgu_proj, *w_out, *norm_ffn_w, *w_ffn_in, *w_ffn_out, *final_norm_w;
    float* out; unsigned char* ws;
};

__device__ __forceinline__ int p0_rowmap(int mode, int c) {
    if (mode == 1) { if (c < 2048) { const int d = c & 127; return (c & ~127) + 2 * (d & 63) + (d >> 6); } return c; }
    if (mode == 2) { const int half = c >= DFF ? 1 : 0, j = c - half * DFF; return 256 * (j >> 7) + 128 * half + (j & 127); }
    return c;
}
__device__ __forceinline__ void p0_transpose_item(const float* W, int Nsrc, int K, bf16* WT, int mode, const float* kscale, float qs, LAS float* scr, int kb, int cb, int lane) {
    const int k0 = 64 * kb, c0 = 64 * cb, c4 = (lane & 15) * 4;
    f32x4 w[16];
#pragma unroll
    for (int i = 0; i < 16; ++i) { const int kk = 4 * i + (lane >> 4); w[i] = *(const GAS f32x4*)(W + (size_t)(k0 + kk) * Nsrc + c0 + c4); }
#pragma unroll
    for (int i = 0; i < 16; ++i) { const int kk = 4 * i + (lane >> 4); const float ks = kscale ? kscale[k0 + kk] : 1.f;
        *(LAS f32x4*)(scr + kk * 64 + (c4 ^ (((kk >> 3) & 7) << 3))) = w[i] * ks; }
    LDS_WAIT(); asm volatile("" ::: "memory");
    const int c = lane & 7;
#pragma unroll
    for (int j = 0; j < 8; ++j) { const int n = (lane >> 3) + 8 * j, row = p0_rowmap(mode, c0 + n); const float cs = (mode == 1 && row < 1024) ? qs : 1.f;
        const LAS float* s = scr + (8 * c) * 64 + (n ^ (c << 3));
        if (mode == 3) {
            int w0 = __builtin_amdgcn_cvt_pk_fp8_f32(s[0 * 64] * 256.0f, s[1 * 64] * 256.0f, 0, false); w0 = __builtin_amdgcn_cvt_pk_fp8_f32(s[2 * 64] * 256.0f, s[3 * 64] * 256.0f, w0, true);
            int w1 = __builtin_amdgcn_cvt_pk_fp8_f32(s[4 * 64] * 256.0f, s[5 * 64] * 256.0f, 0, false); w1 = __builtin_amdgcn_cvt_pk_fp8_f32(s[6 * 64] * 256.0f, s[7 * 64] * 256.0f, w1, true);
            v2u o2; o2.x = (unsigned)w0; o2.y = (unsigned)w1; *(GAS v2u*)((GAS unsigned char*)WT + (size_t)row * K + k0 + 8 * c) = o2;
        } else {
        v4u o; o.x = pk2(s[0 * 64] * cs, s[1 * 64] * cs); o.y = pk2(s[2 * 64] * cs, s[3 * 64] * cs); o.z = pk2(s[4 * 64] * cs, s[5 * 64] * cs); o.w = pk2(s[6 * 64] * cs, s[7 * 64] * cs);
        *(GAS v4u*)(WT + (size_t)row * K + k0 + 8 * c) = o; } }
    LDS_WAIT(); asm volatile("" ::: "memory");
}
#ifndef FP8_L0
#define FP8_L0 DEPTH
#endif
constexpr int I_IN = 32 * (NIN / 64), I_SQ = 32 * 32, I_F1 = 32 * (NFF / 64), I_F2 = (DFF / 64) * 32, I_LAYER = I_IN + 3 * I_SQ + I_F1 + I_F2;
__device__ __forceinline__ void conv_item(Frame& F, int it, LAS float* scr) {
    const int l = it / I_LAYER; int r = it % I_LAYER;
    unsigned char* wl = F.ws + WS_W + (size_t)l * W_LAYER;
    const float* W; int Nsrc = D, K = D, mode = 0, nb = 32; bf16* WT; const float* ks = nullptr; float qs = 1.f;
    if (r < I_IN) { W = F.w_in + (size_t)l * D * NIN; Nsrc = NIN; WT = (bf16*)(wl + W_IN); mode = 1; ks = F.norm_mix_w + l * D; qs = 0.08838834764831845f; nb = NIN / 64; }
    else if ((r -= I_IN) < I_SQ) { W = F.ret_proj + (size_t)l * D * D; WT = (bf16*)(wl + W_R); }
    else if ((r -= I_SQ) < I_SQ) { W = F.sgu_proj + (size_t)l * D * D; WT = (bf16*)(wl + W_S); }
    else if ((r -= I_SQ) < I_SQ) { W = F.w_out + (size_t)l * D * D; WT = (bf16*)(wl + W_O); }
    else if ((r -= I_SQ) < I_F1) { W = F.w_ffn_in + (size_t)l * D * NFF; Nsrc = NFF; WT = (bf16*)(wl + W_F1); mode = 2; ks = F.norm_ffn_w + l * D; nb = NFF / 64; }
    else { r -= I_F1; W = F.w_ffn_out + (size_t)l * DFF * D; K = DFF; WT = (bf16*)(wl + W_F2); if (l >= FP8_L0) mode = 3; }
    p0_transpose_item(W, Nsrc, K, WT, mode, ks, qs, scr, r / nb, r % nb, F.lane);
}
constexpr int CW_CONV_DONE = 2624;
constexpr int CONV_CUR_OFF = MISC_OFF + 64;
__device__ __forceinline__ bool conv_work_one(Frame& F, int max_layer = DEPTH - 1) {
    volatile LAS unsigned* cur = (volatile LAS unsigned*)(F.lds + CONV_CUR_OFF) + F.wave;
    const int NGW = NWG * NWAVES, gw = blockIdx.x * NWAVES + F.wave;
    const int k = __builtin_amdgcn_readfirstlane((int)*cur);
    if (k >= (DEPTH * I_LAYER) / NGW + 1) return false;
    const int it = I_LAYER + gw + k * NGW;
    if (it >= DEPTH * I_LAYER) return false;
    const int layer = it / I_LAYER;
    if (layer > max_layer) return false;
    conv_item(F, it, (LAS float*)(F.lds + RING_OFF + F.wave * 16384));
    if (F.lane == 0) *cur = (unsigned)(k + 1);
    if ((it + NGW) / I_LAYER != layer) {
        asm volatile("s_waitcnt vmcnt(0)" ::: "memory");
        if (F.lane == 0) __hip_atomic_fetch_add((unsigned*)(F.ws + WS_CTL) + CW_CONV_DONE + 64 * layer, 1u, __ATOMIC_RELAXED, __HIP_MEMORY_SCOPE_AGENT); }
    return true;
}
__device__ __forceinline__ void conv_finish(Frame& F, int layer) {
    while (conv_work_one(F, layer)) { }
    unsigned* cnt = (unsigned*)(F.ws + WS_CTL) + CW_CONV_DONE + 64 * layer; const unsigned want = (unsigned)(NWG * NWAVES);
    for (unsigned spins = 0; spins < (1u << 22); ++spins) {
        unsigned d = 0; if (F.lane == 0) d = __hip_atomic_load(cnt, __ATOMIC_RELAXED, __HIP_MEMORY_SCOPE_AGENT);
        d = (unsigned)__builtin_amdgcn_readfirstlane((int)d);
        if (d >= want) break;
        __builtin_amdgcn_s_sleep(8);
    }
    __syncthreads();
}
__device__ __forceinline__ void p0_prologue(Frame& F) {
    LAS float* scr = (LAS float*)(F.lds + RING_OFF + F.wave * 16384);
    const int gw = blockIdx.x * NWAVES + F.wave, NGW = NWG * NWAVES;
    for (int it = gw; it < I_LAYER; it += NGW) conv_item(F, it, scr);
    bf16* XB = (bf16*)(F.ws + WS_XB); float* SS = (float*)(F.ws + WS_SS);
    for (int m = gw; m < M; m += NGW) {
        const GAS f32x4* xr = (const GAS f32x4*)(F.x + (size_t)m * D) + F.lane; GAS v2u* bo = (GAS v2u*)(XB + (size_t)m * D) + F.lane;
        float s = 0.f;
#pragma unroll
        for (int j = 0; j < 8; ++j) { const f32x4 v = xr[64 * j]; s += (v[0] * v[0] + v[1] * v[1]) + (v[2] * v[2] + v[3] * v[3]); v2u w; w.x = pk2(v[0], v[1]); w.y = pk2(v[2], v[3]); bo[64 * j] = w; }
        s = wave_sum(s, F.lane);
        if (F.lane < 32) SS[(size_t)m * 32 + F.lane] = (F.lane == 0) ? s : 0.f;
    }
    float* rope = (float*)(F.ws + WS_ROPE);
    for (int t = blockIdx.x * (NWAVES * 64) + F.tid; t < T * 64; t += NWG * NWAVES * 64) {
        const int pos = t >> 6, i = t & 63; const float inv = powf(10000.0f, -(float)i * (1.0f / 64.0f)); const float ang = (float)pos * inv;
        float sn, cs; sincosf(ang, &sn, &cs); rope[2 * t] = cs; rope[2 * t + 1] = sn;
    }
}

template <bool P2> __device__ __forceinline__ void ret_unit(Frame& F, int u, int layer) {
    LAS unsigned char* lds = F.lds + RING_OFF;
    const int w = F.wave, lane_u = F.lane;
    int lane = lane_u, g = lane >> 4, c16 = lane & 15;
    const int bh = u >> 4, seg = u & 15, b = bh >> 3, h = bh & 7;
    const size_t tb = (size_t)b * T + (size_t)seg * 512;
    const float l2g = l2gamma(h);
    const float cdec = ex2(l2g * 64.0f);
    const bf16* Qg = (const bf16*)(F.ws + WS_Q); const bf16* Kg = (const bf16*)(F.ws + WS_K); const bf16* Vg = (const bf16*)(F.ws + WS_V); const bf16* SGg = (const bf16*)(F.ws + WS_SG);
    bf16* RA = (bf16*)(F.ws + WS_RA);
    float* sp = (float*)(F.ws + WS_SLOC) + (size_t)(bh * 16 + seg) * (128 * 256);
    const float* gnw = F.ret_gn_w + (size_t)layer * 2048 + h * 256;
    f32x4 st[8][2];
    { int so = (32 * w + c16) * 128 + 4 * g;
#pragma unroll
      for (int dt = 0; dt < 8; ++dt) {
        asm volatile("" : "+v"(so));
        const GAS float* spl = (const GAS float*)sp + so;
#pragma unroll
        for (int et = 0; et < 2; ++et) {
            if (P2) st[dt][et] = *(const GAS f32x4*)(spl + et * 2048);
            else st[dt][et] = (f32x4){0.f, 0.f, 0.f, 0.f}; }
        so += 16; } }
    const float l2g_u = l2g;
    v4u qr[2], kr[2], vr[4];
    { const int tid = (w << 6) | lane_u;
#pragma unroll
    for (int i = 0; i < 2; ++i) { const int ch = tid + 512 * i, row = ch >> 4, c8 = ch & 15;
        if (P2) qr[i] = *(const GAS v4u*)(Qg + (tb + row) * 1024 + h * 128 + c8 * 8);
        kr[i] = *(const GAS v4u*)(Kg + (tb + row) * 1024 + h * 128 + c8 * 8); }
#pragma unroll
    for (int i = 0; i < 4; ++i) { const int ch = tid + 512 * i, row = ch >> 5, c8 = ch & 31; vr[i] = *(const GAS v4u*)(Vg + (tb + row) * 2048 + h * 256 + c8 * 8); } }
    for (int cc = 0; cc < 8; ++cc) {
        const size_t r0 = tb + (size_t)cc * 64;
        float l2g = l2g_u; asm volatile("" : "+v"(l2g));
        lane = lane_u; asm volatile("" : "+v"(lane)); g = lane >> 4; c16 = lane & 15;
        const int tid = (w << 6) | lane;
        LAS unsigned char* img = P2 ? lds : lds + (cc & 1) * R1_BUF;
#pragma unroll
        for (int i = 0; i < 2; ++i) { const int ch = tid + 512 * i, row = ch >> 4, c8 = ch & 15;
            if (P2) { *(LAS v4u*)(img + R_Q + row * PQ + c8 * 16) = qr[i]; *(LAS v4u*)(img + R_K + row * PQ + c8 * 16) = kr[i]; }
            const v4u kv = kr[i]; const float kd = ex2(l2g * (float)(63 - row));
            v4u ks; ks.x = pk2(blo(kv.x) * kd, bhi(kv.x) * kd); ks.y = pk2(blo(kv.y) * kd, bhi(kv.y) * kd); ks.z = pk2(blo(kv.z) * kd, bhi(kv.z) * kd); ks.w = pk2(blo(kv.w) * kd, bhi(kv.w) * kd);
            *(LAS v4u*)(img + (P2 ? R_KS : R1_KS) + row * PQ + c8 * 16) = ks; }
#pragma unroll
        for (int i = 0; i < 4; ++i) { const int ch = tid + 512 * i, row = ch >> 5, c8 = ch & 31; { LAS unsigned char* vp = img + (P2 ? R_V : R1_V) + row * PV + ((c8 >> 2) * 32 + (c8 & 3) * 4) * 2;
            v2u lo_, hi_; lo_.x = vr[i].x; lo_.y = vr[i].y; hi_.x = vr[i].z; hi_.y = vr[i].w; *(LAS v2u*)vp = lo_; *(LAS v2u*)(vp + 32) = hi_; } }
        __syncthreads();
        if (cc < 7) { const size_t rn = r0 + 64;
#pragma unroll
            for (int i = 0; i < 2; ++i) { const int ch = tid + 512 * i, row = ch >> 4, c8 = ch & 15;
                if (P2) qr[i] = *(const GAS v4u*)(Qg + (rn + row) * 1024 + h * 128 + c8 * 8);
                kr[i] = *(const GAS v4u*)(Kg + (rn + row) * 1024 + h * 128 + c8 * 8); }
#pragma unroll
            for (int i = 0; i < 4; ++i) { const int ch = tid + 512 * i, row = ch >> 5, c8 = ch & 31; vr[i] = *(const GAS v4u*)(Vg + (rn + row) * 2048 + h * 256 + c8 * 8); } }
        f32x4 o[2][4];
        if (P2) {
#pragma unroll
            for (int tt = 0; tt < 2; ++tt) { const int t16 = 2 * w + tt, jt = t16 >> 2, it = t16 & 3; f32x4 a = (f32x4){0.f, 0.f, 0.f, 0.f};
#pragma unroll
                for (int ks = 0; ks < 4; ++ks) { const bf16x8 A = *(const LAS bf16x8*)(lds + R_K + (16 * jt + c16) * PQ + (32 * ks + 8 * g) * 2); const bf16x8 B = *(const LAS bf16x8*)(lds + R_Q + (16 * it + c16) * PQ + (32 * ks + 8 * g) * 2);
                    a = MFMA16(A, B, a); }
                const int ii = 16 * it + c16;
#pragma unroll
                for (int r = 0; r < 4; ++r) { const int jj = 16 * jt + 4 * g + r; a[r] *= ex2(l2g * fabsf((float)(ii - jj))); }
                v2u pw; pw.x = pg8::cvt_pk_bf16(a[0], a[1]); pw.y = pg8::cvt_pk_bf16(a[2], a[3]);
                *(LAS v2u*)(lds + R_P + ii * PP + (16 * jt + 4 * g) * 2) = pw; }
            __syncthreads();
#pragma unroll
            for (int et = 0; et < 2; ++et)
#pragma unroll
                for (int it = 0; it < 4; ++it) o[et][it] = (f32x4){0.f, 0.f, 0.f, 0.f};
#pragma unroll
            for (int ks = 0; ks < 4; ++ks) { bf16x8 A[2];
#pragma unroll
                for (int et = 0; et < 2; ++et) A[et] = pack_f8(st[2 * ks][et], st[2 * ks + 1][et]);
#pragma unroll
                for (int it = 0; it < 4; ++it) { LAS const unsigned char* qp = lds + R_Q + (16 * it + c16) * PQ + (32 * ks + 4 * g) * 2;
                    const s16x4 lo = *(const LAS s16x4*)qp, hi = *(const LAS s16x4*)(qp + 32); const bf16x8 B = __builtin_shufflevector(lo, hi, 0, 1, 2, 3, 4, 5, 6, 7);
#pragma unroll
                    for (int et = 0; et < 2; ++et) o[et][it] = MFMA16(A[et], B, o[et][it]); }
                __builtin_amdgcn_sched_barrier(0); }
#pragma unroll
            for (int it = 0; it < 4; ++it) { const float qd = ex2(l2g * (float)(16 * it + c16 + 1));
#pragma unroll
                for (int et = 0; et < 2; ++et) o[et][it] *= qd; }
        }
        if (P2) {
#pragma unroll
            for (int ks2 = 0; ks2 < 2; ++ks2) { bf16x8 vf[2];
#pragma unroll
                for (int et = 0; et < 2; ++et) vf[et] = tr_frag(img + (P2 ? R_V : R1_V), PV, 32 * ks2, 32 * w + 16 * et, lane);
#pragma unroll
                for (int it = 0; it < 4; ++it) { const bf16x8 B = *(const LAS bf16x8*)(lds + R_P + (16 * it + c16) * PP + (32 * ks2 + 8 * g) * 2);
#pragma unroll
                    for (int et = 0; et < 2; ++et) o[et][it] = MFMA16(vf[et], B, o[et][it]); __builtin_amdgcn_sched_barrier(0); } }
        }
#pragma unroll
        for (int dt = 0; dt < 8; ++dt)
#pragma unroll
            for (int et = 0; et < 2; ++et) st[dt][et] *= cdec;
#pragma unroll
        for (int ks2 = 0; ks2 < 2; ++ks2) { bf16x8 vf[2];
#pragma unroll
            for (int et = 0; et < 2; ++et) vf[et] = tr_frag(img + (P2 ? R_V : R1_V), PV, 32 * ks2, 32 * w + 16 * et, lane);
#pragma unroll
            for (int dt = 0; dt < 8; ++dt) { const bf16x8 A = tr_frag(img + (P2 ? R_KS : R1_KS), PQ, 32 * ks2, 16 * dt, lane);
#pragma unroll
                for (int et = 0; et < 2; ++et) st[dt][et] = MFMA16(A, vf[et], st[dt][et]); __builtin_amdgcn_sched_barrier(0); } }
        if (P2) {
            LAS f32x2* red = (LAS f32x2*)(lds + R_RED);
            v4u sgr[4];
#pragma unroll
            for (int it = 0; it < 4; ++it) sgr[it] = *(const GAS v4u*)(SGg + (r0 + 16 * it + c16) * 2048 + h * 256 + 32 * w + 8 * g);
#pragma unroll
            for (int it = 0; it < 4; ++it) { float s1 = 0.f, s2 = 0.f;
#pragma unroll
                for (int et = 0; et < 2; ++et)
#pragma unroll
                    for (int r = 0; r < 4; ++r) { const float v = o[et][it][r]; s1 += v; s2 += v * v; }
                s1 += pg8::shx(s1, 16, lane); s1 += pg8::shx(s1, 32, lane); s2 += pg8::shx(s2, 16, lane); s2 += pg8::shx(s2, 32, lane);
                if (g == 0) red[w * 64 + 16 * it + c16] = (f32x2){s1, s2}; }
            __syncthreads();
#pragma unroll
            for (int it = 0; it < 4; ++it) { const int ii = 16 * it + c16; float S1 = 0.f, S2 = 0.f;
#pragma unroll
                for (int w8 = 0; w8 < 8; ++w8) { const f32x2 t = red[w8 * 64 + ii]; S1 += t.x; S2 += t.y; }
                const float mu = S1 * (1.0f / 256.0f), var = fmaxf(S2 * (1.0f / 256.0f) - mu * mu, 0.f), rstd = 1.0f / sqrtf(var + EPS);
                { const int col = h * 256 + 32 * w + 8 * g; const size_t off = (r0 + ii) * 2048 + col; const v4u sg = sgr[it]; v4u ow;
                  { const f32x4 gw4 = *(const f32x4*)(gnw + 32 * w + 8 * g);
                    const float y0 = (o[0][it][0] - mu) * rstd * gw4[0] * blo(sg.x), y1 = (o[0][it][1] - mu) * rstd * gw4[1] * bhi(sg.x), y2 = (o[0][it][2] - mu) * rstd * gw4[2] * blo(sg.y), y3 = (o[0][it][3] - mu) * rstd * gw4[3] * bhi(sg.y);
                    ow.x = pg8::cvt_pk_bf16(y0, y1); ow.y = pg8::cvt_pk_bf16(y2, y3); }
                  { const f32x4 gw4 = *(const f32x4*)(gnw + 32 * w + 8 * g + 4);
                    const float y0 = (o[1][it][0] - mu) * rstd * gw4[0] * blo(sg.z), y1 = (o[1][it][1] - mu) * rstd * gw4[1] * bhi(sg.z), y2 = (o[1][it][2] - mu) * rstd * gw4[2] * blo(sg.w), y3 = (o[1][it][3] - mu) * rstd * gw4[3] * bhi(sg.w);
                    ow.z = pg8::cvt_pk_bf16(y0, y1); ow.w = pg8::cvt_pk_bf16(y2, y3); }
                  *(GAS v4u*)(RA + off) = ow; } }
        }
    }
    __syncthreads();
#if !defined(SKIP_R1_STORE)
    if (!P2) {
        int so = (32 * w + c16) * 128 + 4 * g;
#pragma unroll
        for (int dt = 0; dt < 8; ++dt) {
            asm volatile("" : "+v"(so));
            GAS float* spl = (GAS float*)sp + so;
#pragma unroll
            for (int et = 0; et < 2; ++et) *(GAS f32x4*)(spl + et * 2048) = st[dt][et];
            so += 16; }
    }
#else
    if (!P2) { float acc_ = 0.f;
#pragma unroll
        for (int dt = 0; dt < 8; ++dt)
#pragma unroll
            for (int et = 0; et < 2; ++et)
#pragma unroll
                for (int r = 0; r < 4; ++r) acc_ += st[dt][et][r];
        if (acc_ == 123.456f) sp[0] = acc_; }
#endif
}
__device__ __forceinline__ void ret_scan(Frame& F) {
    float* sl = (float*)(F.ws + WS_SLOC);
    for (int idx = blockIdx.x * (NWAVES * 64) + F.tid; idx < 16 * 8192; idx += NWG * NWAVES * 64) {
        const int bh = idx >> 13, e4 = idx & 8191, h = bh & 7;
        const float l2g = l2gamma(h); const float cd8 = ex2(l2g * 512.0f);
        f32x4 carry = (f32x4){0.f, 0.f, 0.f, 0.f}; asm volatile("" : "+v"(carry));
        for (int seg = 0; seg < 16; ++seg) { GAS f32x4* p = (GAS f32x4*)(sl + (size_t)(bh * 16 + seg) * 32768) + e4; const f32x4 t = *p; *p = carry; carry = carry * cd8 + t; }
    }
}

__device__ __forceinline__ void sgu_stats(const float* LS, size_t r0, LAS f32x2* stt, int tid) {
    if (tid < 128) { const GAS f32x4* p = (const GAS f32x4*)(LS + (r0 + tid) * 64); float S1 = 0.f, S2 = 0.f;
#pragma unroll
        for (int i = 0; i < 16; ++i) { const f32x4 t = p[i]; S1 += t[0] + t[2]; S2 += t[1] + t[3]; }
        const float mu = S1 * (1.0f / 2048.0f), var = fmaxf(S2 * (1.0f / 2048.0f) - mu * mu, 0.f); stt[tid] = (f32x2){mu, 1.0f / sqrtf(var + EPS)}; }
}
__device__ __forceinline__ void sgu_phase(Frame& F, int layer) {
    LAS unsigned char* lds = F.lds + RING_OFF;
    const int w = F.wave, lane_u = F.lane;
    int lane = lane_u, tid = (w << 6) | lane, g = lane >> 4, c16 = lane & 15;
    const bf16* ZU = (const bf16*)(F.ws + WS_ZU); const bf16* ZV = (const bf16*)(F.ws + WS_ZV); bf16* SB = (bf16*)(F.ws + WS_SB);
    const float* LS = (const float*)(F.ws + WS_LS);
    int cg_loaded = -1;
    v4u zvr[8];
    int u = blockIdx.x;
    if (u < 1024) { const int cg = u & 7; const size_t r0 = (size_t)(u >> 3) * 128;
#pragma unroll
        for (int i = 0; i < 8; ++i) { const int ch = tid + 512 * i, j = ch >> 5, c8 = ch & 31; zvr[i] = *(const GAS v4u*)(ZV + (r0 + j) * 2048 + 256 * cg + 8 * c8); }
        sgu_stats(LS, r0, (LAS f32x2*)(lds + S_ST), tid); }
    for (int it_u = 0; u < 1024; u += NWG, ++it_u) {
        lane = lane_u; asm volatile("" : "+v"(lane)); tid = (w << 6) | lane; g = lane >> 4; c16 = lane & 15;
        const int cg = u & 7, rg = u >> 3; const size_t r0 = (size_t)rg * 128; const int ch0 = 256 * cg;
        const float* lnw = F.sgu_ln_w + (size_t)layer * 2048 + ch0; const float* lnb = F.sgu_ln_b + (size_t)layer * 2048 + ch0;
        const float* bs = F.sgu_b_s + ((size_t)layer * 8 + cg) * 128;
        LAS f32x2* stt = (LAS f32x2*)(lds + S_ST + (it_u & 1) * 1024);
        if (cg != cg_loaded) { const float* wsrc = F.sgu_w_s + ((size_t)layer * 8 + cg) * (128 * 128); cg_loaded = cg;
#pragma unroll
            for (int i = 0; i < 8; ++i) { const int idx4 = tid + 512 * i, ir = idx4 >> 5, j4 = (idx4 & 31) * 4; f32x4 wv = *(const GAS f32x4*)(wsrc + ir * 128 + j4);
                if ((j4 >> 6) > (ir >> 6)) wv = (f32x4){0.f, 0.f, 0.f, 0.f};
                v2u pw; pw.x = pk2(wv[0], wv[1]); pw.y = pk2(wv[2], wv[3]); *(LAS v2u*)(lds + S_W + ir * PQ + j4 * 2) = pw; } }
        if (it_u == 0) __syncthreads();
#pragma unroll
        for (int i = 0; i < 8; ++i) { const int ch = tid + 512 * i, j = ch >> 5, c8 = ch & 31; const v4u zv = zvr[i];
            const f32x4 w0 = *(const f32x4*)(lnw + 8 * c8), w1 = *(const f32x4*)(lnw + 8 * c8 + 4), b0 = *(const f32x4*)(lnb + 8 * c8), b1 = *(const f32x4*)(lnb + 8 * c8 + 4);
            const f32x2 ms = stt[j]; const float mu = ms.x, rs = ms.y;
            v4u o; o.x = pk2((blo(zv.x) - mu) * rs * w0[0] + b0[0], (bhi(zv.x) - mu) * rs * w0[1] + b0[1]); o.y = pk2((blo(zv.y) - mu) * rs * w0[2] + b0[2], (bhi(zv.y) - mu) * rs * w0[3] + b0[3]);
            o.z = pk2((blo(zv.z) - mu) * rs * w1[0] + b1[0], (bhi(zv.z) - mu) * rs * w1[1] + b1[1]); o.w = pk2((blo(zv.w) - mu) * rs * w1[2] + b1[2], (bhi(zv.w) - mu) * rs * w1[3] + b1[3]);
            { LAS unsigned char* vp = lds + S_VN + j * PV + ((c8 >> 2) * 32 + (c8 & 3) * 4) * 2;
              v2u lo_, hi_; lo_.x = o.x; lo_.y = o.y; hi_.x = o.z; hi_.y = o.w; *(LAS v2u*)vp = lo_; *(LAS v2u*)(vp + 32) = hi_; } }
        __syncthreads();
        const int un = u + NWG;
        if (un < 1024) { const size_t rn = (size_t)(un >> 3) * 128; const int cgn = un & 7;
#pragma unroll
            for (int i = 0; i < 8; ++i) { const int ch = tid + 512 * i, j = ch >> 5, c8 = ch & 31; zvr[i] = *(const GAS v4u*)(ZV + (rn + j) * 2048 + 256 * cgn + 8 * c8); }
            sgu_stats(LS, rn, (LAS f32x2*)(lds + S_ST + ((it_u + 1) & 1) * 1024), tid); }
        v4u zur[8];
#pragma unroll
        for (int it = 0; it < 8; ++it) zur[it] = *(const GAS v4u*)(ZU + (r0 + 16 * it + c16) * 2048 + ch0 + 32 * w + 8 * g);
        f32x4 acc[2][8];
#pragma unroll
        for (int ct = 0; ct < 2; ++ct)
#pragma unroll
            for (int it = 0; it < 8; ++it) acc[ct][it] = (f32x4){0.f, 0.f, 0.f, 0.f};
#pragma unroll
        for (int ks = 0; ks < 4; ++ks) { bf16x8 A[2];
#pragma unroll
            for (int ct = 0; ct < 2; ++ct) A[ct] = tr_frag(lds + S_VN, PV, 32 * ks, 32 * w + 16 * ct, lane);
#pragma unroll
            for (int it = 0; it < 8; ++it) { if (it < 4 && ks >= 2) continue;
                const bf16x8 B = *(const LAS bf16x8*)(lds + S_W + (16 * it + c16) * PQ + (32 * ks + 8 * g) * 2);
#pragma unroll
                for (int ct = 0; ct < 2; ++ct) acc[ct][it] = MFMA16(A[ct], B, acc[ct][it]); __builtin_amdgcn_sched_barrier(0); } }
#pragma unroll
        for (int it = 0; it < 8; ++it) { const int ii = 16 * it + c16; const float bsv = bs[ii];
            { const size_t off = (r0 + ii) * 2048 + ch0 + 32 * w + 8 * g; const v4u zu = zur[it];
                v4u ow; ow.x = pg8::cvt_pk_bf16(blo(zu.x) * (acc[0][it][0] + bsv), bhi(zu.x) * (acc[0][it][1] + bsv)); ow.y = pg8::cvt_pk_bf16(blo(zu.y) * (acc[0][it][2] + bsv), bhi(zu.y) * (acc[0][it][3] + bsv));
                ow.z = pg8::cvt_pk_bf16(blo(zu.z) * (acc[1][it][0] + bsv), bhi(zu.z) * (acc[1][it][1] + bsv)); ow.w = pg8::cvt_pk_bf16(blo(zu.w) * (acc[1][it][2] + bsv), bhi(zu.w) * (acc[1][it][3] + bsv));
                *(GAS v4u*)(SB + off) = ow; } }
        __syncthreads();
    }
}

__device__ __forceinline__ void final_norm(Frame& F) {
    const int gw = blockIdx.x * NWAVES + F.wave, NGW = NWG * NWAVES;
    const bf16* XB = (const bf16*)(F.ws + WS_XB); const float* SS = (const float*)(F.ws + WS_SS);
    for (int m = gw; m < M; m += NGW) {
        const float s = wave_sum(F.lane < 32 ? SS[(size_t)m * 32 + F.lane] : 0.f, F.lane); const float rstd = 1.0f / sqrtf(s * (1.0f / 2048.0f) + EPS);
        const GAS v2u* xr = (const GAS v2u*)(XB + (size_t)m * D) + F.lane; const GAS f32x4* fw = (const GAS f32x4*)F.final_norm_w + F.lane; GAS f32x4* o = (GAS f32x4*)(F.out + (size_t)m * D) + F.lane;
#pragma unroll
        for (int j = 0; j < 8; ++j) { const v2u w = xr[64 * j]; const f32x4 g = fw[64 * j]; o[64 * j] = (f32x4){blo(w.x) * rstd * g[0], bhi(w.x) * rstd * g[1], blo(w.y) * rstd * g[2], bhi(w.y) * rstd * g[3]}; }
    }
}

#if defined(PROBE_STOP)
__device__ __forceinline__ void probe_dump(Frame& F) {
    const size_t offs[12] = {WS_V, WS_SG, WS_ZU, WS_ZV, WS_GA, WS_GB, WS_RA, WS_SB, WS_MG, WS_XB, WS_P, 0};
    for (size_t i = (size_t)blockIdx.x * 512 + F.tid; i < (size_t)M * D; i += (size_t)NWG * 512) {
        float a = 0.f; const size_t m = i >> 11, c = i & 2047;
#pragma unroll
        for (int b = 0; b < 11; ++b) if (PROBE_MASK & (1 << b)) a += blo((unsigned)((const bf16*)(F.ws + offs[b]))[i]);
        if (PROBE_MASK & (1 << 11)) { if (c < 1024) a += blo((unsigned)((const bf16*)(F.ws + WS_Q))[m * 1024 + c]) + blo((unsigned)((const bf16*)(F.ws + WS_K))[m * 1024 + c]); }
        if (PROBE_MASK & (1 << 12)) a += blo((unsigned)((const bf16*)(F.ws + WS_H))[m * 5632 + c]) + blo((unsigned)((const bf16*)(F.ws + WS_H))[m * 5632 + 2048 + c]) + ((c < 1536) ? blo((unsigned)((const bf16*)(F.ws + WS_H))[m * 5632 + 4096 + c]) : 0.f);
        if (PROBE_MASK & (1 << 13)) { if (i < (size_t)D * D) a += blo((unsigned)((const bf16*)(F.ws + WS_W + W_R))[i]); }
        if (PROBE_MASK & (1 << 14)) { if (i < (size_t)D * D) a += blo((unsigned)((const bf16*)(F.ws + WS_W + W_S))[i]) + blo((unsigned)((const bf16*)(F.ws + WS_W + W_O))[i]); }
        F.out[i] = a;
    }
}
#endif
constexpr int PH_PER_LAYER = 8, NPHASES = 2 + DEPTH * PH_PER_LAYER;
struct Args { const float* in[15]; float* out; unsigned char* ws; int ph_lo, ph_hi; };
static_assert(sizeof(Args) == 15 * 8 + 8 + 8 + 8, "Args has no padding");
__global__ void __launch_bounds__(NWAVES * 64, 2) mk_fwd(Args args) {
    extern __shared__ __attribute__((aligned(16))) unsigned char lds_raw[];
    Frame F;
    F.lds = (LAS unsigned char*)lds_raw;
    F.tid = threadIdx.x; F.lane = F.tid & 63; F.wave = __builtin_amdgcn_readfirstlane(F.tid >> 6);
    F.x = args.in[0]; F.norm_mix_w = args.in[1]; F.w_in = args.in[2]; F.ret_gn_w = args.in[3]; F.ret_proj = args.in[4]; F.sgu_ln_w = args.in[5]; F.sgu_ln_b = args.in[6]; F.sgu_w_s = args.in[7];
    F.sgu_b_s = args.in[8]; F.sgu_proj = args.in[9]; F.w_out = args.in[10]; F.norm_ffn_w = args.in[11]; F.w_ffn_in = args.in[12]; F.w_ffn_out = args.in[13]; F.final_norm_w = args.in[14];
    F.out = args.out; F.ws = args.ws;
#if defined(ZERO_LDS)
    for (int u = F.tid; u < LDS_BYTES / 4; u += NWAVES * 64) ((LAS unsigned*)(F.lds))[u] = 0u;
#else
    for (int u = F.tid; u < (LDS_BYTES - LDSCTL_OFF) / 4; u += NWAVES * 64) ((LAS unsigned*)(F.lds + LDSCTL_OFF))[u] = 0u;
#endif
    __syncthreads();
#if MK_PER_PHASE || defined(PROBE_STOP)
    const int lo = args.ph_lo, hi = args.ph_hi;
#else
    constexpr int lo = 0, hi = NPHASES;
#endif
    unsigned* ctl = (unsigned*)(F.ws + WS_CTL);
#if defined(TAIL_MIN)
    if (blockIdx.x == 0 && threadIdx.x == 0) ((unsigned long long*)(ctl + 2048))[1] = ~0ull;
#endif
    XcdBarrier bar; bar.bar = ctl + CW_BAR; bar.x = 0; bar.st = nullptr;
    if (hi - lo > 1) bar = xcd_barrier_post(ctl + CW_BAR, (volatile LAS unsigned*)(F.lds + MISC_OFF) + 8);
#ifndef MK_ONLY
#define MK_ONLY -1
#endif
#if defined(PROBE_STOP)
#define IN(k) (lo <= (k) && (k) < hi && ((k) <= PROBE_STOP || (k) == NPHASES - 1))
#elif MK_PER_PHASE
#define IN(k) (lo <= (k) && (k) < hi)
#else
#define IN(k) true
#endif
#define INP(slot, k) ((MK_ONLY < 0 || MK_ONLY == (slot)) && IN(k))
#ifndef DUP_SLOT
#define DUP_SLOT -1
#endif
#define REP(slot) for (int rep_ = 0; rep_ < ((DUP_SLOT == (slot)) ? 2 : 1); ++rep_)
#if defined(TAIL_PROBE)
    unsigned long long wait_sum = 0ull;
#ifndef TAIL_MASK
#define TAIL_MASK 0x1ff
#endif
#define SEAM(k) do { if (IN(k) && IN((k) + 1)) { const unsigned long long t0_ = wall_clock64(); xcd_barrier(bar); const int st_ = ((k) == 0) ? 8 : (((k) - 1) & 7); if ((TAIL_MASK >> st_) & 1) wait_sum += wall_clock64() - t0_; } } while (0)
#elif defined(DUP_BARRIER)
#define SEAM(k) do { if (IN(k) && IN((k) + 1)) { xcd_barrier(bar); xcd_barrier(bar); } } while (0)
#else
#define SEAM(k) do { if (IN(k) && IN((k) + 1)) { FRESH(); XcdBarrier b2_ = bar; b2_.bar = (unsigned*)(F.ws + WS_CTL) + CW_BAR; { unsigned so_ = MISC_OFF + 32; asm volatile("" : "+s"(so_)); b2_.st = (volatile LAS unsigned*)(F.lds + so_); } xcd_barrier_idle(b2_, F, F.tid); } } while (0)
#endif
    size_t zero_o = 0; const int wave_s = __builtin_amdgcn_readfirstlane(threadIdx.x >> 6);
#define FRESH() do { asm volatile("" : "+s"(zero_o)); int l_; asm volatile("v_mbcnt_lo_u32_b32 %0, -1, 0\n\tv_mbcnt_hi_u32_b32 %0, -1, %0" : "=v"(l_)); F.ws = args.ws + zero_o; F.lane = l_; F.wave = wave_s; F.tid = (wave_s << 6) | l_; } while (0)
#if defined(START_DELAY)
    if (IN(0)) { const unsigned long long t0 = wall_clock64(); while (wall_clock64() - t0 < 100ull * START_DELAY) __builtin_amdgcn_s_sleep(32); }
#endif
    if (INP(0, 0)) REP(0) { FRESH(); p0_prologue(F); }
    SEAM(0);
    for (int l = 0; l < DEPTH; ++l) {
        const int pb = 1 + PH_PER_LAYER * l;
        if (INP(1, pb + 0)) REP(1) { FRESH(); unsigned char* wl = F.ws + WS_W + (size_t)l * W_LAYER;
            pg8::Gemm gm{(const pg8::bf16_t*)(F.ws + WS_XB), (const pg8::bf16_t*)(wl + W_IN), M, NIN, D}; pg8::StaticOrder S; S.init(M, NIN, NWG, (int)blockIdx.x);
#if defined(G1_REV)
            pg8::RevOrder SR; SR.base = S;
#endif
            pg8::Unit u0; S.next(0, u0); const LAS float* rstab = (const LAS float*)(F.lds + RSTAB_OFF); pg8::rstd_table((const float*)(F.ws + WS_SS), u0.pm, (LAS float*)(F.lds + RSTAB_OFF), F.tid);
            pg8::EpiIn E{(const float*)(F.ws + WS_SS), (const float*)(F.ws + WS_ROPE), (pg8::bf16_t*)(F.ws + WS_Q), (pg8::bf16_t*)(F.ws + WS_K), (pg8::bf16_t*)(F.ws + WS_O2048), (float*)(F.ws + WS_LS), rstab, u0.pm};
#if defined(TIMING_NULL_G1)
#if defined(TIMING_SAME_TILE)
            if (rep_ == 1) { pg8::EpiNull EN{(float*)(F.ws + WS_SLOC)}; pg8::SameTileOrder ST{14}; pg8::gemm_phase<pg8::EpiNull, pg8::SameTileOrder, true, true>(F.lds + RING_OFF, gm, ST, EN, F.tid); } else
#else
#if defined(TIMING_NOSP2)
            if (rep_ == 1) { pg8::EpiNull EN{(float*)(F.ws + WS_SLOC)}; pg8::gemm_phase<pg8::EpiNull, pg8::StaticOrder, true, false>(F.lds + RING_OFF, gm, S, EN, F.tid); } else
#elif defined(TIMING_MM32)
            if (rep_ == 1) { pg8::EpiNull EN{(float*)(F.ws + WS_SLOC)}; pg8::gemm_phase<pg8::EpiNull, pg8::StaticOrder, true, true, true>(F.lds + RING_OFF, gm, S, EN, F.tid); } else
#else
            if (rep_ == 1) { pg8::EpiNull EN{(float*)(F.ws + WS_SLOC)}; pg8::gemm_phase<pg8::EpiNull, pg8::StaticOrder, true, true>(F.lds + RING_OFF, gm, S, EN, F.tid); } else
#endif
#endif
#endif
#if defined(G1_REV)
            pg8::gemm_phase<pg8::EpiIn, pg8::RevOrder, true, true>(F.lds + RING_OFF, gm, SR, E, F.tid);
#else
            pg8::gemm_phase<pg8::EpiIn, pg8::StaticOrder, true, true>(F.lds + RING_OFF, gm, S, E, F.tid);
#endif
        }
        SEAM(pb + 0);
        if (INP(2, pb + 1)) REP(2) { FRESH();
#if !defined(SKIP_R1)
#if defined(DUPSKIP_R1)
            if (rep_ == 0)
#endif
            for (int u = blockIdx.x; u < 256; u += NWG) ret_unit<false>(F, u, l);
#endif
#if defined(SLEEP_R1)
            { const unsigned long long t0 = wall_clock64(); while (wall_clock64() - t0 < 100ull * SLEEP_R1) __builtin_amdgcn_s_sleep(32); }
#endif
#if defined(DUMMY_R1)
            { const GAS v4u* src = (const GAS v4u*)(F.ws + WS_K); unsigned a_ = 0;
              for (size_t i = (size_t)blockIdx.x * 512 + F.tid; i < (size_t)96 * MiB / 16; i += (size_t)NWG * 512) { const v4u t = src[i]; a_ += t.x ^ t.y ^ t.z ^ t.w; }
              if (a_ == 0x12345678u) ((float*)(F.ws + WS_SLOC))[0] = 1.f; }
#endif
#if !defined(SGU_AFTER_R3)
            FRESH();
#if !defined(SKIP_SGU)
#if defined(DUPSKIP_SGU)
            if (rep_ == 0)
#endif
            sgu_phase(F, l);
#endif
#endif
        }
        SEAM(pb + 1);
        if (INP(3, pb + 2)) { FRESH(); ret_scan(F); }
        SEAM(pb + 2);
#if defined(SGU_AFTER_R3)
        if (INP(4, pb + 3)) REP(4) { FRESH(); for (int u = blockIdx.x; u < 256; u += NWG) ret_unit<true>(F, u, l); FRESH(); sgu_phase(F, l); }
#else
        if (INP(4, pb + 3)) REP(4) { FRESH(); for (int u = blockIdx.x; u < 256; u += NWG) ret_unit<true>(F, u, l); }
#endif
        SEAM(pb + 3);
        if (INP(5, pb + 4)) REP(5) { FRESH(); unsigned char* wl = F.ws + WS_W + (size_t)l * W_LAYER;
            pg8::Gemm gm{(const pg8::bf16_t*)(F.ws + WS_RA), (const pg8::bf16_t*)(wl + W_R), M, D, D}; pg8::PairOrder S; S.base.init(M, D, NWG, (int)blockIdx.x);
            pg8::EpiMerge E{(const pg8::bf16_t*)(F.ws + WS_GA), (const pg8::bf16_t*)(F.ws + WS_GB), (pg8::bf16_t*)(F.ws + WS_MG)};
            pg8::gemm_phase<pg8::EpiMerge, pg8::PairOrder, true, true>(F.lds + RING_OFF, gm, S, E, F.tid);
        }
        SEAM(pb + 4);
        if (INP(6, pb + 5)) REP(6) { FRESH(); unsigned char* wl = F.ws + WS_W + (size_t)l * W_LAYER;
            pg8::Gemm gm{(const pg8::bf16_t*)(F.ws + WS_MG), (const pg8::bf16_t*)(wl + W_O), M, D, D}; pg8::StaticOrder S; S.init(M, D, NWG, (int)blockIdx.x);
            pg8::EpiResid E{(pg8::bf16_t*)(F.ws + WS_XB), (float*)(F.ws + WS_SS2), (rep_ == 1) ? 0.f : 1.f};
#if defined(TIMING_NULL_G35)
            if (rep_ == 1) { pg8::EpiNull EN{(float*)(F.ws + WS_SLOC)}; pg8::gemm_phase<pg8::EpiNull, pg8::StaticOrder, true, true>(F.lds + RING_OFF, gm, S, EN, F.tid); } else
#endif
            pg8::gemm_phase<pg8::EpiResid, pg8::StaticOrder, true, true>(F.lds + RING_OFF, gm, S, E, F.tid);
        }
        SEAM(pb + 5);
        if (INP(7, pb + 6)) REP(7) { FRESH(); unsigned char* wl = F.ws + WS_W + (size_t)l * W_LAYER;
            pg8::Gemm gm{(const pg8::bf16_t*)(F.ws + WS_XB), (const pg8::bf16_t*)(wl + W_F1), M, NFF, D}; pg8::StaticOrder S; S.init(M, NFF, NWG, (int)blockIdx.x);
            pg8::Unit u0; S.next(0, u0); const LAS float* rstab = (const LAS float*)(F.lds + RSTAB_OFF); pg8::rstd_table((const float*)(F.ws + WS_SS2), u0.pm, (LAS float*)(F.lds + RSTAB_OFF), F.tid);
            pg8::EpiSwiglu E{(const float*)(F.ws + WS_SS2), (pg8::bf16_t*)(F.ws + WS_H), rstab, u0.pm};
#if defined(G4_REV)
            if (l >= FP8_L0) { pg8::EpiSwiglu8 E8{(const float*)(F.ws + WS_SS2), F.ws + WS_H, rstab, u0.pm}; pg8::RevOrder SR; SR.base = S; pg8::gemm_phase<pg8::EpiSwiglu8, pg8::RevOrder, true, true>(F.lds + RING_OFF, gm, SR, E8, F.tid); }
            else { pg8::RevOrder SR; SR.base = S; pg8::gemm_phase<pg8::EpiSwiglu, pg8::RevOrder, true, true>(F.lds + RING_OFF, gm, SR, E, F.tid); }
#else
            pg8::gemm_phase<pg8::EpiSwiglu, pg8::StaticOrder, true, true>(F.lds + RING_OFF, gm, S, E, F.tid);
#endif
        }
        SEAM(pb + 6);
        if (INP(8, pb + 7)) REP(8) { FRESH(); unsigned char* wl = F.ws + WS_W + (size_t)l * W_LAYER;
            pg8::Gemm gm{(const pg8::bf16_t*)(F.ws + WS_H), (const pg8::bf16_t*)(wl + W_F2), M, D, DFF}; pg8::StaticOrder S; S.init(M, D, NWG, (int)blockIdx.x);
            pg8::EpiResid E{(pg8::bf16_t*)(F.ws + WS_XB), (float*)(F.ws + WS_SS), (rep_ == 1) ? 0.f : 1.f};
#if defined(TIMING_NULL_G35)
            if (rep_ == 1) { pg8::EpiNull EN{(float*)(F.ws + WS_SLOC)}; pg8::gemm_phase<pg8::EpiNull, pg8::StaticOrder, true, true>(F.lds + RING_OFF, gm, S, EN, F.tid); } else
#endif
            if (l >= FP8_L0) { FRESH();
                pg8::Gemm gm8{(const pg8::bf16_t*)(F.ws + WS_H), (const pg8::bf16_t*)(wl + W_F2), M, D, DFF / 2};
                pg8::EpiResid E8{(pg8::bf16_t*)(F.ws + WS_XB), (float*)(F.ws + WS_SS), (rep_ == 1) ? 0.f : (1.0f / 2048.0f)};
                pg8::gemm_phase<pg8::EpiResid, pg8::StaticOrder, true, false, false, true>(F.lds + RING_OFF, gm8, S, E8, F.tid);
            } else { FRESH();
            pg8::gemm_phase<pg8::EpiResid, pg8::StaticOrder, true, true>(F.lds + RING_OFF, gm, S, E, F.tid); }
        }
        if (IN(pb + 7) && l + 1 < DEPTH) { FRESH(); conv_finish(F, l + 1); }
        SEAM(pb + 7);
    }
#if defined(TAIL_PROBE)
    if (hi - lo > 1) { unsigned long long* accp = (unsigned long long*)(ctl + 2048);
#if defined(TAIL_MIN)
        if (F.tid == 0) atomicMin(accp + 1, wait_sum);
#else
        if (F.tid == 0) atomicAdd(accp, wait_sum);
#endif
        xcd_barrier(bar);
        if (blockIdx.x == 0 && F.tid == 0) {
#if defined(TAIL_MIN)
            const unsigned long long avg = __hip_atomic_load(accp + 1, __ATOMIC_RELAXED, __HIP_MEMORY_SCOPE_AGENT);
#else
            const unsigned long long tot = __hip_atomic_load(accp, __ATOMIC_RELAXED, __HIP_MEMORY_SCOPE_AGENT); const unsigned long long avg = tot / gridDim.x;
#endif
            const unsigned long long t0_ = wall_clock64(); while (wall_clock64() - t0_ < avg * TAIL_PROBE) __builtin_amdgcn_s_sleep(32); } }
#endif
#if defined(END_WB)
    asm volatile("s_waitcnt vmcnt(0)" ::: "memory"); __builtin_amdgcn_fence(__ATOMIC_RELEASE, "agent"); asm volatile("s_waitcnt vmcnt(0)" ::: "memory");
#endif
#if defined(PROBE_STOP)
    if (hi - lo > 1) xcd_barrier(bar);
    if (IN(NPHASES - 1)) { FRESH(); probe_dump(F); }
#else
    if (INP(9, NPHASES - 1)) { FRESH(); final_norm(F); }
#endif
#undef IN
#undef INP
#undef FRESH
#undef SEAM
}

extern "C" void kernel_launch(void* const* d_in, const int* in_sizes, int n_in, void* d_out, int out_size, void* d_ws, size_t ws_size, hipStream_t stream) {
    static int grid = 0;
    if (grid == 0) {
        if (n_in != 15 || in_sizes[0] != M * D || out_size != M * D || ws_size < WS_END) { fprintf(stderr, "kernel_launch: unexpected sizes (n_in %d, in0 %d, out %d, ws %zu < %zu?)\n", n_in, n_in > 0 ? in_sizes[0] : -1, out_size, ws_size, (size_t)WS_END); grid = -1; return; }
        int dev = 0, cus = 0, per_cu = 0;
        if (hipGetDevice(&dev) != hipSuccess || hipDeviceGetAttribute(&cus, hipDeviceAttributeMultiprocessorCount, dev) != hipSuccess) { grid = -1; return; }
        if (hipFuncSetAttribute((const void*)mk_fwd, hipFuncAttributeMaxDynamicSharedMemorySize, LDS_BYTES) != hipSuccess) { fprintf(stderr, "kernel_launch: hipFuncSetAttribute failed\n"); grid = -1; return; }
        if (hipOccupancyMaxActiveBlocksPerMultiprocessor(&per_cu, (const void*)mk_fwd, NWAVES * 64, LDS_BYTES) != hipSuccess || per_cu < 1) fprintf(stderr, "kernel_launch: occupancy query reports %d\n", per_cu);
        (void)hipGetLastError();
        if (cus < NWG) { fprintf(stderr, "kernel_launch: built for a %d-CU device (one resident workgroup per CU), this one has %d; nothing launched\n", NWG, cus); grid = -1; return; }
        grid = NWG;
    }
    if (grid < 0) return;
    if (hipMemsetAsync((char*)d_ws + WS_CTL, 0, CTL_ZERO_BYTES, stream) != hipSuccess) return;
    Args a{};
    for (int i = 0; i < 15; ++i) a.in[i] = (const float*)d_in[i];
    a.out = (float*)d_out; a.ws = (unsigned char*)d_ws;
#if MK_PER_PHASE
    for (int p = 0; p < NPHASES; ++p) { a.ph_lo = p; a.ph_hi = p + 1; hipLaunchKernelGGL(mk_fwd, dim3(grid), dim3(NWAVES * 64), LDS_BYTES, stream, a); }
#else
    a.ph_lo = 0; a.ph_hi = NPHASES; hipLaunchKernelGGL(mk_fwd, dim3(grid), dim3(NWAVES * 64), LDS_BYTES, stream, a);
#endif
}
```
